# Optimizing an MI355X kernel written in HIP

```python
import jax, jax.numpy as jnp
from jax import lax
import numpy as np

D_MODEL = 2048
BATCH = 4
SEQ = 4096
DEPTH = 4

GRID_W = 64
CTX_LEN = 256
N_MIXERS = 2
N_RET_LAYERS = (DEPTH + 1) // 2
N_MLA_LAYERS = DEPTH // 2

RET_HEADS = 8
RET_DK = D_MODEL // RET_HEADS
RET_DV = 2 * D_MODEL // RET_HEADS
RET_CHUNK = 128
RET_ROPE_BASE = 10000.0
GN_EPS = 1e-6

MLA_HEADS = 16
MLA_Q_LORA = 512
MLA_KV_LORA = 512
MLA_D_NOPE = 128
MLA_D_ROPE = 64
MLA_D_V = 128
MLA_Q_BLOCK = 128
MLA_SCALE = (MLA_D_NOPE + MLA_D_ROPE) ** -0.5
AXIAL_ROPE_BASE = 10000.0
RMS_EPS = 1e-6

FFN_HIDDEN = (((8 * D_MODEL + 2) // 3) + 255) // 256 * 256

DEEPNORM_ALPHA = (2 * DEPTH) ** 0.25
DEEPNORM_BETA = (8 * DEPTH) ** -0.25
LN_EPS = 1e-5

kernel_name = 'hybrid_retention_mla_dit_trunk'


def layer_norm(x, g, b):
    xf = x.astype(jnp.float32)
    mu = jnp.mean(xf, axis=-1, keepdims=True)
    var = jnp.mean(jnp.square(xf - mu), axis=-1, keepdims=True)
    return ((xf - mu) * lax.rsqrt(var + LN_EPS) * g + b).astype(x.dtype)


def rms_norm(x, g):
    xf = x.astype(jnp.float32)
    return (xf * lax.rsqrt(jnp.mean(jnp.square(xf), axis=-1, keepdims=True) + RMS_EPS) * g).astype(x.dtype)


def rope_tables(pos, inv_freq):
    ang = pos.astype(jnp.float32)[:, None] * inv_freq[None, :]
    return jnp.cos(ang), jnp.sin(ang)


def apply_rope(x, cos, sin):
    x1, x2 = jnp.split(x, 2, axis=-1)
    c = cos[:, None, :]
    s = sin[:, None, :]
    return jnp.concatenate([x1 * c - x2 * s, x1 * s + x2 * c], axis=-1).astype(x.dtype)


def apply_rope_2d(x, row_cos, row_sin, col_cos, col_sin):
    xr, xc = jnp.split(x, 2, axis=-1)
    return jnp.concatenate([apply_rope(xr, row_cos, row_sin), apply_rope(xc, col_cos, col_sin)], axis=-1)


def modulation(cond, w, b):
    return jnp.split(jax.nn.silu(cond) @ w + b, 6, axis=-1)


def retention_chunkwise(q, k, v, log_gamma, s0):
    B, H, N, dk = q.shape
    dv = v.shape[-1]
    C = RET_CHUNK
    nc = N // C

    def to_chunks(t):
        return t.reshape(B, H, nc, C, t.shape[-1]).transpose(2, 0, 1, 3, 4)

    idx = jnp.arange(C, dtype=jnp.float32)
    diff = idx[:, None] - idx[None, :]
    intra = jnp.where(diff >= 0, jnp.exp(log_gamma[:, None, None] * jnp.maximum(diff, 0.0)), 0.0)
    q_dec = jnp.exp(log_gamma[:, None] * (idx + 1.0))[:, :, None]
    k_dec = jnp.exp(log_gamma[:, None] * (C - 1.0 - idx))[:, :, None]
    c_dec = jnp.exp(log_gamma * C)[:, None, None]

    def step(S, qkv):
        qc, kc, vc = qkv
        scores = jnp.einsum('bhid,bhjd->bhij', qc, kc) * intra
        o = jnp.einsum('bhij,bhjv->bhiv', scores, vc) + jnp.einsum('bhid,bhdv->bhiv', qc * q_dec, S)
        S = S * c_dec + jnp.einsum('bhjd,bhjv->bhdv', kc * k_dec, vc)
        return S, o

    S, o = lax.scan(step, s0, (to_chunks(q), to_chunks(k), to_chunks(v)))
    return o.transpose(1, 2, 0, 3, 4).reshape(B, H, N, dv), S


def head_group_norm(o):
    mu = jnp.mean(o, axis=-1, keepdims=True)
    var = jnp.mean(jnp.square(o - mu), axis=-1, keepdims=True)
    o = (o - mu) * lax.rsqrt(var + GN_EPS)
    B, H, N, dv = o.shape
    return o.transpose(0, 2, 1, 3).reshape(B, N, H * dv)


def retention_mixer(u_x, u_c, ret_cos, ret_sin, w_qkv, w_g, decay_logit, w_o, ctx_out):
    H, dk, dv = RET_HEADS, RET_DK, RET_DV

    def project(u):
        B, N, _ = u.shape
        q, k, v = jnp.split(u @ w_qkv, [H * dk, 2 * H * dk], axis=-1)
        return q.reshape(B, N, H, dk), k.reshape(B, N, H, dk) * (dk ** -0.5), v.reshape(B, N, H, dv)

    def heads_first(t):
        return t.astype(jnp.float32).transpose(0, 2, 1, 3)

    q_x, k_x, v_x = project(u_x)
    q_x = apply_rope(q_x, ret_cos, ret_sin)
    k_x = apply_rope(k_x, ret_cos, ret_sin)
    q_x, k_x, v_x = heads_first(q_x), heads_first(k_x), heads_first(v_x)
    q_c, k_c, v_c = project(u_c)
    q_c, k_c, v_c = heads_first(q_c), heads_first(k_c), heads_first(v_c)

    log_gamma = jax.nn.log_sigmoid(decay_logit.astype(jnp.float32))
    s0 = jnp.zeros((q_x.shape[0], H, dk, dv), jnp.float32)
    flip = lambda t: jnp.flip(t, axis=2)
    oc_f, sc_f = retention_chunkwise(q_c, k_c, v_c, log_gamma[0], s0)
    ox_f, _ = retention_chunkwise(q_x, k_x, v_x, log_gamma[0], sc_f)
    oc_b, sc_b = retention_chunkwise(flip(q_c), flip(k_c), flip(v_c), log_gamma[1], s0)
    ox_b, _ = retention_chunkwise(flip(q_x), flip(k_x), flip(v_x), log_gamma[1], sc_b)

    def combine(u, o_f, o_b):
        g_f, g_b = jnp.split(u @ w_g, 2, axis=-1)
        y = (jax.nn.silu(g_f) * head_group_norm(o_f).astype(u.dtype)
             + jax.nn.silu(g_b) * head_group_norm(o_b).astype(u.dtype))
        return y @ w_o

    y_x = combine(u_x, ox_f, flip(ox_b))
    y_c = combine(u_c, oc_f, flip(oc_b)) if ctx_out else None
    return y_x, y_c


def mla_attend(qn, qr, kn, kr, v):
    s = jnp.einsum('bqhd,bkhd->bhqk', qn, kn) + jnp.einsum('bqhd,bkd->bhqk', qr, kr)
    p = jax.nn.softmax(s.astype(jnp.float32) * MLA_SCALE, axis=-1)
    return jnp.einsum('bhqk,bkhd->bqhd', p.astype(v.dtype), v)


def mla_block_attention(qn, qr, kn, kr, v):
    B, N, H, _ = qn.shape
    nb = N // MLA_Q_BLOCK

    def blocks(t):
        return t.reshape(B, nb, MLA_Q_BLOCK, *t.shape[2:]).swapaxes(0, 1)

    o = lax.map(lambda qs: mla_attend(qs[0], qs[1], kn, kr, v), (blocks(qn), blocks(qr)))
    return o.swapaxes(0, 1).reshape(B, N, H, MLA_D_V)


def mla_mixer(u_x, u_c, row_cos, row_sin, col_cos, col_sin,
              w_dq, g_q, w_uq, w_dkv, g_kv, w_ukv, w_o, ctx_out):
    H, dn, dr, dv = MLA_HEADS, MLA_D_NOPE, MLA_D_ROPE, MLA_D_V

    def queries(u):
        B, N, _ = u.shape
        q = (rms_norm(u @ w_dq, g_q) @ w_uq).reshape(B, N, H, dn + dr)
        return q[..., :dn], q[..., dn:]

    def keys_values(u):
        B, N, _ = u.shape
        ckv = u @ w_dkv
        c_kv = rms_norm(ckv[..., :MLA_KV_LORA], g_kv)
        kr = ckv[..., MLA_KV_LORA:]
        kv = (c_kv @ w_ukv).reshape(B, N, H, dn + dv)
        return kv[..., :dn], kr, kv[..., dn:]

    qn_x, qr_x = queries(u_x)
    qr_x = apply_rope_2d(qr_x, row_cos, row_sin, col_cos, col_sin)
    kn_x, kr_x, v_x = keys_values(u_x)
    kr_x = apply_rope_2d(kr_x[:, :, None, :], row_cos, row_sin, col_cos, col_sin)[:, :, 0, :]
    kn_c, kr_c, v_c = keys_values(u_c)

    kn = jnp.concatenate([kn_x, kn_c], axis=1)
    kr = jnp.concatenate([kr_x, kr_c], axis=1)
    v = jnp.concatenate([v_x, v_c], axis=1)
    B, N, _ = u_x.shape
    o_x = mla_block_attention(qn_x, qr_x, kn, kr, v)
    y_x = o_x.reshape(B, N, H * dv) @ w_o
    y_c = None
    if ctx_out:
        qn_c, qr_c = queries(u_c)
        o_c = mla_attend(qn_c, qr_c, kn_c, kr_c, v_c)
        y_c = o_c.reshape(B, u_c.shape[1], H * dv) @ w_o
    return y_x, y_c


def swiglu(u, w_in, w_out):
    a, b = jnp.split(u @ w_in, 2, axis=-1)
    return (jax.nn.silu(a) * b) @ w_out


def setup_inputs(seed: int = 0) -> dict:
    key = jax.random.key(seed)
    ks = jax.random.split(key, 21)
    f32 = jnp.float32
    D, F = D_MODEL, FFN_HIDDEN

    def nrm(k, shape, scale):
        return jax.random.normal(k, shape, f32) * scale

    ret_qkv_w = 2 * RET_HEADS * RET_DK + RET_HEADS * RET_DV
    base_logit = jnp.log(2.0 ** (5.0 + jnp.arange(RET_HEADS, dtype=f32)) - 1.0)
    return {
        'x': nrm(ks[0], (BATCH, SEQ, D), 1.0),
        'c': nrm(ks[1], (BATCH, D), 1.0),
        'ctx': nrm(ks[2], (BATCH, CTX_LEN, D), 1.0),
        'c_ctx': nrm(ks[3], (D,), 1.0),
        'ada_w': nrm(ks[4], (DEPTH, D, 6 * D), 0.5 * D ** -0.5),
        'ada_b': nrm(ks[5], (DEPTH, 6 * D), 0.02),
        'ln_g': 1.0 + nrm(ks[6], (DEPTH, 2, D), 0.02),
        'ln_b': nrm(ks[7], (DEPTH, 2, D), 0.02),
        'ret_w_qkv': nrm(ks[8], (N_RET_LAYERS, D, ret_qkv_w), D ** -0.5),
        'ret_w_g': nrm(ks[9], (N_RET_LAYERS, D, 2 * RET_HEADS * RET_DV), D ** -0.5),
        'ret_decay_logit': base_logit + nrm(ks[10], (N_RET_LAYERS, 2, RET_HEADS), 0.1),
        'ret_w_o': nrm(ks[11], (N_RET_LAYERS, RET_HEADS * RET_DV, D), DEEPNORM_BETA * (RET_HEADS * RET_DV) ** -0.5),
        'mla_w_dq': nrm(ks[12], (N_MLA_LAYERS, D, MLA_Q_LORA), D ** -0.5),
        'mla_g_q': 1.0 + nrm(ks[13], (N_MLA_LAYERS, MLA_Q_LORA), 0.02),
        'mla_w_uq': nrm(ks[14], (N_MLA_LAYERS, MLA_Q_LORA, MLA_HEADS * (MLA_D_NOPE + MLA_D_ROPE)), MLA_Q_LORA ** -0.5),
        'mla_w_dkv': nrm(ks[15], (N_MLA_LAYERS, D, MLA_KV_LORA + MLA_D_ROPE), D ** -0.5),
        'mla_g_kv': 1.0 + nrm(ks[16], (N_MLA_LAYERS, MLA_KV_LORA), 0.02),
        'mla_w_ukv': nrm(ks[17], (N_MLA_LAYERS, MLA_KV_LORA, MLA_HEADS * (MLA_D_NOPE + MLA_D_V)), MLA_KV_LORA ** -0.5),
        'mla_w_o': nrm(ks[18], (N_MLA_LAYERS, MLA_HEADS * MLA_D_V, D), DEEPNORM_BETA * (MLA_HEADS * MLA_D_V) ** -0.5),
        'ffn_w_in': nrm(ks[19], (DEPTH, D, 2 * F), D ** -0.5),
        'ffn_w_out': nrm(ks[20], (DEPTH, F, D), DEEPNORM_BETA * F ** -0.5),
    }


def reference(x, c, ctx, c_ctx, ada_w, ada_b, ln_g, ln_b,
              ret_w_qkv, ret_w_g, ret_decay_logit, ret_w_o,
              mla_w_dq, mla_g_q, mla_w_uq, mla_w_dkv, mla_g_kv, mla_w_ukv, mla_w_o,
              ffn_w_in, ffn_w_out):
    N = x.shape[1]
    ROWS = N // GRID_W
    rows = jnp.repeat(jnp.arange(ROWS), GRID_W)
    cols = jnp.tile(jnp.arange(GRID_W), ROWS)
    t = jnp.arange(N)

    axial_dim = MLA_D_ROPE // 2
    axial_inv = AXIAL_ROPE_BASE ** (-jnp.arange(axial_dim // 2, dtype=jnp.float32) * 2.0 / axial_dim)
    row_cos, row_sin = rope_tables(rows, axial_inv)
    col_cos, col_sin = rope_tables(cols, axial_inv)
    ret_inv = RET_ROPE_BASE ** (-jnp.linspace(0.0, 1.0, RET_DK // 2, dtype=jnp.float32))
    ret_cos, ret_sin = rope_tables(t, ret_inv)

    h_x, h_c = x, ctx
    for i in range(DEPTH):
        ctx_out = i < DEPTH - 1
        sh_a, sc_a, g_a, sh_f, sc_f, g_f = [m[:, None, :] for m in modulation(c, ada_w[i], ada_b[i])]
        csh_a, csc_a, cg_a, csh_f, csc_f, cg_f = modulation(c_ctx, ada_w[i], ada_b[i])

        u_x = h_x * (1.0 + sc_a) + sh_a
        u_c = h_c * (1.0 + csc_a) + csh_a
        j = i // N_MIXERS
        if i % N_MIXERS == 0:
            y_x, y_c = retention_mixer(u_x, u_c, ret_cos, ret_sin, ret_w_qkv[j], ret_w_g[j],
                                       ret_decay_logit[j], ret_w_o[j], ctx_out)
        else:
            y_x, y_c = mla_mixer(u_x, u_c, row_cos, row_sin, col_cos, col_sin,
                                 mla_w_dq[j], mla_g_q[j], mla_w_uq[j], mla_w_dkv[j], mla_g_kv[j],
                                 mla_w_ukv[j], mla_w_o[j], ctx_out)
        h_x = layer_norm(DEEPNORM_ALPHA * h_x + g_a * y_x, ln_g[i, 0], ln_b[i, 0])
        f_x = swiglu(h_x * (1.0 + sc_f) + sh_f, ffn_w_in[i], ffn_w_out[i])
        h_x = layer_norm(DEEPNORM_ALPHA * h_x + g_f * f_x, ln_g[i, 1], ln_b[i, 1])
        if ctx_out:
            h_c = layer_norm(DEEPNORM_ALPHA * h_c + cg_a * y_c, ln_g[i, 0], ln_b[i, 0])
            f_c = swiglu(h_c * (1.0 + csc_f) + csh_f, ffn_w_in[i], ffn_w_out[i])
            h_c = layer_norm(DEEPNORM_ALPHA * h_c + cg_f * f_c, ln_g[i, 1], ln_b[i, 1])
    return h_x
```

```cpp
#include <hip/hip_runtime.h>
#include <cstdio>
#include <cstdint>
#define MK_LAUNCH_PER_PHASE 0
namespace pg8 {
#define PG8_LAS __attribute__((address_space(3)))
typedef unsigned short bf16_t;
typedef short bf16x8 __attribute__((ext_vector_type(8)));
typedef float f32x4 __attribute__((ext_vector_type(4)));
typedef unsigned u32x4 __attribute__((ext_vector_type(4)));
constexpr int BM = 256, BK = 64, HALF = 128, HTB = HALF * BK * 2  , STAGE_BYTES = 8 * HTB, NXCD = 8, WGM = 8;

__host__ __device__ __forceinline__ int lds_byte(int r, int c) { const int st = (r >> 4) * 2 + (c >> 5), rr = r & 15, cc = c & 31, ob = rr * 64 + cc * 2; return st * 1024 + (ob ^ (((ob >> 9) & 1) << 5)); }
__host__ __device__ __forceinline__ void stage_rc(int b, int& R, int& C) { const int st = b / 1024, sb = b % 1024, swz = sb ^ (((sb >> 9) & 1) << 5); R = (st >> 1) * 16 + swz / 64; C = (st & 1) * 32 + (swz % 64) / 2; }
__host__ __device__ __forceinline__ int perm32(int rho) { const int n = rho >> 4, i = rho & 15; return 8 * (i >> 2) + 4 * n + (i & 3); }

struct Unit { int pm, pn, k0, nt, ks; };
struct Gemm { const bf16_t* A; const bf16_t* Bt; int M, N, K; };

struct StaticOrder {
    int nM, nN, nwg, G, c;
    __host__ __device__ void init(int M, int N, int G_, int c_) { nM = M / BM; nN = N / BM; nwg = nM * nN; G = G_; c = c_; }
    __host__ __device__ bool next(int i, Unit& u) const {
        const long L = (long)i * G + c; if (L >= nwg) return false;
        int wgid = (int)L; { const int q = nwg / NXCD, r = nwg % NXCD, xcd = wgid % NXCD, off = wgid / NXCD; wgid = (xcd < r ? xcd * (q + 1) : r * (q + 1) + (xcd - r) * q) + off; }
        const int nig = WGM * nN, gid = wgid / nig, fm = gid * WGM, gsz = (nM - fm) < WGM ? (nM - fm) : WGM;
        u.pm = fm + ((wgid % nig) % gsz); u.pn = (wgid % nig) / gsz; return true;
    }
    __device__ __forceinline__ void a_ready(const Unit&) const {}
    __device__ __forceinline__ void done(const Unit&) const {}
};

__device__ __forceinline__ unsigned cvt_pk_bf16(float lo, float hi) { unsigned r; asm volatile("v_cvt_pk_bf16_f32 %0, %1, %2" : "=v"(r) : "v"(lo), "v"(hi)); return r; }
struct TileOrder {
    int nM, nN, nmain, nwg, G, c, lat, split, kt, ioff = 0, ilim = 1 << 30;
    __host__ __device__ void init(int nM_, int nN_, int G_, int c_, int lat_, int split_, int kt_) { nM = nM_; nN = nN_; nmain = nM * nN; G = G_; c = c_; lat = lat_; split = split_; kt = kt_; nwg = nmain + 4 * nN * split; }
    __host__ __device__ __forceinline__ bool next(int i, Unit& u) const {
        if (i + ioff >= ilim) return false;
        const long L = (long)(i + ioff) * G + c; if (L >= nwg) return false;
        const bool sp = L >= nmain;
        const int e = (int)L - nmain, sdiv = split > 0 ? split : 1, tile = e / sdiv, sl = e - tile * sdiv, snt = kt / sdiv;
        int wgid = sp ? 0 : (int)L; { const int q = nmain / NXCD, r = nmain % NXCD, xcd = wgid % NXCD, off = wgid / NXCD; wgid = (xcd < r ? xcd * (q + 1) : r * (q + 1) + (xcd - r) * q) + off; }
        const int nig = WGM * nN, gid = wgid / nig, fm = gid * WGM, gsz = (nM - fm) < WGM ? (nM - fm) : WGM;
        int pm = fm + ((wgid % nig) % gsz); const int pn = (wgid % nig) / gsz; if (lat) pm += pm >> 4;
        Unit r; r.pm = sp ? 17 * (tile & 3) + 16 : pm; r.pn = sp ? (tile >> 2) : pn; r.k0 = sp ? sl * snt : 0; r.nt = sp ? snt : kt; r.ks = sp ? sl : -1;
        u = r; return true;
    }
    __device__ __forceinline__ void a_ready(const Unit&) const {}
    __device__ __forceinline__ void done(const Unit&) const {}
};
template <class Epi, class Sched, bool ALIGN_EPI = false, bool SP2 = false>
__device__ __forceinline__ void gemm_phase(PG8_LAS unsigned char* lds, const Gemm g, const Sched& S, const Epi& E, int tid_in) {
    int tid_ = tid_in; asm volatile("" : "+v"(tid_));
    const int tid = tid_, wid = __builtin_amdgcn_readfirstlane(tid >> 6), lane = tid & 63, wr = wid >> 2, wc = wid & 3, fr = lane & 15, fq = lane >> 4;
    const int K = g.K;
    unsigned voffA[2], voffB[2];
#pragma unroll
    for (int i = 0; i < 2; ++i) { int R, C; stage_rc(tid * 16 + i * 8192, R, C); const int Rb = Epi::PERM ? ((R & ~31) + perm32(R & 31)) : R;
        voffA[i] = (unsigned)(R * K + C) * 2u; voffB[i] = (unsigned)(Rb * K + C) * 2u; }
    const size_t kstep = (size_t)(BK * 2);
    const size_t hstep = (size_t)HALF * K * 2;
    const size_t tstep = 2 * hstep;
    const unsigned ldsw = (unsigned)wid * 1024u;
    const int aoff = lds_byte(wr * 64 + fr, fq * 8), boff = lds_byte(wc * 32 + fr, fq * 8);
#define PG8_SA(b, h) (((b) * 2 + (h)) * HTB)
#define PG8_SB(b, h) ((4 + (b) * 2 + (h)) * HTB)
#define PG8_STAGE(bufoff, gbase, voff) do { _Pragma("unroll") for (int _i = 0; _i < 2; ++_i) \
        __builtin_amdgcn_global_load_lds((const unsigned*)((const char*)(gbase) + (voff)[_i]), (PG8_LAS unsigned*)(lds + (bufoff) + ldsw + _i * 8192), 16, 0, 0); } while (0)
#define PG8_LDA(dst, b, h) do { _Pragma("unroll") for (int m = 0; m < 4; ++m) _Pragma("unroll") for (int k = 0; k < 2; ++k) dst[m][k] = *(const PG8_LAS bf16x8*)(lds + PG8_SA(b, h) + aoff + m * 2048 + k * 1024); } while (0)
#define PG8_LDB(dst, b, h) do { _Pragma("unroll") for (int n = 0; n < 2; ++n) _Pragma("unroll") for (int k = 0; k < 2; ++k) dst[n][k] = *(const PG8_LAS bf16x8*)(lds + PG8_SB(b, h) + boff + n * 2048 + k * 1024); } while (0)
#define PG8_MMA(ai, bj, At, Bt) do { __builtin_amdgcn_s_setprio(1); _Pragma("unroll") for (int m = 0; m < 4; ++m) _Pragma("unroll") for (int n = 0; n < 2; ++n) _Pragma("unroll") for (int k = 0; k < 2; ++k) \
        acc[ai][bj][m][n] = __builtin_amdgcn_mfma_f32_16x16x32_bf16(Bt[n][k], At[m][k], acc[ai][bj][m][n], 0, 0, 0); __builtin_amdgcn_s_setprio(0); } while (0)
#define PG8_WAIT_V(n) asm volatile("s_waitcnt vmcnt(" #n ")" ::: "memory")
#define PG8_WAIT_L(n) asm volatile("s_waitcnt lgkmcnt(" #n ")" ::: "memory")
#define PG8_BAR __builtin_amdgcn_s_barrier()
#define PG8_SCHED __builtin_amdgcn_sched_barrier(0)
    Unit cur, nxt; int ui = 0;
    if (!S.next(0, cur)) return;
    f32x4 acc[2][2][4][2];
#pragma unroll
    for (int a = 0; a < 2; ++a)
#pragma unroll
        for (int b = 0; b < 2; ++b)
#pragma unroll
            for (int m = 0; m < 4; ++m)
#pragma unroll
                for (int n = 0; n < 2; ++n) acc[a][b][m][n] = (f32x4){0.f, 0.f, 0.f, 0.f};
    bf16x8 At[4][2], B0[2][2], B1[2][2];
    const char* cA = (const char*)g.A + (size_t)cur.pm * tstep + (size_t)cur.k0 * kstep; const char* cB = (const char*)g.Bt + (size_t)cur.pn * tstep + (size_t)cur.k0 * kstep;
    S.a_ready(cur);
    if constexpr (SP2) {
        PG8_STAGE(PG8_SB(0, 0), cB, voffB); PG8_STAGE(PG8_SB(0, 1), cB + hstep, voffB); PG8_STAGE(PG8_SA(0, 0), cA, voffA); PG8_STAGE(PG8_SA(0, 1), cA + hstep, voffA);
        if (wr == 1) PG8_BAR;
        PG8_WAIT_V(2); PG8_BAR;
        PG8_STAGE(PG8_SB(1, 0), cB + kstep, voffB); PG8_STAGE(PG8_SA(1, 0), cA + kstep, voffA); PG8_STAGE(PG8_SB(1, 1), cB + hstep + kstep, voffB);
        PG8_WAIT_V(6); PG8_BAR;
    } else {
        PG8_STAGE(PG8_SB(0, 0), cB, voffB); PG8_STAGE(PG8_SA(0, 0), cA, voffA); PG8_STAGE(PG8_SB(0, 1), cB + hstep, voffB); PG8_STAGE(PG8_SA(0, 1), cA + hstep, voffA);
        if (wr == 1) PG8_BAR;
        PG8_WAIT_V(4); PG8_BAR;
        PG8_STAGE(PG8_SB(1, 0), cB + kstep, voffB); PG8_STAGE(PG8_SA(1, 0), cA + kstep, voffA); PG8_STAGE(PG8_SB(1, 1), cB + hstep + kstep, voffB);
        PG8_WAIT_V(6); PG8_BAR;
    }
    for (;;) {
        const bool has_next = S.next(ui + 1, nxt);
        const char* nA = has_next ? (const char*)g.A + (size_t)nxt.pm * tstep + (size_t)nxt.k0 * kstep : cA; const char* nB = has_next ? (const char*)g.Bt + (size_t)nxt.pn * tstep + (size_t)nxt.k0 * kstep : cB;
        const int nt = cur.nt;
        for (int t = 0; t < nt; t += 2) {
            const bool last = (t == nt - 2);
            const char* a1 = cA + (size_t)(t + 1) * kstep;
            const char* a2 = last ? nA : cA + (size_t)(t + 2) * kstep; const char* b2 = last ? nB : cB + (size_t)(t + 2) * kstep;
            const char* a3 = a2 + kstep; const char* b3 = b2 + kstep;
            if (last && has_next) S.a_ready(nxt);
            if constexpr (SP2) {
            PG8_LDB(B0, 0, 0); PG8_LDB(B1, 0, 1); PG8_SCHED; PG8_LDA(At, 0, 0); PG8_STAGE(PG8_SA(1, 1), a1 + hstep, voffA);
            PG8_WAIT_V(8); PG8_WAIT_L(0); PG8_BAR; PG8_MMA(0, 0, At, B0); PG8_MMA(0, 1, At, B1); PG8_BAR; PG8_SCHED;
            PG8_LDA(At, 0, 1); PG8_STAGE(PG8_SB(0, 0), b2, voffB); PG8_STAGE(PG8_SB(0, 1), b2 + hstep, voffB); PG8_STAGE(PG8_SA(0, 0), a2, voffA);
            PG8_WAIT_V(8); PG8_WAIT_L(0); PG8_BAR; PG8_MMA(1, 0, At, B0); PG8_MMA(1, 1, At, B1); PG8_BAR; PG8_SCHED;
            PG8_LDB(B0, 1, 0); PG8_LDB(B1, 1, 1); PG8_SCHED; PG8_LDA(At, 1, 0); PG8_STAGE(PG8_SA(0, 1), a2 + hstep, voffA);
            PG8_WAIT_V(8); PG8_WAIT_L(0); PG8_BAR; PG8_MMA(0, 0, At, B0); PG8_MMA(0, 1, At, B1); PG8_BAR; PG8_SCHED;
            PG8_LDA(At, 1, 1); PG8_STAGE(PG8_SB(1, 0), b3, voffB); PG8_STAGE(PG8_SB(1, 1), b3 + hstep, voffB); PG8_STAGE(PG8_SA(1, 0), a3, voffA);
            PG8_WAIT_V(8); PG8_WAIT_L(0); PG8_BAR; PG8_MMA(1, 0, At, B0); PG8_MMA(1, 1, At, B1); PG8_BAR; PG8_SCHED;
            } else {
            PG8_LDB(B0, 0, 0); PG8_SCHED; PG8_LDA(At, 0, 0); PG8_STAGE(PG8_SA(1, 1), a1 + hstep, voffA);
            PG8_WAIT_L(8); PG8_BAR; PG8_WAIT_L(0); PG8_MMA(0, 0, At, B0); PG8_BAR; PG8_SCHED;
            PG8_LDB(B1, 0, 1); PG8_STAGE(PG8_SB(0, 0), b2, voffB);
            PG8_BAR; PG8_WAIT_L(0); PG8_MMA(0, 1, At, B1); PG8_BAR;
            PG8_LDA(At, 0, 1); PG8_STAGE(PG8_SA(0, 0), a2, voffA);
            PG8_BAR; PG8_WAIT_L(0); PG8_MMA(1, 0, At, B0); PG8_BAR; PG8_SCHED;
            PG8_STAGE(PG8_SB(0, 1), b2 + hstep, voffB);
            PG8_WAIT_V(6); PG8_BAR; PG8_MMA(1, 1, At, B1); PG8_BAR;
            PG8_LDB(B0, 1, 0); PG8_SCHED; PG8_LDA(At, 1, 0); PG8_STAGE(PG8_SA(0, 1), a2 + hstep, voffA);
            PG8_WAIT_L(8); PG8_BAR; PG8_WAIT_L(0); PG8_MMA(0, 0, At, B0); PG8_BAR; PG8_SCHED;
            PG8_LDB(B1, 1, 1); PG8_STAGE(PG8_SB(1, 0), b3, voffB);
            PG8_BAR; PG8_WAIT_L(0); PG8_MMA(0, 1, At, B1); PG8_BAR;
            PG8_LDA(At, 1, 1); PG8_STAGE(PG8_SA(1, 0), a3, voffA);
            PG8_BAR; PG8_WAIT_L(0); PG8_MMA(1, 0, At, B0); PG8_BAR; PG8_SCHED;
            PG8_STAGE(PG8_SB(1, 1), b3 + hstep, voffB);
            PG8_WAIT_V(6); PG8_BAR; PG8_MMA(1, 1, At, B1); PG8_BAR;
            }
        }
        if constexpr (ALIGN_EPI) { if (wr == 0) PG8_BAR; }
        asm volatile("s_nop 15\n\ts_nop 15" ::: "memory");
        if constexpr (!Epi::AFTER_DRAIN) { E(acc, cur, wr, wc, fr, fq); S.done(cur); }
        if (!has_next) break;
#pragma unroll
        for (int a = 0; a < 2; ++a)
#pragma unroll
            for (int b = 0; b < 2; ++b)
#pragma unroll
                for (int m = 0; m < 4; ++m)
#pragma unroll
                    for (int n = 0; n < 2; ++n) acc[a][b][m][n] = (f32x4){0.f, 0.f, 0.f, 0.f};
        cur = nxt; cA = nA; cB = nB; ++ui;
        if constexpr (ALIGN_EPI) { if (wr == 1) PG8_BAR; }
    }
    PG8_WAIT_V(0);
    if constexpr (!ALIGN_EPI) { if (wr == 0) PG8_BAR; }
    PG8_BAR;
    if constexpr (Epi::AFTER_DRAIN) { E.fused(acc, cur, wr, wc, fr, fq, lds, wid, lane); S.done(cur); }
#undef PG8_SA
#undef PG8_SB
#undef PG8_STAGE
#undef PG8_LDA
#undef PG8_LDB
#undef PG8_MMA
#undef PG8_WAIT_V
#undef PG8_WAIT_L
#undef PG8_BAR
#undef PG8_SCHED
}
}

constexpr int D = 2048, BATCH = 4, SEQ = 4096, CTXL = 256, DEPTH = 4, FF = 5632;
constexpr int TPB = SEQ + CTXL;
constexpr int M = BATCH * TPB;
constexpr int NTM = M / 256;
constexpr int NTL = BATCH * SEQ / 256;
constexpr float ALPHA = 1.6817928305074290f;
constexpr float LN_EPS = 1e-5f, GN_EPS = 1e-6f, RMS_EPS = 1e-6f;
constexpr float MLA_SCALE = 0.07216878364870322f;
constexpr int NWAVES = 8;

constexpr size_t MiB = 1u << 20;
constexpr size_t WS_CTL = 0, CTL_ZERO_BYTES = 64 * 1024;
constexpr size_t WS_MOD = 1 * MiB;
constexpr size_t WS_RCS = 2 * MiB;
constexpr size_t WS_ACS = 6 * MiB;
constexpr size_t WS_WQKV = 8 * MiB;
constexpr size_t WS_WG = 72 * MiB;
constexpr size_t WS_WOR = 136 * MiB;
constexpr size_t WS_WD = 168 * MiB;
constexpr size_t WS_WUQ = 178 * MiB;
constexpr size_t WS_WUKV = 184 * MiB;
constexpr size_t WS_WOM = 192 * MiB;
constexpr size_t WS_WIN = 208 * MiB;
constexpr size_t WS_WOUT = 384 * MiB;
constexpr size_t WS_H = 472 * MiB;
constexpr size_t WS_U = 608 * MiB;
constexpr size_t WS_Y = 676 * MiB;
constexpr size_t WS_S = 744 * MiB;
constexpr size_t WS_RQ = WS_S, WS_RK = WS_S + 68 * MiB, WS_RV = WS_S + 136 * MiB, WS_OF = WS_S + 272 * MiB, WS_OB = WS_S + 408 * MiB, WS_PART = WS_S + 544 * MiB;
constexpr size_t WS_YG = WS_S;
constexpr size_t WS_SSQ = WS_S  , WS_CQKV = WS_S, WS_CQN = WS_S + 85 * MiB, WS_CKVN = WS_S + 102 * MiB, WS_KR = WS_S + 119 * MiB, WS_QB = WS_S + 122 * MiB,
                 WS_KN = WS_S + 224 * MiB, WS_VB = WS_S + 292 * MiB, WS_AO = WS_S + 360 * MiB;
constexpr size_t WS_HID = WS_S;
constexpr size_t WS_YP = 1297 * MiB;
constexpr size_t WS_END = 1329 * MiB;
constexpr int KSPLIT = 4;

constexpr int CW_BAR = 4096;

constexpr int RING_BYTES = 131072;
constexpr int LDSCTL_OFF = RING_BYTES, MISC_OFF = LDSCTL_OFF + 320;
constexpr int LDS_BYTES = 147456;

#define GAS __attribute__((address_space(1)))
#define LAS __attribute__((address_space(3)))
typedef unsigned short bf16;
typedef unsigned v4u __attribute__((ext_vector_type(4)));
typedef unsigned v2u __attribute__((ext_vector_type(2)));
typedef float f32x4 __attribute__((ext_vector_type(4)));
typedef float f32x2 __attribute__((ext_vector_type(2)));
typedef float f32x16 __attribute__((ext_vector_type(16)));
typedef short bf16x8 __attribute__((ext_vector_type(8)));
typedef short s16x4 __attribute__((ext_vector_type(4)));
typedef _Float16 h16;
typedef _Float16 h16x4 __attribute__((ext_vector_type(4)));
#define LDS_WAIT() asm volatile("s_waitcnt lgkmcnt(0)" ::: "memory")
#define VM_WAIT() asm volatile("s_waitcnt vmcnt(0)" ::: "memory")
#define SBAR() __builtin_amdgcn_sched_barrier(0)
using pg8::cvt_pk_bf16;
__device__ __forceinline__ float bf2f(unsigned short b) { return __uint_as_float(((unsigned)b) << 16); }
__device__ __forceinline__ float bflo(unsigned w) { return __uint_as_float(w << 16); }
__device__ __forceinline__ float bfhi(unsigned w) { return __uint_as_float(w & 0xffff0000u); }
__device__ __forceinline__ float silu_f(float x) { return x * __builtin_amdgcn_rcpf(1.0f + __expf(-x)); }

#define XB_TMO      128
#define XB_XCNT(j)  (256  + 64 * (j))
#define XB_XSUB(j)  (1280 + 64 * (j))
#define XB_XGEN(j)  (2304 + 64 * (j))
#define XB_TOP      3328
#define XB_TOPGEN   3392
#define XCD_BAR_WORDS 3456
#define XB_SPIN_CAP (1u << 20)

__device__ __forceinline__ unsigned xb_ld(unsigned* p)              { return __hip_atomic_load(p, __ATOMIC_RELAXED, __HIP_MEMORY_SCOPE_AGENT); }
__device__ __forceinline__ unsigned xb_add(unsigned* p, unsigned v) { return __hip_atomic_fetch_add(p, v, __ATOMIC_RELAXED, __HIP_MEMORY_SCOPE_AGENT); }
__device__ __forceinline__ unsigned xb_xcc_id() { return (unsigned)__builtin_amdgcn_s_getreg((3 << 11) | 20) & 0xFu; }
#define XB_SPIN(cond, bar) do { unsigned _sp = 0; while (cond) { __builtin_amdgcn_s_sleep(1); \
    if ((++_sp & 255u) == 0u) { if (xb_ld(&(bar)[XB_TMO])) break; if (_sp > XB_SPIN_CAP) { atomicAdd(&(bar)[XB_TMO], 1u); break; } } } } while (0)

struct XcdBarrier { unsigned* bar; unsigned x; volatile LAS unsigned* st; };
__device__ __forceinline__ XcdBarrier xcd_barrier_post(unsigned* bar, volatile LAS unsigned* st) {
    XcdBarrier b; b.bar = bar; b.x = xb_xcc_id(); b.st = st;
    if (threadIdx.x == 0) (void)xb_add(&bar[XB_XCNT(b.x)], 1u);
    return b;
}
__device__ __forceinline__ void xcd_barrier_complete(unsigned* bar, unsigned x, unsigned& nloc, unsigned& nx) {
    const unsigned G = gridDim.x * gridDim.y * gridDim.z;
    unsigned sum, cnt, mine, sp = 0u;
    for (;;) {
        sum = 0u; cnt = 0u; mine = 0u;
#pragma unroll
        for (unsigned j = 0; j < 16; ++j) { const unsigned c = xb_ld(&bar[XB_XCNT(j)]); sum += c; cnt += (c > 0u) ? 1u : 0u; mine = (j == x) ? c : mine; }
        if (sum == G) break;
        __builtin_amdgcn_s_sleep(1);
        if ((++sp & 255u) == 0u) { if (xb_ld(&bar[XB_TMO])) break; if (sp > XB_SPIN_CAP) { atomicAdd(&bar[XB_TMO], 1u); break; } }
    }
    nloc = mine > 0u ? mine : 1u; nx = cnt > 0u ? cnt : 1u;
}
__device__ __forceinline__ void xcd_barrier(const XcdBarrier& b, int wave) {
    asm volatile("s_waitcnt vmcnt(0)" ::: "memory");
    __syncthreads();
    int l_; asm volatile("v_mbcnt_lo_u32_b32 %0, -1, 0\n\tv_mbcnt_hi_u32_b32 %0, -1, %0" : "=v"(l_));
    if (l_ == 0 && wave == 0) {
        unsigned* bar = b.bar;
        __builtin_amdgcn_s_waitcnt(0);
        unsigned nloc = b.st[0], nx = b.st[1];
        if (nloc == 0u) { xcd_barrier_complete(bar, b.x, nloc, nx); b.st[0] = nloc; b.st[1] = nx; }
        const unsigned old = xb_add(&bar[XB_XSUB(b.x)], 1u);
        const unsigned gen = old / nloc;
        if (old + 1u == (gen + 1u) * nloc) {
            __builtin_amdgcn_fence(__ATOMIC_RELEASE, "agent");
            asm volatile("s_waitcnt vmcnt(0)" ::: "memory");
            const unsigned og = xb_add(&bar[XB_TOP], 1u);
            const unsigned tg = og / nx;
            if (og + 1u == (tg + 1u) * nx) xb_add(&bar[XB_TOPGEN], 1u);
            else XB_SPIN(xb_ld(&bar[XB_TOPGEN]) == tg, bar);
            __builtin_amdgcn_fence(__ATOMIC_ACQUIRE, "agent");
            xb_add(&bar[XB_XGEN(b.x)], 1u);
            asm volatile("s_waitcnt vmcnt(0)" ::: "memory");
        } else {
            XB_SPIN(xb_ld(&bar[XB_XGEN(b.x)]) == gen, bar);
            __builtin_amdgcn_fence(__ATOMIC_ACQUIRE, "agent");
            asm volatile("s_waitcnt vmcnt(0)" ::: "memory");
        }
    }
    __syncthreads();
}

__device__ __forceinline__ float shx(float v, int mask, int lane) { return __int_as_float(__builtin_amdgcn_ds_bpermute((lane ^ mask) << 2, __float_as_int(v))); }
__device__ __forceinline__ float wave_sum(float v, int lane) {
#pragma unroll
    for (int o = 1; o < 64; o <<= 1) v += shx(v, o, lane);
    return v;
}

typedef const pg8::f32x4 (&AccRef)[2][2][4][2];

struct EpiQKV {
    static constexpr bool PERM = true, AFTER_DRAIN = false;
    bf16 *Q, *K, *V; const float* cs;
    __device__ __forceinline__ void operator()(AccRef acc, const pg8::Unit& u, int wr, int wc, int fr, int fq) const {
        const int pn = u.pn, row0 = u.pm * 256 + wr * 64 + fr, tj = u.pm % 17; const bool isctx = (tj == 16); const int t0 = tj * 256 + wr * 64 + fr;
        if (pn < 16) {
            bf16* dst = (pn < 8) ? Q : K; const float sc = (pn < 8) ? 1.0f : 0.0625f; const int hc = (pn & 7) * 256 + wc * 32 + 8 * fq;
#pragma unroll
            for (int ai = 0; ai < 2; ++ai)
#pragma unroll
                for (int m = 0; m < 4; ++m) { const int r = row0 + ai * 128 + m * 16, t = t0 + ai * 128 + m * 16;
#pragma unroll
                    for (int bj = 0; bj < 2; ++bj) { f32x4 v0 = acc[ai][bj][m][0], v1 = acc[ai][bj][m][1];
                        if (!isctx) { const f32x4* cp = (const f32x4*)(cs + ((size_t)t * 128 + bj * 64 + wc * 16 + 4 * fq) * 2); const f32x4 c0 = cp[0], c1 = cp[1];
                            v0 = (f32x4){v0[0] * c0[0] - v0[1] * c0[1], v0[0] * c0[1] + v0[1] * c0[0], v0[2] * c0[2] - v0[3] * c0[3], v0[2] * c0[3] + v0[3] * c0[2]};
                            v1 = (f32x4){v1[0] * c1[0] - v1[1] * c1[1], v1[0] * c1[1] + v1[1] * c1[0], v1[2] * c1[2] - v1[3] * c1[3], v1[2] * c1[3] + v1[3] * c1[2]}; }
                        v0 = v0 * sc; v1 = v1 * sc;
                        v4u w; w.x = cvt_pk_bf16(v0[0], v0[1]); w.y = cvt_pk_bf16(v0[2], v0[3]); w.z = cvt_pk_bf16(v1[0], v1[1]); w.w = cvt_pk_bf16(v1[2], v1[3]);
                        *(v4u*)(dst + (size_t)r * 2048 + hc + bj * 128) = w; } }
        } else {
            const int vc = (pn - 16) * 256 + wc * 32 + 8 * fq;
#pragma unroll
            for (int ai = 0; ai < 2; ++ai)
#pragma unroll
                for (int m = 0; m < 4; ++m) { const int r = row0 + ai * 128 + m * 16;
#pragma unroll
                    for (int bj = 0; bj < 2; ++bj) { const f32x4 v0 = acc[ai][bj][m][0], v1 = acc[ai][bj][m][1];
                        v4u w; w.x = cvt_pk_bf16(v0[0], v0[1]); w.y = cvt_pk_bf16(v0[2], v0[3]); w.z = cvt_pk_bf16(v1[0], v1[1]); w.w = cvt_pk_bf16(v1[2], v1[3]);
                        *(v4u*)(V + (size_t)r * 4096 + vc + bj * 128) = w; } }
        }
    }
};
struct EpiGate {
    static constexpr bool PERM = true, AFTER_DRAIN = false;
    const bf16 *OF, *OB; const float* part; bf16* YG;
    __device__ __forceinline__ void operator()(AccRef acc, const pg8::Unit& u, int wr, int wc, int fr, int fq) const {
        const int head = u.pn >> 2, col = u.pn * 128 + wc * 32 + 8 * fq, row0 = u.pm * 256 + wr * 64 + fr;
#pragma unroll
        for (int hb = 0; hb < 4; ++hb) { const int ai = hb >> 1, mb = (hb & 1) * 2;
            f32x4 pa[2][4]; v4u of[2], ob[2];
#pragma unroll
            for (int mm = 0; mm < 2; ++mm) { const int r = row0 + ai * 128 + (mb + mm) * 16; const f32x4* pp = (const f32x4*)(part + ((size_t)r * 8 + head) * 16);
                pa[mm][0] = pp[0]; pa[mm][1] = pp[1]; pa[mm][2] = pp[2]; pa[mm][3] = pp[3];
                of[mm] = *(const v4u*)(OF + (size_t)r * 4096 + col); ob[mm] = *(const v4u*)(OB + (size_t)r * 4096 + col); }
#pragma unroll
            for (int mm = 0; mm < 2; ++mm) { const int m = mb + mm; const int r = row0 + ai * 128 + m * 16;
                const f32x4 a0 = pa[mm][0], a1 = pa[mm][1], b0 = pa[mm][2], b1 = pa[mm][3];
                const float mf = ((a0[0] + a0[2]) + (a1[0] + a1[2])) * (1.0f / 512.0f), qf = ((a0[1] + a0[3]) + (a1[1] + a1[3])) * (1.0f / 512.0f);
                const float mbb = ((b0[0] + b0[2]) + (b1[0] + b1[2])) * (1.0f / 512.0f), qb = ((b0[1] + b0[3]) + (b1[1] + b1[3])) * (1.0f / 512.0f);
                const float rf = rsqrtf(fmaxf(qf - mf * mf, 0.f) + GN_EPS), rb = rsqrtf(fmaxf(qb - mbb * mbb, 0.f) + GN_EPS);
                float y[8];
#pragma unroll
                for (int n = 0; n < 2; ++n) { const f32x4 gf = acc[ai][0][m][n], gb = acc[ai][1][m][n];
#pragma unroll
                    for (int e = 0; e < 4; ++e) { const int idx = n * 4 + e; const unsigned wf = of[mm][idx >> 1], wb = ob[mm][idx >> 1];
                        const float xf = (idx & 1) ? bfhi(wf) : bflo(wf), xb = (idx & 1) ? bfhi(wb) : bflo(wb);
                        y[idx] = silu_f(gf[e]) * ((xf - mf) * rf) + silu_f(gb[e]) * ((xb - mbb) * rb); } }
                v4u w; w.x = cvt_pk_bf16(y[0], y[1]); w.y = cvt_pk_bf16(y[2], y[3]); w.z = cvt_pk_bf16(y[4], y[5]); w.w = cvt_pk_bf16(y[6], y[7]);
                *(v4u*)(YG + (size_t)r * 4096 + col) = w; } }
    }
};
struct EpiSwiglu {
    static constexpr bool PERM = true, AFTER_DRAIN = false;
    bf16* HID;
    __device__ __forceinline__ void operator()(AccRef acc, const pg8::Unit& u, int wr, int wc, int fr, int fq) const {
        const int col = u.pn * 128 + wc * 32 + 8 * fq, row0 = u.pm * 256 + wr * 64 + fr;
#pragma unroll
        for (int ai = 0; ai < 2; ++ai)
#pragma unroll
            for (int m = 0; m < 4; ++m) { const int r = row0 + ai * 128 + m * 16; float y[8];
#pragma unroll
                for (int n = 0; n < 2; ++n) { const f32x4 a = acc[ai][0][m][n], b = acc[ai][1][m][n];
#pragma unroll
                    for (int e = 0; e < 4; ++e) y[n * 4 + e] = silu_f(a[e]) * b[e]; }
                v4u w; w.x = cvt_pk_bf16(y[0], y[1]); w.y = cvt_pk_bf16(y[2], y[3]); w.z = cvt_pk_bf16(y[4], y[5]); w.w = cvt_pk_bf16(y[6], y[7]);
                *(v4u*)(HID + (size_t)r * FF + col) = w; }
    }
};
struct EpiBf {
    static constexpr bool PERM = true, AFTER_DRAIN = false;
    bf16 *O0, *O1; int ldc, split; float* YP;
    __device__ __forceinline__ void operator()(AccRef acc, const pg8::Unit& u, int wr, int wc, int fr, int fq) const {
        const int row0 = u.pm * 256 + wr * 64 + fr, cw = wc * 32 + 8 * fq;
        if (u.ks >= 0) {
            const int crow0 = ((u.pm - 16) / 17) * 256 + wr * 64 + fr;
#pragma unroll
            for (int ai = 0; ai < 2; ++ai)
#pragma unroll
                for (int m = 0; m < 4; ++m) { float* rp = YP + ((size_t)u.ks * 1024 + crow0 + ai * 128 + m * 16) * 2048 + u.pn * 256 + cw;
#pragma unroll
                    for (int bj = 0; bj < 2; ++bj) { *(f32x4*)(rp + bj * 128) = acc[ai][bj][m][0]; *(f32x4*)(rp + bj * 128 + 4) = acc[ai][bj][m][1]; } }
            return; }
#pragma unroll
        for (int ai = 0; ai < 2; ++ai)
#pragma unroll
            for (int m = 0; m < 4; ++m) { const int r = row0 + ai * 128 + m * 16;
#pragma unroll
                for (int bj = 0; bj < 2; ++bj) { const f32x4 v0 = acc[ai][bj][m][0], v1 = acc[ai][bj][m][1];
                    v4u w; w.x = cvt_pk_bf16(v0[0], v0[1]); w.y = cvt_pk_bf16(v0[2], v0[3]); w.z = cvt_pk_bf16(v1[0], v1[1]); w.w = cvt_pk_bf16(v1[2], v1[3]);
                    bf16* dst = split ? ((bj ? O1 : O0) + (size_t)r * ldc + u.pn * 128 + cw) : (O0 + (size_t)r * ldc + u.pn * 256 + bj * 128 + cw);
                    *(v4u*)dst = w; } }
    }
};
struct EpiF32 {
    static constexpr bool PERM = false, AFTER_DRAIN = false;
    float* C; int ldc;
    __device__ __forceinline__ void operator()(AccRef acc, const pg8::Unit& u, int wr, int wc, int fr, int fq) const {
        const int row0 = u.pm * 256 + wr * 64 + fr, col0 = u.pn * 256 + wc * 32 + 4 * fq;
#pragma unroll
        for (int ai = 0; ai < 2; ++ai)
#pragma unroll
            for (int m = 0; m < 4; ++m) { float* rowp = C + (size_t)(row0 + ai * 128 + m * 16) * ldc + col0;
#pragma unroll
                for (int bj = 0; bj < 2; ++bj)
#pragma unroll
                    for (int n = 0; n < 2; ++n) *(f32x4*)(rowp + bj * 128 + n * 16) = acc[ai][bj][m][n]; }
    }
};
struct EpiDQKV {
    static constexpr bool PERM = true, AFTER_DRAIN = false;
    bf16 *CQ, *CKV, *KR; float* ssq; const float* acs;
    __device__ __forceinline__ void operator()(AccRef acc, const pg8::Unit& u, int wr, int wc, int fr, int fq) const {
        const int row0 = u.pm * 256 + wr * 64 + fr, tj = u.pm % 17; const bool isctx = (tj == 16); const int t0 = tj * 256 + wr * 64 + fr;
        if (u.pn < 4) { bf16* dst = (u.pn < 2) ? CQ : CKV; const int colb = (u.pn & 1) * 256 + wc * 32 + 8 * fq;
#pragma unroll
            for (int ai = 0; ai < 2; ++ai)
#pragma unroll
                for (int m = 0; m < 4; ++m) { const int r = row0 + ai * 128 + m * 16; float q = 0.f;
#pragma unroll
                    for (int bj = 0; bj < 2; ++bj) { const f32x4 v0 = acc[ai][bj][m][0], v1 = acc[ai][bj][m][1];
                        q += (v0[0] * v0[0] + v0[1] * v0[1]) + (v0[2] * v0[2] + v0[3] * v0[3]) + (v1[0] * v1[0] + v1[1] * v1[1]) + (v1[2] * v1[2] + v1[3] * v1[3]);
                        v4u w; w.x = cvt_pk_bf16(v0[0], v0[1]); w.y = cvt_pk_bf16(v0[2], v0[3]); w.z = cvt_pk_bf16(v1[0], v1[1]); w.w = cvt_pk_bf16(v1[2], v1[3]);
                        *(v4u*)(dst + (size_t)r * 512 + colb + bj * 128) = w; }
                    { const int ln = fq * 16 + fr;
                      q += shx(q, 16, ln); q += shx(q, 32, ln); }
                    if (fq == 0) ssq[(size_t)r * 16 + u.pn * 4 + wc] = q; }
        } else if (wc < 2) {
#pragma unroll
            for (int ai = 0; ai < 2; ++ai)
#pragma unroll
                for (int m = 0; m < 4; ++m) { const int r = row0 + ai * 128 + m * 16, t = t0 + ai * 128 + m * 16;
                    f32x4 v0 = acc[ai][0][m][0], v1 = acc[ai][0][m][1];
                    if (!isctx) { const f32x4* cp = (const f32x4*)(acs + ((size_t)t * 32 + 16 * wc + 4 * fq) * 2); const f32x4 c0 = cp[0], c1 = cp[1];
                        v0 = (f32x4){v0[0] * c0[0] - v0[1] * c0[1], v0[0] * c0[1] + v0[1] * c0[0], v0[2] * c0[2] - v0[3] * c0[3], v0[2] * c0[3] + v0[3] * c0[2]};
                        v1 = (f32x4){v1[0] * c1[0] - v1[1] * c1[1], v1[0] * c1[1] + v1[1] * c1[0], v1[2] * c1[2] - v1[3] * c1[3], v1[2] * c1[3] + v1[3] * c1[2]}; }
                    v4u w; w.x = cvt_pk_bf16(v0[0], v0[1]); w.y = cvt_pk_bf16(v0[2], v0[3]); w.z = cvt_pk_bf16(v1[0], v1[1]); w.w = cvt_pk_bf16(v1[2], v1[3]);
                    *(v4u*)(KR + (size_t)r * 64 + wc * 32 + 8 * fq) = w; }
        }
    }
};
__device__ __forceinline__ float rms_rstd(const float* p) { const f32x4 a = *(const f32x4*)p, b = *(const f32x4*)(p + 4); return rsqrtf(((a[0] + a[1]) + (a[2] + a[3]) + (b[0] + b[1]) + (b[2] + b[3])) * (1.0f / 512.0f) + RMS_EPS); }
struct EpiUKV {
    static constexpr bool PERM = true, AFTER_DRAIN = false;
    bf16 *KN, *VB; const float* ssq;
    __device__ __forceinline__ void operator()(AccRef acc, const pg8::Unit& u, int wr, int wc, int fr, int fq) const {
        const int row0 = u.pm * 256 + wr * 64 + fr, cw = u.pn * 128 + wc * 32 + 8 * fq;
#pragma unroll
        for (int ai = 0; ai < 2; ++ai)
#pragma unroll
            for (int m = 0; m < 4; ++m) { const int r = row0 + ai * 128 + m * 16; const float rs = rms_rstd(ssq + (size_t)r * 16 + 8);
#pragma unroll
                for (int bj = 0; bj < 2; ++bj) { const f32x4 v0 = acc[ai][bj][m][0] * rs, v1 = acc[ai][bj][m][1] * rs;
                    v4u w; w.x = cvt_pk_bf16(v0[0], v0[1]); w.y = cvt_pk_bf16(v0[2], v0[3]); w.z = cvt_pk_bf16(v1[0], v1[1]); w.w = cvt_pk_bf16(v1[2], v1[3]);
                    *(v4u*)((bj ? VB : KN) + (size_t)r * 2048 + cw) = w; } }
    }
};
struct EpiUQ {
    static constexpr bool PERM = true, AFTER_DRAIN = false;
    bf16* QB; const float* acs; const float* ssq;
    __device__ __forceinline__ void operator()(AccRef acc, const pg8::Unit& u, int wr, int wc, int fr, int fq) const {
        const int row0 = u.pm * 256 + wr * 64 + fr, tj = u.pm % 17; const bool isctx = (tj == 16); const int t0 = tj * 256 + wr * 64 + fr;
#pragma unroll
        for (int bj = 0; bj < 2; ++bj) { const int blk = 4 * u.pn + 2 * bj + (wc >> 1); const bool rope = ((blk % 3) == 2) && !isctx;
            const int col = u.pn * 256 + bj * 128 + wc * 32 + 8 * fq, p0 = 16 * (wc & 1) + 4 * fq;
#pragma unroll
            for (int ai = 0; ai < 2; ++ai)
#pragma unroll
                for (int m = 0; m < 4; ++m) { const int r = row0 + ai * 128 + m * 16, t = t0 + ai * 128 + m * 16; const float rs = rms_rstd(ssq + (size_t)r * 16);
                    f32x4 v0 = acc[ai][bj][m][0] * rs, v1 = acc[ai][bj][m][1] * rs;
                    if (rope) { const f32x4* cp = (const f32x4*)(acs + ((size_t)t * 32 + p0) * 2); const f32x4 c0 = cp[0], c1 = cp[1];
                        v0 = (f32x4){v0[0] * c0[0] - v0[1] * c0[1], v0[0] * c0[1] + v0[1] * c0[0], v0[2] * c0[2] - v0[3] * c0[3], v0[2] * c0[3] + v0[3] * c0[2]};
                        v1 = (f32x4){v1[0] * c1[0] - v1[1] * c1[1], v1[0] * c1[1] + v1[1] * c1[0], v1[2] * c1[2] - v1[3] * c1[3], v1[2] * c1[3] + v1[3] * c1[2]}; }
                    v4u w; w.x = cvt_pk_bf16(v0[0], v0[1]); w.y = cvt_pk_bf16(v0[2], v0[3]); w.z = cvt_pk_bf16(v1[0], v1[1]); w.w = cvt_pk_bf16(v1[2], v1[3]);
                    *(v4u*)(QB + (size_t)r * 3072 + col) = w; } }
    }
};

__device__ __forceinline__ int srccol(int mode, int n, int halfn) {
    if (mode == 1) { if (n >= 4096) return n; const int d = n & 255; return (n & ~255) + ((d & 1) ? 128 + (d >> 1) : (d >> 1)); }
    if (mode == 2) { const int t = n >> 8, r = n & 255; return (r < 128) ? t * 128 + r : halfn + t * 128 + (r - 128); }
    if (mode == 4) { const int h = n / 192, d = n - h * 192; if (d < 128) return n; const int p = d - 128, hf = p >> 5, dd = p & 31; return h * 192 + 128 + hf * 32 + ((dd & 1) ? 16 + (dd >> 1) : (dd >> 1)); }
    if (mode == 5) { const int hf = n >> 5, dd = n & 31; return 512 + hf * 32 + ((dd & 1) ? 16 + (dd >> 1) : (dd >> 1)); }
    return n;
}
struct CvtJob { const float* W; bf16* WT; int ldw, K, Nd, mode, halfn; const float* kscale; };
template <bool KS> __device__ __forceinline__ void transpose_item(const CvtJob& J, LAS float* scr, int item, int lane) {
    const int nblk = J.Nd / 32, kb = item / nblk, nb = item - kb * nblk, k0 = 64 * kb, n0 = 32 * nb;
    const int sc = srccol(J.mode, n0 + (lane & 31), J.halfn);
#pragma unroll
    for (int i = 0; i < 32; ++i) { const int kk = 2 * i + (lane >> 5); float w = J.W[(size_t)(k0 + kk) * J.ldw + sc]; if (KS) w *= J.kscale[k0 + kk]; scr[kk * 33 + (lane & 31)] = w; }
    LDS_WAIT(); asm volatile("" ::: "memory");
    const int c = lane & 7;
#pragma unroll
    for (int j = 0; j < 4; ++j) { const int n = (lane >> 3) + 8 * j; const LAS float* s = scr + (8 * c) * 33 + n;
        v4u o; o.x = cvt_pk_bf16(s[0 * 33], s[1 * 33]); o.y = cvt_pk_bf16(s[2 * 33], s[3 * 33]); o.z = cvt_pk_bf16(s[4 * 33], s[5 * 33]); o.w = cvt_pk_bf16(s[6 * 33], s[7 * 33]);
        *(v4u*)(J.WT + (size_t)(n0 + n) * J.K + k0 + 8 * c) = o; }
    LDS_WAIT(); asm volatile("" ::: "memory");
}

struct Args { const float* in[21]; float* out; unsigned char* ws; int ph_lo, ph_hi; };
enum { I_X = 0, I_C, I_CTX, I_CCTX, I_ADAW, I_ADAB, I_LNG, I_LNB, I_RWQKV, I_RWG, I_RDEC, I_RWO, I_MWDQ, I_MGQ, I_MWUQ, I_MWDKV, I_MGKV, I_MWUKV, I_MWO, I_FWIN, I_FWOUT };

__device__ __forceinline__ CvtJob cvt_job(const Args& a, int j) {
    unsigned char* ws = a.ws; CvtJob J; J.mode = 0; J.halfn = 0; J.kscale = nullptr;
    if (j < 6) { const int l = j / 3, k = j - 3 * l;
        if (k == 0) { J.W = a.in[I_RWQKV] + (size_t)l * 2048 * 8192; J.WT = (bf16*)(ws + WS_WQKV) + (size_t)l * 8192 * 2048; J.ldw = 8192; J.K = 2048; J.Nd = 8192; J.mode = 1; }
        else if (k == 1) { J.W = a.in[I_RWG] + (size_t)l * 2048 * 8192; J.WT = (bf16*)(ws + WS_WG) + (size_t)l * 8192 * 2048; J.ldw = 8192; J.K = 2048; J.Nd = 8192; J.mode = 2; J.halfn = 4096; }
        else { J.W = a.in[I_RWO] + (size_t)l * 4096 * 2048; J.WT = (bf16*)(ws + WS_WOR) + (size_t)l * 2048 * 4096; J.ldw = 2048; J.K = 4096; J.Nd = 2048; }
    } else if (j < 18) { const int jj = j - 6, l = jj / 6, k = jj - 6 * l; bf16* wd = (bf16*)(ws + WS_WD) + (size_t)l * 1280 * 2048;
        if (k == 0) { J.W = a.in[I_MWDQ] + (size_t)l * 2048 * 512; J.WT = wd; J.ldw = 512; J.K = 2048; J.Nd = 512; }
        else if (k == 1) { J.W = a.in[I_MWDKV] + (size_t)l * 2048 * 576; J.WT = wd + (size_t)512 * 2048; J.ldw = 576; J.K = 2048; J.Nd = 512; }
        else if (k == 2) { J.W = a.in[I_MWDKV] + (size_t)l * 2048 * 576; J.WT = wd + (size_t)1024 * 2048; J.ldw = 576; J.K = 2048; J.Nd = 64; J.mode = 5; }
        else if (k == 3) { J.W = a.in[I_MWUQ] + (size_t)l * 512 * 3072; J.WT = (bf16*)(ws + WS_WUQ) + (size_t)l * 3072 * 512; J.ldw = 3072; J.K = 512; J.Nd = 3072; J.mode = 4; J.kscale = a.in[I_MGQ] + (size_t)l * 512; }
        else if (k == 4) { J.W = a.in[I_MWUKV] + (size_t)l * 512 * 4096; J.WT = (bf16*)(ws + WS_WUKV) + (size_t)l * 4096 * 512; J.ldw = 4096; J.K = 512; J.Nd = 4096; J.kscale = a.in[I_MGKV] + (size_t)l * 512; }
        else { J.W = a.in[I_MWO] + (size_t)l * 2048 * 2048; J.WT = (bf16*)(ws + WS_WOM) + (size_t)l * 2048 * 2048; J.ldw = 2048; J.K = 2048; J.Nd = 2048; }
    } else { const int jj = j - 18, l = jj >> 1;
        if ((jj & 1) == 0) { J.W = a.in[I_FWIN] + (size_t)l * 2048 * 11264; J.WT = (bf16*)(ws + WS_WIN) + (size_t)l * 11264 * 2048; J.ldw = 11264; J.K = 2048; J.Nd = 11264; J.mode = 2; J.halfn = 5632; }
        else { J.W = a.in[I_FWOUT] + (size_t)l * 5632 * 2048; J.WT = (bf16*)(ws + WS_WOUT) + (size_t)l * 2048 * 5632; J.ldw = 2048; J.K = 5632; J.Nd = 2048; }
    }
    return J;
}
constexpr int N_CVT_JOBS = 26;

__device__ __forceinline__ void phase_pro_a(const Args& a, LAS unsigned char* lds, int tid, int lane, int wave, int vcu, int G) {
    unsigned char* ws = a.ws;
    const int gw = vcu * NWAVES + wave, NGW = G * NWAVES;
#ifndef PROA_REP_CVT
#define PROA_REP_CVT 1
#endif
#ifndef PROA_REP_GEMV
#define PROA_REP_GEMV 1
#endif
    for (int rep_c = 0; rep_c < PROA_REP_CVT; ++rep_c)
    { LAS float* scr = (LAS float*)(lds + wave * 16384);
      int cum = 0;
      for (int j = 0; j < N_CVT_JOBS; ++j) { const CvtJob J = cvt_job(a, j); const int nit = (J.K / 64) * (J.Nd / 32);
          int start = (gw - cum) % NGW; if (start < 0) start += NGW;
          if (J.kscale) { for (int it = start; it < nit; it += NGW) transpose_item<true>(J, scr, it, lane); }
          else { for (int it = start; it < nit; it += NGW) transpose_item<false>(J, scr, it, lane); }
          cum = (cum + nit) % NGW; }
      const int gt = vcu * 512 + tid, NT = G * 512;
      for (int l = 0; l < 2; ++l) { v4u* z = (v4u*)((bf16*)(ws + WS_WD) + (size_t)l * 1280 * 2048 + (size_t)1088 * 2048);
          for (int i = gt; i < 192 * 2048 / 8; i += NT) z[i] = (v4u){0u, 0u, 0u, 0u}; }
    }
    __syncthreads();
    { const int gt = vcu * 512 + tid, NT = G * 512; f32x2* rcs = (f32x2*)(ws + WS_RCS); f32x2* acs = (f32x2*)(ws + WS_ACS);
      for (int e = gt; e < 4096 * 128; e += NT) { const int t = e >> 7, j = e & 127; const float inv = exp2f(-((float)j * (1.0f / 127.0f)) * 13.287712379549449f);
          const float ang = (float)t * inv; rcs[e] = (f32x2){cosf(ang), sinf(ang)}; }
      for (int e = gt; e < 4096 * 32; e += NT) { const int t = e >> 5, p = e & 31; const int j = p & 15; const float inv = exp2f(-((float)j * (1.0f / 16.0f)) * 13.287712379549449f);
          const float pos = (p < 16) ? (float)(t >> 6) : (float)(t & 63); const float ang = pos * inv; acs[e] = (f32x2){cosf(ang), sinf(ang)}; }
    }
    { LAS float* sc = (LAS float*)lds;
      LAS float* red = (LAS float*)(lds + 5 * 2048 * 4);
      for (int i = tid; i < 5 * 2048; i += 512) { const float v = (i < 4 * 2048) ? a.in[I_C][i] : a.in[I_CCTX][i - 4 * 2048]; sc[i] = silu_f(v); }
      __syncthreads();
      float* mod = (float*)(ws + WS_MOD);
      const int kq = lane >> 4, c4 = lane & 15;
      for (int rep_g = 0; rep_g < PROA_REP_GEMV; ++rep_g)
      for (int it = vcu; it < 4 * 192; it += G) { const int layer = it / 192, col0 = (it - layer * 192) * 64;
          const float* Wl = a.in[I_ADAW] + (size_t)layer * 2048 * 12288 + col0 + 4 * c4;
          float acc[5][4];
#pragma unroll
          for (int r = 0; r < 5; ++r)
#pragma unroll
              for (int e = 0; e < 4; ++e) acc[r][e] = 0.f;
#pragma unroll 8
          for (int j = 0; j < 64; ++j) { const int k = wave * 256 + 4 * j + kq; const f32x4 w = *(const f32x4*)(Wl + (size_t)k * 12288);
#pragma unroll
              for (int r = 0; r < 5; ++r) { const float s = sc[r * 2048 + k]; acc[r][0] += s * w[0]; acc[r][1] += s * w[1]; acc[r][2] += s * w[2]; acc[r][3] += s * w[3]; } }
#pragma unroll
          for (int r = 0; r < 5; ++r)
#pragma unroll
              for (int e = 0; e < 4; ++e) { float v = acc[r][e]; v += shx(v, 16, lane); v += shx(v, 32, lane); acc[r][e] = v; }
          if (lane < 16) {
#pragma unroll
              for (int r = 0; r < 5; ++r)
#pragma unroll
                  for (int e = 0; e < 4; ++e) red[(wave * 5 + r) * 64 + 4 * c4 + e] = acc[r][e]; }
          __syncthreads();
          if (tid < 320) { const int r = tid >> 6, c = tid & 63; float s = 0.f;
#pragma unroll
              for (int w = 0; w < 8; ++w) s += red[(w * 5 + r) * 64 + c];
              mod[((size_t)layer * 5 + r) * 12288 + col0 + c] = s + a.in[I_ADAB][(size_t)layer * 12288 + col0 + c]; }
          __syncthreads(); }
    }
}

__device__ __forceinline__ const float* src_row(const Args& a, int r, int& r5) {
    const int b = r / TPB, t = r - b * TPB;
    if (t < SEQ) { r5 = b; return a.in[I_X] + ((size_t)b * SEQ + t) * D; }
    r5 = 4; return a.in[I_CTX] + ((size_t)b * CTXL + (t - SEQ)) * D;
}
__device__ __forceinline__ void phase_pro_b(const Args& a, int lane, int wave, int vcu, int G) {
    const int gw = vcu * NWAVES + wave, NGW = G * NWAVES; const float* mod = (const float*)(a.ws + WS_MOD);
    bf16* U = (bf16*)(a.ws + WS_U);
    for (int r = gw; r < M; r += NGW) { int r5; const float* src = src_row(a, r, r5); const float* sh = mod + (size_t)r5 * 12288, *scl = sh + 2048;
#pragma unroll
        for (int j = 0; j < 8; ++j) { const int c = 4 * lane + 256 * j; const f32x4 v = *(const f32x4*)(src + c), s = *(const f32x4*)(scl + c), t = *(const f32x4*)(sh + c);
            const f32x4 uu = v * (1.0f + s) + t;
            v2u w; w.x = cvt_pk_bf16(uu[0], uu[1]); w.y = cvt_pk_bf16(uu[2], uu[3]); *(v2u*)(U + (size_t)r * D + c) = w; } }
}
template <bool FIRST> __device__ __forceinline__ void phase_ln_t(const Args& a, int layer, int which, LAS unsigned char* lds, int tid, int lane, int wave, int vcu, int G, bool dry) {
    const float* mod = (const float*)(a.ws + WS_MOD);
    const h16* H = (const h16*)(a.ws + WS_H); h16* Hw = (h16*)(a.ws + (dry ? WS_END : WS_H)); bf16* U = (bf16*)(a.ws + (dry ? WS_END + 136 * MiB : WS_U)); const bf16* Y = (const bf16*)(a.ws + WS_Y);
    const bool latonly = (layer == DEPTH - 1), final = (layer == DEPTH - 1) && which == 1; const bool ysplit = !latonly; const float* YP = (const float*)(a.ws + WS_YP);
    const float* lg = a.in[I_LNG] + ((size_t)layer * 2 + which) * D; const float* lb = a.in[I_LNB] + ((size_t)layer * 2 + which) * D;
    const int gch = which ? 5 : 2; const int nlayer = final ? 0 : (which ? layer + 1 : layer), nsh = which ? 0 : 3;
    const int nrows = latonly ? BATCH * SEQ : M, rpc = nrows / G;
    LAS float* V = (LAS float*)lds;
    if (G != 256) return;
    const int bb = vcu >> 6, c6 = vcu & 63; const int i0 = 0;
    __syncthreads();
    {
        const int i4 = 4 * tid; f32x4 v8[8];
#pragma unroll
        for (int v = 0; v < 2; ++v) { const int r5 = v ? 4 : bb;
            v8[v * 3 + 0] = *(const f32x4*)(mod + ((size_t)layer * 5 + r5) * 12288 + gch * 2048 + i4);
            v8[v * 3 + 1] = *(const f32x4*)(mod + ((size_t)nlayer * 5 + r5) * 12288 + nsh * 2048 + i4);
            v8[v * 3 + 2] = *(const f32x4*)(mod + ((size_t)nlayer * 5 + r5) * 12288 + (nsh + 1) * 2048 + i4); }
        v8[6] = *(const f32x4*)(lg + i4); v8[7] = *(const f32x4*)(lb + i4);
#pragma unroll
        for (int v = 0; v < 8; ++v) *(LAS f32x4*)(V + v * 2048 + i4) = v8[v]; }

    __syncthreads();
    for (int k = wave; k < rpc; k += 2 * NWAVES) {
        f32x4 z[2][8]; int rr[2], tt[2]; bool ok[2];
#pragma unroll
        for (int q = 0; q < 2; ++q) { const int kk = k + q * NWAVES; ok[q] = kk < rpc; const int ii = ok[q] ? kk : 0;
            const int t = (ii < 64) ? c6 * 64 + ii : SEQ + c6 * 4 + (ii - 64); const int r = bb * TPB + t; rr[q] = r; tt[q] = t;
            const LAS float* gate = V + (t < SEQ ? 0 : 3) * 2048;
            const float* xrow = (t < SEQ) ? a.in[I_X] + ((size_t)bb * SEQ + t) * D : a.in[I_CTX] + ((size_t)bb * CTXL + (t - SEQ)) * D; const h16* hrow = H + (size_t)r * D;
            f32x4 hv[8], yv[8];
            if (FIRST) {
#pragma unroll
                for (int j = 0; j < 8; ++j) hv[j] = *(const f32x4*)(xrow + 4 * lane + 256 * j);
            } else {
#pragma unroll
                for (int j = 0; j < 8; ++j) hv[j] = __builtin_convertvector(*(const h16x4*)(hrow + 4 * lane + 256 * j), f32x4);
            }
            if (ysplit && t >= SEQ) { const float* yp = YP + ((size_t)bb * CTXL + (t - SEQ)) * D + 4 * lane;
#pragma unroll
                for (int jh = 0; jh < 2; ++jh) { f32x4 p[4][4];
#pragma unroll
                    for (int jj = 0; jj < 4; ++jj)
#pragma unroll
                        for (int s4 = 0; s4 < 4; ++s4) p[jj][s4] = *(const f32x4*)(yp + 256 * (4 * jh + jj) + (size_t)s4 * 1024 * D);
#pragma unroll
                    for (int jj = 0; jj < 4; ++jj) yv[4 * jh + jj] = (p[jj][0] + p[jj][1]) + (p[jj][2] + p[jj][3]); }
            } else {
#pragma unroll
                for (int j = 0; j < 8; ++j) { const v2u yw = *(const v2u*)(Y + (size_t)r * D + 4 * lane + 256 * j); yv[j] = (f32x4){bflo(yw.x), bfhi(yw.x), bflo(yw.y), bfhi(yw.y)}; }
            }
#pragma unroll
            for (int j = 0; j < 8; ++j) { const int c = 4 * lane + 256 * j; const f32x4 g = *(const LAS f32x4*)(gate + c);
                z[q][j] = hv[j] * ALPHA + g * yv[j]; } }
        float s0 = 0.f, s1 = 0.f;
#pragma unroll
        for (int j = 0; j < 8; ++j) { s0 += (z[0][j][0] + z[0][j][1]) + (z[0][j][2] + z[0][j][3]); s1 += (z[1][j][0] + z[1][j][1]) + (z[1][j][2] + z[1][j][3]); }
#pragma unroll
        for (int o = 1; o < 64; o <<= 1) { s0 += shx(s0, o, lane); s1 += shx(s1, o, lane); }
        const float m0 = s0 * (1.0f / D), m1 = s1 * (1.0f / D); float q0 = 0.f, q1 = 0.f;
#pragma unroll
        for (int j = 0; j < 8; ++j) { z[0][j] = z[0][j] - m0; z[1][j] = z[1][j] - m1;
            q0 += (z[0][j][0] * z[0][j][0] + z[0][j][1] * z[0][j][1]) + (z[0][j][2] * z[0][j][2] + z[0][j][3] * z[0][j][3]);
            q1 += (z[1][j][0] * z[1][j][0] + z[1][j][1] * z[1][j][1]) + (z[1][j][2] * z[1][j][2] + z[1][j][3] * z[1][j][3]); }
#pragma unroll
        for (int o = 1; o < 64; o <<= 1) { q0 += shx(q0, o, lane); q1 += shx(q1, o, lane); }
        const float rs[2] = {rsqrtf(q0 * (1.0f / D) + LN_EPS), rsqrtf(q1 * (1.0f / D) + LN_EPS)};
#pragma unroll
        for (int q = 0; q < 2; ++q) { if (!ok[q]) continue; const int r = rr[q], t = tt[q]; const LAS float* nm = V + ((t < SEQ ? 0 : 3) + 1) * 2048;
#pragma unroll
            for (int j = 0; j < 8; ++j) { const int c = 4 * lane + 256 * j; const f32x4 gg = *(const LAS f32x4*)(V + 6 * 2048 + c), bv = *(const LAS f32x4*)(V + 7 * 2048 + c);
                const f32x4 hn = z[q][j] * rs[q] * gg + bv;
                if (final) { if (!dry) *(f32x4*)(a.out + ((size_t)bb * SEQ + t) * D + c) = hn; else *(h16x4*)(Hw + (size_t)r * D + c) = __builtin_convertvector(hn, h16x4); }
                else { *(h16x4*)(Hw + (size_t)r * D + c) = __builtin_convertvector(hn, h16x4); const f32x4 sh = *(const LAS f32x4*)(nm + c), sc = *(const LAS f32x4*)(nm + 2048 + c); const f32x4 uu = hn * (1.0f + sc) + sh;
                    v2u w; w.x = cvt_pk_bf16(uu[0], uu[1]); w.y = cvt_pk_bf16(uu[2], uu[3]); *(v2u*)(U + (size_t)r * D + c) = w; } } }
    }
    __syncthreads();
}
__device__ __forceinline__ void phase_ln(const Args& a, int layer, int which, LAS unsigned char* lds, int tid, int lane, int wave, int vcu, int G, bool dry = false) {
    if (layer == 0 && which == 0) phase_ln_t<true>(a, layer, which, lds, tid, lane, wave, vcu, G, dry); else phase_ln_t<false>(a, layer, which, lds, tid, lane, wave, vcu, G, dry);
}
__device__ __forceinline__ void phase_mla_norm(const Args& a, int ml, int lane, int wave, int vcu, int G) {
    const int gw = vcu * NWAVES + wave, NGW = G * NWAVES;
    const float* C = (const float*)(a.ws + WS_CQKV); bf16* CQN = (bf16*)(a.ws + WS_CQN); bf16* CKVN = (bf16*)(a.ws + WS_CKVN); bf16* KR = (bf16*)(a.ws + WS_KR);
    const float* gq = a.in[I_MGQ] + (size_t)ml * 512; const float* gkv = a.in[I_MGKV] + (size_t)ml * 512; const f32x2* acs = (const f32x2*)(a.ws + WS_ACS);
    for (int r = gw; r < M; r += NGW) { const float* row = C + (size_t)r * 1280; const int b = r / TPB, t = r - b * TPB;
        f32x4 q0 = *(const f32x4*)(row + 4 * lane), q1 = *(const f32x4*)(row + 256 + 4 * lane), k0 = *(const f32x4*)(row + 512 + 4 * lane), k1 = *(const f32x4*)(row + 768 + 4 * lane);
        float sq = (q0[0] * q0[0] + q0[1] * q0[1]) + (q0[2] * q0[2] + q0[3] * q0[3]) + (q1[0] * q1[0] + q1[1] * q1[1]) + (q1[2] * q1[2] + q1[3] * q1[3]);
        float sk = (k0[0] * k0[0] + k0[1] * k0[1]) + (k0[2] * k0[2] + k0[3] * k0[3]) + (k1[0] * k1[0] + k1[1] * k1[1]) + (k1[2] * k1[2] + k1[3] * k1[3]);
        const float rq = rsqrtf(wave_sum(sq, lane) * (1.0f / 512.0f) + RMS_EPS), rk = rsqrtf(wave_sum(sk, lane) * (1.0f / 512.0f) + RMS_EPS);
        const f32x4 g0 = *(const f32x4*)(gq + 4 * lane), g1 = *(const f32x4*)(gq + 256 + 4 * lane), h0 = *(const f32x4*)(gkv + 4 * lane), h1 = *(const f32x4*)(gkv + 256 + 4 * lane);
        q0 = q0 * rq * g0; q1 = q1 * rq * g1; k0 = k0 * rk * h0; k1 = k1 * rk * h1;
        v2u w; w.x = cvt_pk_bf16(q0[0], q0[1]); w.y = cvt_pk_bf16(q0[2], q0[3]); *(v2u*)(CQN + (size_t)r * 512 + 4 * lane) = w;
        w.x = cvt_pk_bf16(q1[0], q1[1]); w.y = cvt_pk_bf16(q1[2], q1[3]); *(v2u*)(CQN + (size_t)r * 512 + 256 + 4 * lane) = w;
        w.x = cvt_pk_bf16(k0[0], k0[1]); w.y = cvt_pk_bf16(k0[2], k0[3]); *(v2u*)(CKVN + (size_t)r * 512 + 4 * lane) = w;
        w.x = cvt_pk_bf16(k1[0], k1[1]); w.y = cvt_pk_bf16(k1[2], k1[3]); *(v2u*)(CKVN + (size_t)r * 512 + 256 + 4 * lane) = w;
        if (lane < 32) { f32x2 kr = *(const f32x2*)(row + 1024 + 2 * lane);
            if (t < SEQ) { const f32x2 cs = acs[(size_t)t * 32 + lane]; kr = (f32x2){kr[0] * cs[0] - kr[1] * cs[1], kr[0] * cs[1] + kr[1] * cs[0]}; }
            *(unsigned*)(KR + (size_t)r * 64 + 2 * lane) = cvt_pk_bf16(kr[0], kr[1]); } }
}

constexpr int RQ_RS = 528, RV_RS = 288, RP_RS = 144;
__device__ __forceinline__ int koff(int row, int ch32) { const int f = ((row & 3) << 2) | ((row >> 2) & 3); return (ch32 >> 4) * 16384 + row * 256 + (((ch32 & 15) ^ f) << 4); }
constexpr int RL_Q = 0, RL_K = RL_Q + 64 * RQ_RS, RL_V = RL_K + 32768, RL_P = RL_V + 64 * RV_RS, RL_OT = RL_P + 64 * RP_RS, RL_FAC = RL_OT + 64 * 272, RL_END = RL_FAC + 4 * 64 * 4;
constexpr int ROT_RS = 272;
static_assert(RL_END <= RING_BYTES, "retention LDS map");
template <int OFF> __device__ __forceinline__ s16x4 tr_read(int addr) {
    s16x4 r; asm volatile("ds_read_b64_tr_b16 %0, %1 offset:%2" : "=&v"(r) : "v"(addr), "i"(OFF) : "memory"); return r;
}
template <int CTL> __device__ __forceinline__ float dpp_ctl(float v) { return __int_as_float(__builtin_amdgcn_update_dpp(0, __float_as_int(v), CTL, 0xf, 0xf, false)); }
template <int N> __device__ __forceinline__ float dpp_ror(float v) { return __int_as_float(__builtin_amdgcn_update_dpp(0, __float_as_int(v), 0x120 + N, 0xf, 0xf, false)); }
__device__ __forceinline__ bf16x8 cat4(s16x4 l, s16x4 h) { return (bf16x8){l[0], l[1], l[2], l[3], h[0], h[1], h[2], h[3]}; }

__device__ __forceinline__ void phase_ret_scan(const Args& a, int rl, LAS unsigned char* lds, int tid, int lane, int wave, int vcu, int G) {
    const bf16* Qg = (const bf16*)(a.ws + WS_RQ); const bf16* Kg = (const bf16*)(a.ws + WS_RK); const bf16* Vg = (const bf16*)(a.ws + WS_RV);
    bf16* OFg = (bf16*)(a.ws + WS_OF); bf16* OBg = (bf16*)(a.ws + WS_OB); f32x2* part = (f32x2*)(a.ws + WS_PART);
    LAS float* fac = (LAS float*)(lds + RL_FAC);
    const int ldsb = (int)(uintptr_t)lds;
    for (int item = vcu; item < 256; item += G) {
        const int slice = item & 3, dir = (item >> 2) & 1, h = (item >> 3) & 7, b = item >> 6;
        __syncthreads();
        if (tid < 64) { const float x = a.in[I_RDEC][(size_t)rl * 16 + dir * 8 + h]; const float lg = -log1pf(expf(-x));
            const int i = tid;
            fac[i] = dir ? expf(-lg * (float)i) : expf(lg * (float)(i - 63));
            fac[64 + i] = dir ? expf(lg * (float)(64 - i)) : expf(lg * (float)(i + 1));
            fac[128 + i] = dir ? expf(lg * (float)i) : expf(lg * (float)(63 - i));
            if (i == 0) fac[192] = expf(lg * 64.0f); }
        __syncthreads();
#define RET_ROWBASE(n) ({ int _cc, _rb; if ((n) < 4) { _cc = dir ? 3 - (n) : (n); _rb = b * TPB + SEQ + 64 * _cc; } else { _cc = dir ? 63 - ((n) - 4) : (n) - 4; _rb = b * TPB + 64 * _cc; } _rb; })
        if (wave < 4) {
            int lane_c = lane; asm volatile("" : "+v"(lane_c));
            const int g = lane_c >> 4, c16 = lane_c & 15, q4 = c16 >> 2, p4 = lane_c & 3;
            const int cw = wave, sa = cw >> 1, sb = cw & 1;
            const float cdec = fac[192];
            const float pf[2] = {fac[16 * (2 * sa) + c16], fac[16 * (2 * sa + 1) + c16]};
            int kb[4][2];
#pragma unroll
            for (int u = 0; u < 4; ++u)
#pragma unroll
                for (int t = 0; t < 2; ++t) { const int row = 8 * g + 4 * t + q4, f = ((row & 3) << 2) | ((row >> 2) & 3); kb[u][t] = ldsb + RL_K + row * 256 + (((4 * u + p4) ^ f) << 4); }
            pg8::f32x4 S[2][16];
#pragma unroll
            for (int nb = 0; nb < 2; ++nb)
#pragma unroll
                for (int T = 0; T < 16; ++T) S[nb][T] = (pg8::f32x4){0.f, 0.f, 0.f, 0.f};
            for (int n = 0; n < 68; ++n) {
                __syncthreads();
                { pg8::f32x4 sc[2][2];
#pragma unroll
                  for (int ti = 0; ti < 2; ++ti)
#pragma unroll
                      for (int tj = 0; tj < 2; ++tj) sc[ti][tj] = (pg8::f32x4){0.f, 0.f, 0.f, 0.f};
                  bf16x8 fq_[2][2], fa_[2][2];
#pragma unroll
                  for (int t = 0; t < 2; ++t) { fq_[0][t] = *(const LAS bf16x8*)(lds + RL_Q + (16 * (2 * sa + t) + c16) * RQ_RS + (8 * g) * 2); fa_[0][t] = *(const LAS bf16x8*)(lds + RL_K + koff(16 * (2 * sb + t) + c16, g)); }
#pragma unroll
                  for (int s = 0; s < 8; ++s) {
                      if (s < 7) {
#pragma unroll
                          for (int t = 0; t < 2; ++t) { fq_[(s + 1) & 1][t] = *(const LAS bf16x8*)(lds + RL_Q + (16 * (2 * sa + t) + c16) * RQ_RS + (32 * (s + 1) + 8 * g) * 2);
                              fa_[(s + 1) & 1][t] = *(const LAS bf16x8*)(lds + RL_K + koff(16 * (2 * sb + t) + c16, 4 * (s + 1) + g)); } }
#pragma unroll
                      for (int ti = 0; ti < 2; ++ti)
#pragma unroll
                          for (int tj = 0; tj < 2; ++tj) sc[ti][tj] = __builtin_amdgcn_mfma_f32_16x16x32_bf16(fa_[s & 1][tj], fq_[s & 1][ti], sc[ti][tj], 0, 0, 0); }
#pragma unroll
                  for (int ti = 0; ti < 2; ++ti) { const int i = 16 * (2 * sa + ti) + c16;
#pragma unroll
                      for (int tj = 0; tj < 2; ++tj) { const pg8::f32x4 scv = sc[ti][tj]; const int j0 = 16 * (2 * sb + tj) + 4 * g; float pv[4];
#pragma unroll
                          for (int r = 0; r < 4; ++r) { const int j = j0 + r; const bool keep = dir ? (j >= i) : (j <= i); pv[r] = keep ? scv[r] * pf[ti] : 0.f; }
                          v2u w; w.x = cvt_pk_bf16(pv[0], pv[1]); w.y = cvt_pk_bf16(pv[2], pv[3]);
                          *(LAS v2u*)(lds + RL_P + i * RP_RS + j0 * 2) = w; } } }
                pg8::f32x4 o[2][4];
#pragma unroll
                for (int nb = 0; nb < 2; ++nb)
#pragma unroll
                    for (int ib = 0; ib < 4; ++ib) o[nb][ib] = (pg8::f32x4){0.f, 0.f, 0.f, 0.f};
                { bf16x8 aq[2][4];
#pragma unroll
                  for (int ib = 0; ib < 4; ++ib) aq[0][ib] = *(const LAS bf16x8*)(lds + RL_Q + (16 * ib + c16) * RQ_RS + (8 * g) * 2);
#pragma unroll
                  for (int s = 0; s < 8; ++s) {
                      if (s < 7) {
#pragma unroll
                          for (int ib = 0; ib < 4; ++ib) aq[(s + 1) & 1][ib] = *(const LAS bf16x8*)(lds + RL_Q + (16 * ib + c16) * RQ_RS + (32 * (s + 1) + 8 * g) * 2); }
                      bf16x8 bs[2];
#pragma unroll
                      for (int nb = 0; nb < 2; ++nb) { v4u bw; bw.x = cvt_pk_bf16(S[nb][2 * s][0], S[nb][2 * s][1]); bw.y = cvt_pk_bf16(S[nb][2 * s][2], S[nb][2 * s][3]); bw.z = cvt_pk_bf16(S[nb][2 * s + 1][0], S[nb][2 * s + 1][1]); bw.w = cvt_pk_bf16(S[nb][2 * s + 1][2], S[nb][2 * s + 1][3]);
                          bs[nb] = __builtin_bit_cast(bf16x8, bw); }
#pragma unroll
                      for (int ib = 0; ib < 4; ++ib)
#pragma unroll
                          for (int nb = 0; nb < 2; ++nb) o[nb][ib] = __builtin_amdgcn_mfma_f32_16x16x32_bf16(aq[s & 1][ib], bs[nb], o[nb][ib], 0, 0, 0); } }
#pragma unroll
                for (int ib = 0; ib < 4; ++ib)
#pragma unroll
                    for (int r = 0; r < 4; ++r) { const float qf = fac[64 + 16 * ib + 4 * g + r]; o[0][ib][r] *= qf; o[1][ib][r] *= qf; }
                bf16x8 bv[2][2];
                { const int va = ldsb + RL_V + (8 * g + q4) * RV_RS + (32 * cw + 4 * p4) * 2;
                  const s16x4 l0 = tr_read<0>(va), h0 = tr_read<4 * RV_RS>(va), l1 = tr_read<32 * RV_RS>(va), h1 = tr_read<36 * RV_RS>(va);
                  const s16x4 m0 = tr_read<32>(va), n0 = tr_read<32 + 4 * RV_RS>(va), m1 = tr_read<32 + 32 * RV_RS>(va), n1 = tr_read<32 + 36 * RV_RS>(va);
                  LDS_WAIT(); SBAR();
                  bv[0][0] = cat4(l0, h0); bv[0][1] = cat4(l1, h1); bv[1][0] = cat4(m0, n0); bv[1][1] = cat4(m1, n1); }
                {
#define KTR(T, ks, t) tr_read<(ks) * 8192 + ((T) >> 3) * 16384 + ((T) & 1) * 8>(kb[((T) >> 1) & 3][t])
#define KLOAD(T, L0, H0, L1, H1) do { L0 = KTR(T, 0, 0); H0 = KTR(T, 0, 1); L1 = KTR(T, 1, 0); H1 = KTR(T, 1, 1); } while (0)
#define KMMA(T, L0, H0, L1, H1) do { const bf16x8 A0_ = cat4(L0, H0), A1_ = cat4(L1, H1); \
                      pg8::f32x4 ac0_ = S[0][T] * cdec, ac1_ = S[1][T] * cdec; \
                      ac0_ = __builtin_amdgcn_mfma_f32_16x16x32_bf16(A0_, bv[0][0], ac0_, 0, 0, 0); ac1_ = __builtin_amdgcn_mfma_f32_16x16x32_bf16(A0_, bv[1][0], ac1_, 0, 0, 0); \
                      ac0_ = __builtin_amdgcn_mfma_f32_16x16x32_bf16(A1_, bv[0][1], ac0_, 0, 0, 0); ac1_ = __builtin_amdgcn_mfma_f32_16x16x32_bf16(A1_, bv[1][1], ac1_, 0, 0, 0); \
                      S[0][T] = ac0_; S[1][T] = ac1_; } while (0)
                  s16x4 xa0, xa1, xa2, xa3, ya0, ya1, ya2, ya3;
                  KLOAD(0, xa0, xa1, xa2, xa3);
#define KGROUP(T, LAST) do { KLOAD(T + 1, ya0, ya1, ya2, ya3); \
                      asm volatile("s_waitcnt lgkmcnt(4)" ::: "memory"); SBAR(); \
                      KMMA(T, xa0, xa1, xa2, xa3); \
                      if (!(LAST)) { KLOAD(((T) + 2) & 15, xa0, xa1, xa2, xa3); asm volatile("s_waitcnt lgkmcnt(4)" ::: "memory"); } \
                      else asm volatile("s_waitcnt lgkmcnt(0)" ::: "memory"); \
                      SBAR(); \
                      KMMA(T + 1, ya0, ya1, ya2, ya3); } while (0)
                  KGROUP(0, false); KGROUP(2, false); KGROUP(4, false); KGROUP(6, false); KGROUP(8, false); KGROUP(10, false); KGROUP(12, false); KGROUP(14, true);
#undef KGROUP
#undef KTR
#undef KLOAD
#undef KMMA
                }
                __syncthreads();
#pragma unroll
                for (int ks = 0; ks < 2; ++ks)
#pragma unroll
                    for (int ib = 0; ib < 4; ++ib) { const bf16x8 ap = *(const LAS bf16x8*)(lds + RL_P + (16 * ib + c16) * RP_RS + (32 * ks + 8 * g) * 2);
                        o[0][ib] = __builtin_amdgcn_mfma_f32_16x16x32_bf16(ap, bv[0][ks], o[0][ib], 0, 0, 0); o[1][ib] = __builtin_amdgcn_mfma_f32_16x16x32_bf16(ap, bv[1][ks], o[1][ib], 0, 0, 0); }
#pragma unroll
                for (int nb = 0; nb < 2; ++nb)
#pragma unroll
                    for (int ib = 0; ib < 4; ++ib)
#pragma unroll
                        for (int r = 0; r < 4; ++r) *(LAS unsigned short*)(lds + RL_OT + (16 * ib + 4 * g + r) * ROT_RS + (32 * cw + 16 * nb + c16) * 2) = __builtin_bit_cast(unsigned short, (__bf16)o[nb][ib][r]);
            }
            __syncthreads();
        } else {
            int lt_ = tid - 256; asm volatile("" : "+v"(lt_)); const int lt = lt_; bf16* Og = dir ? OBg : OFg;
            const int qrow = lt >> 5, qch = lt & 31, vrow = lt >> 4, vch = lt & 15;
            v4u sq[8], sk[8], sv[4];
#define RET_LOAD(n) do { const int _rb = RET_ROWBASE(n); \
            _Pragma("unroll") for (int e = 0; e < 8; ++e) { sq[e] = *(const v4u*)(Qg + (size_t)(_rb + qrow + 8 * e) * 2048 + h * 256 + qch * 8); sk[e] = *(const v4u*)(Kg + (size_t)(_rb + qrow + 8 * e) * 2048 + h * 256 + qch * 8); } \
            _Pragma("unroll") for (int e = 0; e < 4; ++e) sv[e] = *(const v4u*)(Vg + (size_t)(_rb + vrow + 16 * e) * 4096 + h * 512 + slice * 128 + vch * 8); } while (0)
#define RET_STAGE() do { \
            _Pragma("unroll") for (int e = 0; e < 8; ++e) { *(LAS v4u*)(lds + RL_Q + (qrow + 8 * e) * RQ_RS + qch * 16) = sq[e]; *(LAS v4u*)(lds + RL_K + koff(qrow + 8 * e, qch)) = sk[e]; } \
            _Pragma("unroll") for (int e = 0; e < 4; ++e) { const float vf = fac[128 + vrow + 16 * e]; v4u w; \
                w.x = cvt_pk_bf16(bflo(sv[e].x) * vf, bfhi(sv[e].x) * vf); w.y = cvt_pk_bf16(bflo(sv[e].y) * vf, bfhi(sv[e].y) * vf); \
                w.z = cvt_pk_bf16(bflo(sv[e].z) * vf, bfhi(sv[e].z) * vf); w.w = cvt_pk_bf16(bflo(sv[e].w) * vf, bfhi(sv[e].w) * vf); \
                *(LAS v4u*)(lds + RL_V + (vrow + 16 * e) * RV_RS + vch * 16) = w; } } while (0)
#define RET_OSTORE(n) do { const int rowprev = RET_ROWBASE(n); \
            _Pragma("unroll") for (int e = 0; e < 2; ++e) { const int orow = (lt >> 3) + 32 * e, ocg = lt & 7; const LAS v4u* op = (const LAS v4u*)(lds + RL_OT + orow * ROT_RS + ocg * 32); const v4u w0 = op[0], w1 = op[1]; \
              float s1 = 0.f, s2 = 0.f; \
              _Pragma("unroll") for (int q = 0; q < 4; ++q) { const float a0 = bflo(w0[q]), a1 = bfhi(w0[q]), b0 = bflo(w1[q]), b1 = bfhi(w1[q]); s1 += (a0 + a1) + (b0 + b1); s2 += (a0 * a0 + a1 * a1) + (b0 * b0 + b1 * b1); } \
              s1 += dpp_ctl<0xB1>(s1); s2 += dpp_ctl<0xB1>(s2); s1 += dpp_ctl<0x4E>(s1); s2 += dpp_ctl<0x4E>(s2); s1 += dpp_ctl<0x141>(s1); s2 += dpp_ctl<0x141>(s2); \
              v4u* gp = (v4u*)(Og + (size_t)(rowprev + orow) * 4096 + h * 512 + slice * 128 + ocg * 16); gp[0] = w0; gp[1] = w1; \
              if (ocg == 0) part[(size_t)(rowprev + orow) * 64 + h * 8 + dir * 4 + slice] = (f32x2){s1, s2}; } } while (0)
            RET_LOAD(0);
            RET_STAGE();
            for (int n = 0; n < 68; ++n) {
                __syncthreads();
                if (n + 1 < 68) RET_LOAD(n + 1);
                if (n > 0) RET_OSTORE(n - 1);
                __syncthreads();
                if (n + 1 < 68) RET_STAGE();
            }
            __syncthreads();
            RET_OSTORE(67);
#undef RET_LOAD
#undef RET_STAGE
#undef RET_OSTORE
        }
#undef RET_ROWBASE
    }
}

namespace att {
constexpr int KVBLK = 64, QBLK = 32;
constexpr int LDQ = 3072, LDKN = 2048, LDKR = 64, LDV = 2048, LDO = 2048;
constexpr float SCALE = MLA_SCALE;
constexpr float THR = 8.f;
constexpr int SHM_V = KVBLK * 128 * 2, SHM_K = KVBLK * 128 * 2, SHM_R = KVBLK * 64 * 2;
constexpr int L_V = 0, L_K = 2 * SHM_V, L_R = L_K + 2 * SHM_K, L_WS = L_R + 2 * SHM_R, L_END = L_WS + NWAVES * 64 * 4;
static_assert(L_END <= RING_BYTES, "attention LDS map");
#define KSWZ(row, colB) ((row) * 256 + ((colB) ^ (((row) & 7) << 4)))
#define RSWZ(row, colB) ((row) * 128 + ((colB) ^ (((row) & 7) << 4)))
__device__ __forceinline__ int crow(int r, int hi) { return (r & 3) + 8 * (r >> 2) + 4 * hi; }
__device__ __forceinline__ void partialSM(f32x16& p0, f32x16& p1, float& m_reg, float& mn, float& alpha) {
  constexpr float C = SCALE * 1.4426950408889634f;
  float pmax = p0[0];
#pragma unroll
  for (int r = 1; r < 16; ++r) pmax = fmaxf(pmax, p0[r]);
#pragma unroll
  for (int r = 0; r < 16; ++r) pmax = fmaxf(pmax, p1[r]);
  { auto rr = __builtin_amdgcn_permlane32_swap(__float_as_uint(pmax), __float_as_uint(pmax), false, false);
    pmax = fmaxf(__uint_as_float(rr[0]), __uint_as_float(rr[1])); }
  if (__builtin_expect(__all(pmax - m_reg <= THR / SCALE), 1)) { mn = m_reg; alpha = 1.f; }
  else { mn = fmaxf(m_reg, pmax); alpha = __builtin_amdgcn_exp2f((m_reg - mn) * C); m_reg = mn; }
  const float mnC = -mn * C;
#pragma unroll
  for (int r = 0; r < 16; ++r) p0[r] = fmaf(p0[r], C, mnC);
#pragma unroll
  for (int r = 0; r < 16; ++r) p1[r] = fmaf(p1[r], C, mnC);
#pragma unroll
  for (int r = 0; r < 16; ++r) p0[r] = __builtin_amdgcn_exp2f(p0[r]);
}
__device__ __forceinline__ void finishSM(f32x16& p0, f32x16& p1, float alpha, float& l_reg, bf16x8& pa0, bf16x8& pa1, bf16x8& pa2, bf16x8& pa3) {
#pragma unroll
  for (int r = 0; r < 16; ++r) p1[r] = __builtin_amdgcn_exp2f(p1[r]);
  float ps = 0;
#pragma unroll
  for (int r = 0; r < 16; ++r) ps += p0[r];
#pragma unroll
  for (int r = 0; r < 16; ++r) ps += p1[r];
  { auto rr = __builtin_amdgcn_permlane32_swap(__float_as_uint(ps), __float_as_uint(ps), false, false);
    ps = __uint_as_float(rr[0]) + __uint_as_float(rr[1]); }
  l_reg = l_reg * alpha + ps;
#define PK4(P, BASE, OUT) do { unsigned a0 = cvt_pk_bf16(P[BASE + 0], P[BASE + 1]), a1 = cvt_pk_bf16(P[BASE + 2], P[BASE + 3]);   \
    unsigned b0 = cvt_pk_bf16(P[BASE + 4], P[BASE + 5]), b1 = cvt_pk_bf16(P[BASE + 6], P[BASE + 7]);                              \
    auto r0 = __builtin_amdgcn_permlane32_swap(a0, b0, false, false); auto r1 = __builtin_amdgcn_permlane32_swap(a1, b1, false, false); \
    v4u w = {r0[0], r1[0], r0[1], r1[1]}; OUT = __builtin_bit_cast(bf16x8, w); } while (0)
  PK4(p0, 0, pa0); PK4(p0, 8, pa1); PK4(p1, 0, pa2); PK4(p1, 8, pa3);
#undef PK4
}
__device__ __forceinline__ void qkt(f32x16& p0, f32x16& p1, const LAS unsigned char* Ks, const LAS unsigned char* Rs, const bf16x8 (&qr)[12], int r32, int hi) {
  p0 = f32x16{}; p1 = f32x16{};
#pragma unroll
  for (int d0 = 0; d0 < 8; ++d0) { const int cb = (d0 * 16 + hi * 8) * 2;
    const bf16x8 b0 = *(const LAS bf16x8*)(Ks + KSWZ(r32, cb));
    const bf16x8 b1 = *(const LAS bf16x8*)(Ks + KSWZ(32 + r32, cb));
    p0 = __builtin_amdgcn_mfma_f32_32x32x16_bf16(b0, qr[d0], p0, 0, 0, 0);
    p1 = __builtin_amdgcn_mfma_f32_32x32x16_bf16(b1, qr[d0], p1, 0, 0, 0); }
#pragma unroll
  for (int d0 = 0; d0 < 4; ++d0) { const int cb = (d0 * 16 + hi * 8) * 2;
    const bf16x8 b0 = *(const LAS bf16x8*)(Rs + RSWZ(r32, cb));
    const bf16x8 b1 = *(const LAS bf16x8*)(Rs + RSWZ(32 + r32, cb));
    p0 = __builtin_amdgcn_mfma_f32_32x32x16_bf16(b0, qr[8 + d0], p0, 0, 0, 0);
    p1 = __builtin_amdgcn_mfma_f32_32x32x16_bf16(b1, qr[8 + d0], p1, 0, 0, 0); }
}
__device__ __forceinline__ int v_st(int k, int c) { const int kk = (k & ~0xC) | ((k & 4) << 1) | ((k & 8) >> 1); return ((kk >> 3) * 4 + (c >> 5)) * 512 + ((kk & 7) * 32 + (c & 31)) * 2; }
__device__ __forceinline__ int v_rd_base(int lane) { return ((lane & 3) << 3) | (((lane >> 2) & 3) << 6) | (((lane >> 4) & 1) << 5) | (((lane >> 5) & 1) << 8); }
constexpr int v_rd_off(int d0, int ks, int half) { return d0 * 512 + ks * 4096 + half * 2048; }
template <int D0> __device__ __forceinline__ void pv_one(f32x16& od, int vb, bf16x8 pa0, bf16x8 pa1, bf16x8 pa2, bf16x8 pa3) {
  const s16x4 l0 = tr_read<v_rd_off(D0, 0, 0)>(vb), h0 = tr_read<v_rd_off(D0, 0, 1)>(vb), l1 = tr_read<v_rd_off(D0, 1, 0)>(vb), h1 = tr_read<v_rd_off(D0, 1, 1)>(vb);
  const s16x4 l2 = tr_read<v_rd_off(D0, 2, 0)>(vb), h2 = tr_read<v_rd_off(D0, 2, 1)>(vb), l3 = tr_read<v_rd_off(D0, 3, 0)>(vb), h3 = tr_read<v_rd_off(D0, 3, 1)>(vb);
  asm volatile("s_waitcnt lgkmcnt(0)" ::: "memory"); SBAR();
  od = __builtin_amdgcn_mfma_f32_32x32x16_bf16(pa0, cat4(l0, h0), od, 0, 0, 0);
  od = __builtin_amdgcn_mfma_f32_32x32x16_bf16(pa1, cat4(l1, h1), od, 0, 0, 0);
  od = __builtin_amdgcn_mfma_f32_32x32x16_bf16(pa2, cat4(l2, h2), od, 0, 0, 0);
  od = __builtin_amdgcn_mfma_f32_32x32x16_bf16(pa3, cat4(l3, h3), od, 0, 0, 0);
}
__device__ __forceinline__ void pv_d0(f32x16* o, int vb, bf16x8 pa0, bf16x8 pa1, bf16x8 pa2, bf16x8 pa3) {
  pv_one<0>(o[0], vb, pa0, pa1, pa2, pa3); pv_one<1>(o[1], vb, pa0, pa1, pa2, pa3); pv_one<2>(o[2], vb, pa0, pa1, pa2, pa3); pv_one<3>(o[3], vb, pa0, pa1, pa2, pa3);
}
__device__ __forceinline__ void attn_body(const bf16* __restrict__ Qb, const bf16* __restrict__ Kn, const bf16* __restrict__ Kr, const bf16* __restrict__ Vh,
                                          bf16* __restrict__ Ob, int seq, LAS unsigned char* lds, int tid_in) {
  int tid_ = tid_in; asm volatile("" : "+v"(tid_));
  const int tid = tid_, wid = tid >> 6, lane = tid & 63, r32 = lane & 31, hi = lane >> 5;
  LAS unsigned char* V_lds = lds + L_V; LAS unsigned char* K_lds = lds + L_K; LAS unsigned char* R_lds = lds + L_R;
  LAS float* wsf = (LAS float*)(lds + L_WS) + wid * 64; LAS float* li_l = wsf; LAS float* al_l = wsf + 32;
  float m_reg = -1e30f, l_reg = 0; f32x16 o[4] = {}; bf16x8 qr[12];
  const bf16* Qw = Qb + (size_t)(wid * QBLK + r32) * LDQ + hi * 8;
#pragma unroll
  for (int d0 = 0; d0 < 12; ++d0) qr[d0] = *(const bf16x8*)(Qw + d0 * 16);
  const int sr = tid >> 4, sc = (tid & 15) * 8, vst0 = v_st(sr, sc), vst1 = v_st(32 + sr, sc);
  const int rr = tid >> 3, rc = (tid & 7) * 8;
  const int vb0 = (int)(uintptr_t)V_lds + v_rd_base(lane);
  bf16x8 vs0, vs1, ks0, ks1, rs0;
#define SLOAD(k0) do { vs0 = *(const bf16x8*)(Vh + (size_t)((k0) + sr) * LDV + sc); vs1 = *(const bf16x8*)(Vh + (size_t)((k0) + 32 + sr) * LDV + sc); \
    ks0 = *(const bf16x8*)(Kn + (size_t)((k0) + sr) * LDKN + sc); ks1 = *(const bf16x8*)(Kn + (size_t)((k0) + 32 + sr) * LDKN + sc); \
    rs0 = *(const bf16x8*)(Kr + (size_t)((k0) + rr) * LDKR + rc); } while (0)
#define SWRITE(b) do { *(LAS bf16x8*)(V_lds + (b) * SHM_V + vst0) = vs0; *(LAS bf16x8*)(V_lds + (b) * SHM_V + vst1) = vs1; const int kc = sc * 2; \
    *(LAS bf16x8*)(K_lds + (b) * SHM_K + KSWZ(sr, kc)) = ks0; *(LAS bf16x8*)(K_lds + (b) * SHM_K + KSWZ(32 + sr, kc)) = ks1; \
    *(LAS bf16x8*)(R_lds + (b) * SHM_R + RSWZ(rr, rc * 2)) = rs0; } while (0)
#define RESC(a) do { if (__any((a) < 1.f)) { if (hi == 0) al_l[r32] = (a); asm volatile("s_waitcnt lgkmcnt(0)" ::: "memory"); \
    _Pragma("unroll") for (int d = 0; d < 4; ++d) _Pragma("unroll") for (int r = 0; r < 16; ++r) o[d][r] *= al_l[crow(r, hi)]; } } while (0)
  f32x16 pA0, pA1, pB0, pB1; float mnA, mnB, alA, alB; bf16x8 pa0, pa1, pa2, pa3; const int NT = seq / KVBLK;
  SLOAD(0); VM_WAIT(); SWRITE(0); __syncthreads();
  qkt(pA0, pA1, K_lds, R_lds, qr, r32, hi); partialSM(pA0, pA1, m_reg, mnA, alA);
  SLOAD(KVBLK);
  VM_WAIT(); SWRITE(1); __syncthreads();
  for (int j = 1; j + 1 < NT; j += 2) {
    SBAR(); qkt(pB0, pB1, K_lds + SHM_K, R_lds + SHM_R, qr, r32, hi);
    finishSM(pA0, pA1, alA, l_reg, pa0, pa1, pa2, pa3); SBAR();
    SLOAD((j + 1) * KVBLK); SBAR();
    pv_d0(o, vb0, pa0, pa1, pa2, pa3); partialSM(pB0, pB1, m_reg, mnB, alB);
    __syncthreads(); VM_WAIT(); SWRITE(0);
    RESC(alB); __syncthreads();
    SBAR(); qkt(pA0, pA1, K_lds, R_lds, qr, r32, hi);
    finishSM(pB0, pB1, alB, l_reg, pa0, pa1, pa2, pa3); SBAR();
    SLOAD((j + 2) * KVBLK); SBAR();
    pv_d0(o, vb0 + SHM_V, pa0, pa1, pa2, pa3); partialSM(pA0, pA1, m_reg, mnA, alA);
    __syncthreads(); VM_WAIT(); SWRITE(1);
    RESC(alA); __syncthreads();
  }
  SBAR(); qkt(pB0, pB1, K_lds + SHM_K, R_lds + SHM_R, qr, r32, hi);
  finishSM(pA0, pA1, alA, l_reg, pa0, pa1, pa2, pa3); SBAR();
  pv_d0(o, vb0, pa0, pa1, pa2, pa3); partialSM(pB0, pB1, m_reg, mnB, alB);
  __syncthreads(); RESC(alB);
  finishSM(pB0, pB1, alB, l_reg, pa0, pa1, pa2, pa3); SBAR();
  pv_d0(o, vb0 + SHM_V, pa0, pa1, pa2, pa3);
  if (hi == 0) li_l[r32] = l_reg; asm volatile("s_waitcnt lgkmcnt(0)" ::: "memory");
  float rli[16];
#pragma unroll
  for (int r = 0; r < 16; ++r) rli[r] = __builtin_amdgcn_rcpf(li_l[crow(r, hi)]);
  bf16* Ow = Ob + (size_t)(wid * QBLK) * LDO;
#pragma unroll
  for (int r = 0; r < 16; ++r) { const int orow = crow(r, hi);
#pragma unroll
    for (int d0 = 0; d0 < 4; ++d0) Ow[(size_t)orow * LDO + d0 * 32 + r32] = (bf16)(cvt_pk_bf16(o[d0][r] * rli[r], 0.f) & 0xffffu); }
  __syncthreads();
#undef SLOAD
#undef SWRITE
#undef RESC
}
}

__device__ __forceinline__ void phase_attn(const Args& a, bool withctx, LAS unsigned char* lds, int tid, int vcu, int G) {
    const bf16* QB = (const bf16*)(a.ws + WS_QB); const bf16* KN = (const bf16*)(a.ws + WS_KN); const bf16* KR = (const bf16*)(a.ws + WS_KR); const bf16* VB = (const bf16*)(a.ws + WS_VB);
    bf16* AO = (bf16*)(a.ws + WS_AO);
    const int nunits = 1024 + (withctx ? 64 : 0);
    for (int u = vcu; u < nunits; u += G) {
        int b, h, qrow0, krow0, seq;
        if (u < 1024) { const int bh = u >> 4, qb = u & 15; b = bh >> 4; h = bh & 15; qrow0 = b * TPB + qb * 256; krow0 = b * TPB; seq = TPB; }
        else { const int v = u - 1024; b = v >> 4; h = v & 15; qrow0 = b * TPB + SEQ; krow0 = b * TPB + SEQ; seq = CTXL; }
        att::attn_body(QB + (size_t)qrow0 * 3072 + h * 192, KN + (size_t)krow0 * 2048 + h * 128, KR + (size_t)krow0 * 64, VB + (size_t)krow0 * 2048 + h * 128,
                       AO + (size_t)qrow0 * 2048 + h * 128, seq, lds, tid);
    }
}

constexpr int PH_PER_LAYER = 10, PH_TOTAL = 2 + DEPTH * PH_PER_LAYER;
#ifndef MK_LAUNCH_PER_PHASE
#define MK_LAUNCH_PER_PHASE 0
#endif

__global__ void __launch_bounds__(NWAVES * 64, 2) fwd(Args a) {
    extern __shared__ __attribute__((aligned(16))) unsigned char lds_raw[];
    LAS unsigned char* lds = (LAS unsigned char*)lds_raw;
    const int tid = threadIdx.x, lane = tid & 63, wave = __builtin_amdgcn_readfirstlane(tid >> 6);
    const int G = gridDim.x; const int bx = blockIdx.x; const int vcu = (G % 8 == 0) ? (bx % 8) * (G / 8) + bx / 8 : bx;
    volatile LAS unsigned* MISC = (volatile LAS unsigned*)(lds + MISC_OFF);
    for (int u = tid; u < (LDS_BYTES - LDSCTL_OFF) / 4; u += NWAVES * 64) ((LAS unsigned*)(lds + LDSCTL_OFF))[u] = 0u;
    __syncthreads();
    const int lo = a.ph_lo, hi = a.ph_hi; const bool use_bar = (hi - lo) > 1;
    XcdBarrier bar; bar.bar = (unsigned*)(a.ws + WS_CTL) + CW_BAR; bar.x = 0; bar.st = MISC + 8;
    if (use_bar) bar = xcd_barrier_post((unsigned*)(a.ws + WS_CTL) + CW_BAR, MISC + 8);
#ifndef DBLMASK
#define DBLMASK 0u
#endif
#define REP(k) (((DBLMASK >> (k)) & 1) ? 2 : 1)
#ifndef PHMASK
#define PHMASK 0xFFFFFFFFu
#endif
#define IN(k) (lo <= (k) && (k) < hi)
#define SEAM(k) do { if ((k) + 1 < hi) xcd_barrier(bar, wave); } while (0)
#define U ((const bf16*)(ws + WS_U))
#define Y ((bf16*)(ws + WS_Y))
#define FRESH_TID() int lane_l; asm volatile("v_mbcnt_lo_u32_b32 %0, -1, 0\n\tv_mbcnt_hi_u32_b32 %0, -1, %0" : "=v"(lane_l));     const int wave_l = wave, tid_l = (wave << 6) | lane_l; (void)tid_l; (void)wave_l; size_t wz_ = 0; asm volatile("" : "+s"(wz_)); Args al = a; al.ws = a.ws + wz_; unsigned char* ws = al.ws; (void)ws;     int bxl = bx, vcul = vcu; asm volatile("" : "+s"(bxl), "+s"(vcul)); (void)bxl; (void)vcul

    if (((PHMASK >> 0) & 1) && IN(0)) { for (int rep = 0; rep < REP(0); ++rep) { FRESH_TID(); phase_pro_a(al, lds, tid_l, lane_l, wave_l, vcul, G); __syncthreads(); } SEAM(0); }
    if (((PHMASK >> 1) & 1) && IN(1)) { FRESH_TID(); phase_pro_b(al, lane_l, wave_l, vcul, G); SEAM(1); }

    for (int layer = 0; layer < DEPTH; ++layer) {
        const int pb = 2 + layer * PH_PER_LAYER; const int j = layer >> 1; const bool last = (layer == DEPTH - 1);
        if ((layer & 1) == 0) {
            if (((PHMASK >> 2) & 1) && IN(pb + 0)) { FRESH_TID();
                pg8::Gemm g{U, (const bf16*)(ws + WS_WQKV) + (size_t)j * 8192 * 2048, M, 8192, 2048}; pg8::TileOrder S; S.init(NTM, 32, G, bxl, 0, 0, 32);
                EpiQKV E{(bf16*)(ws + WS_RQ), (bf16*)(ws + WS_RK), (bf16*)(ws + WS_RV), (const float*)(ws + WS_RCS)};
                for (int rep = 0; rep < REP(2); ++rep) { pg8::gemm_phase<EpiQKV, pg8::TileOrder, true, true>(lds, g, S, E, tid_l); __syncthreads(); } SEAM(pb + 0); }
            if (((PHMASK >> 3) & 1) && IN(pb + 1)) { for (int rep = 0; rep < REP(3); ++rep) { FRESH_TID(); phase_ret_scan(al, j, lds, tid_l, lane_l, wave_l, vcul, G); __syncthreads(); } SEAM(pb + 1); }
            if (((PHMASK >> 4) & 1) && IN(pb + 2)) { FRESH_TID();
                pg8::Gemm g{U, (const bf16*)(ws + WS_WG) + (size_t)j * 8192 * 2048, M, 8192, 2048}; pg8::TileOrder S; S.init(NTM, 32, G, bxl, 0, 0, 32);
                EpiGate E{(const bf16*)(ws + WS_OF), (const bf16*)(ws + WS_OB), (const float*)(ws + WS_PART), (bf16*)(ws + WS_YG)};
                for (int rep = 0; rep < REP(4); ++rep) { pg8::gemm_phase<EpiGate, pg8::TileOrder, true, true>(lds, g, S, E, tid_l); __syncthreads(); } SEAM(pb + 2); }
            if (((PHMASK >> 5) & 1) && IN(pb + 3)) { FRESH_TID();
                pg8::Gemm g{(const bf16*)(ws + WS_YG), (const bf16*)(ws + WS_WOR) + (size_t)j * 2048 * 4096, M, 2048, 4096}; pg8::TileOrder S; S.init(NTL, 8, G, bxl, 1, KSPLIT, 64);
                EpiBf E{Y, Y, 2048, 0, (float*)(ws + WS_YP)};
                for (int rep = 0; rep < REP(5); ++rep) { pg8::gemm_phase<EpiBf, pg8::TileOrder, true, true>(lds, g, S, E, tid_l); __syncthreads(); } SEAM(pb + 3); }
        } else {
            if (((PHMASK >> 6) & 1) && IN(pb + 0)) { FRESH_TID();
                pg8::Gemm g{U, (const bf16*)(ws + WS_WD) + (size_t)j * 1280 * 2048, M, 1280, 2048}; pg8::TileOrder S; S.init(NTM, 5, G, bxl, 0, 0, 32);
                EpiDQKV E{(bf16*)(ws + WS_CQN), (bf16*)(ws + WS_CKVN), (bf16*)(ws + WS_KR), (float*)(ws + WS_SSQ), (const float*)(ws + WS_ACS)};
                for (int rep = 0; rep < REP(6); ++rep) { pg8::gemm_phase<EpiDQKV, pg8::TileOrder, true, true>(lds, g, S, E, tid_l); __syncthreads(); } SEAM(pb + 0); }
            if (((PHMASK >> 8) & 1) && IN(pb + 2)) { FRESH_TID();
                { pg8::Gemm g{(const bf16*)(ws + WS_CQN), (const bf16*)(ws + WS_WUQ) + (size_t)j * 3072 * 512, M, 3072, 512}; pg8::TileOrder S; S.init(last ? NTL : NTM, 12, G, bxl, last ? 1 : 0, 0, 8);
                  EpiUQ E{(bf16*)(ws + WS_QB), (const float*)(ws + WS_ACS), (const float*)(ws + WS_SSQ)};
                  for (int rep = 0; rep < REP(8); ++rep) { pg8::gemm_phase<EpiUQ, pg8::TileOrder, true, true>(lds, g, S, E, tid_l); __syncthreads(); } }
                __syncthreads();
                { pg8::Gemm g{(const bf16*)(ws + WS_CKVN), (const bf16*)(ws + WS_WUKV) + (size_t)j * 4096 * 512, M, 4096, 512}; pg8::TileOrder S; S.init(NTM, 16, G, bxl, 0, 0, 8);
                  EpiUKV E{(bf16*)(ws + WS_KN), (bf16*)(ws + WS_VB), (const float*)(ws + WS_SSQ)};
                  for (int rep = 0; rep < REP(8); ++rep) { pg8::gemm_phase<EpiUKV, pg8::TileOrder, true, true>(lds, g, S, E, tid_l); __syncthreads(); } }
                SEAM(pb + 2); }
            if (((PHMASK >> 9) & 1) && IN(pb + 3)) { FRESH_TID(); for (int rep = 0; rep < REP(9); ++rep) phase_attn(al, !last, lds, tid_l, vcul, G); SEAM(pb + 3); }
            if (((PHMASK >> 10) & 1) && IN(pb + 4)) { FRESH_TID();
                pg8::Gemm g{(const bf16*)(ws + WS_AO), (const bf16*)(ws + WS_WOM) + (size_t)j * 2048 * 2048, M, 2048, 2048}; pg8::TileOrder S; S.init(NTL, 8, G, bxl, 1, last ? 0 : KSPLIT, 32);
                EpiBf E{Y, Y, 2048, 0, (float*)(ws + WS_YP)};
                for (int rep = 0; rep < REP(10); ++rep) { pg8::gemm_phase<EpiBf, pg8::TileOrder, true, true>(lds, g, S, E, tid_l); __syncthreads(); } SEAM(pb + 4); }
        }
        if (((PHMASK >> 11) & 1) && IN(pb + 5)) { if (REP(11) > 1) { FRESH_TID(); phase_ln(al, layer, 0, lds, tid_l, lane_l, wave_l, vcul, G, true); } FRESH_TID(); phase_ln(al, layer, 0, lds, tid_l, lane_l, wave_l, vcul, G); SEAM(pb + 5); }
        if (((PHMASK >> 12) & 1) && IN(pb + 6)) { FRESH_TID();
            pg8::Gemm g{U, (const bf16*)(ws + WS_WIN) + (size_t)layer * 11264 * 2048, M, 11264, 2048}; pg8::TileOrder S; S.init(last ? NTL : NTM, 44, G, bxl, last ? 1 : 0, 0, 32);
            EpiSwiglu E{(bf16*)(ws + WS_HID)};
#if defined(SPLIT_WIN_PROBE)
            { pg8::TileOrder S1 = S; S1.ilim = 6; pg8::gemm_phase<EpiSwiglu, pg8::TileOrder, true, true>(lds, g, S1, E, tid_l); __syncthreads(); xcd_barrier(bar, wave);
              pg8::TileOrder S2 = S; S2.ioff = 6; pg8::gemm_phase<EpiSwiglu, pg8::TileOrder, true, true>(lds, g, S2, E, tid_l); __syncthreads(); } SEAM(pb + 6); }
#else
            for (int rep = 0; rep < REP(12); ++rep) { pg8::gemm_phase<EpiSwiglu, pg8::TileOrder, true, true>(lds, g, S, E, tid_l); __syncthreads(); } SEAM(pb + 6); }
#endif
        if (((PHMASK >> 13) & 1) && IN(pb + 7)) { FRESH_TID();
            pg8::Gemm g{(const bf16*)(ws + WS_HID), (const bf16*)(ws + WS_WOUT) + (size_t)layer * 2048 * 5632, M, 2048, 5632}; pg8::TileOrder S; S.init(NTL, 8, G, bxl, 1, last ? 0 : KSPLIT, 88);
            EpiBf E{Y, Y, 2048, 0, (float*)(ws + WS_YP)};
            for (int rep = 0; rep < REP(13); ++rep) { pg8::gemm_phase<EpiBf, pg8::TileOrder, true, true>(lds, g, S, E, tid_l); __syncthreads(); } SEAM(pb + 7); }
        if (((PHMASK >> 14) & 1) && IN(pb + 8)) { if (REP(11) > 1) { FRESH_TID(); phase_ln(al, layer, 1, lds, tid_l, lane_l, wave_l, vcul, G, true); } FRESH_TID(); phase_ln(al, layer, 1, lds, tid_l, lane_l, wave_l, vcul, G); SEAM(pb + 8); }
    }
#undef IN
#undef SEAM
#undef U
#undef Y
}

extern "C" void kernel_launch(void* const* d_in, const int* in_sizes, int n_in, void* d_out, int out_size, void* d_ws, size_t ws_size, hipStream_t stream) {
    static int grid = 0;
    if (grid == 0) {
        if (n_in != 21 || ws_size < WS_END) { fprintf(stderr, "kernel_launch: need 21 inputs and %zu bytes of workspace; got %d, %zu\n", (size_t)WS_END, n_in, ws_size); grid = -1; return; }
        int dev = 0, cus = 0, per_cu = 0;
        if (hipGetDevice(&dev) != hipSuccess || hipDeviceGetAttribute(&cus, hipDeviceAttributeMultiprocessorCount, dev) != hipSuccess) { grid = -1; return; }
        if (hipFuncSetAttribute((const void*)fwd, hipFuncAttributeMaxDynamicSharedMemorySize, LDS_BYTES) != hipSuccess) { fprintf(stderr, "kernel_launch: hipFuncSetAttribute failed\n"); grid = -1; return; }
        if (hipOccupancyMaxActiveBlocksPerMultiprocessor(&per_cu, (const void*)fwd, NWAVES * 64, LDS_BYTES) != hipSuccess || per_cu < 1)
            fprintf(stderr, "kernel_launch: occupancy query reports %d workgroups per CU\n", per_cu);
        (void)hipGetLastError();
        grid = cus;
    }
    if (grid < 0) return;
    if (hipMemsetAsync((char*)d_ws + WS_CTL, 0, CTL_ZERO_BYTES, stream) != hipSuccess) return;
    Args a{};
    for (int i = 0; i < 21; ++i) a.in[i] = (const float*)d_in[i];
    a.out = (float*)d_out; a.ws = (unsigned char*)d_ws;
#if MK_LAUNCH_PER_PHASE
    for (int p = 0; p < PH_TOTAL; ++p) {
        const int pl = (p - 2) % PH_PER_LAYER, layer = (p - 2) / PH_PER_LAYER;
        if (p >= 2 && (pl == 9 || (pl == 4 && (layer & 1) == 0))) continue;
        a.ph_lo = p; a.ph_hi = p + 1;
        hipLaunchKernelGGL(fwd, dim3(grid), dim3(NWAVES * 64), LDS_BYTES, stream, a);
    }
#else
    a.ph_lo = 0; a.ph_hi = PH_TOTAL;
    hipLaunchKernelGGL(fwd, dim3(grid), dim3(NWAVES * 64), LDS_BYTES, stream, a);
#endif
    const hipError_t le = hipPeekAtLastError();
    if (le != hipSuccess) fprintf(stderr, "kernel_launch: launch failed: %s\n", hipGetErrorName(le));
}
```

```cpp
#include <hip/hip_runtime.h>
#include <cstdio>
#include <cstdint>
#define MK_LAUNCH_PER_PHASE 0
namespace pg8 {
#define PG8_LAS __attribute__((address_space(3)))
typedef unsigned short bf16_t;
typedef short bf16x8 __attribute__((ext_vector_type(8)));
typedef float f32x4 __attribute__((ext_vector_type(4)));
typedef unsigned u32x4 __attribute__((ext_vector_type(4)));
constexpr int BM = 256, BK = 64, HALF = 128, HTB = HALF * BK * 2  , STAGE_BYTES = 8 * HTB, NXCD = 8, WGM = 8;

__host__ __device__ __forceinline__ int lds_byte(int r, int c) { const int st = (r >> 4) * 2 + (c >> 5), rr = r & 15, cc = c & 31, ob = rr * 64 + cc * 2; return st * 1024 + (ob ^ (((ob >> 9) & 1) << 5)); }
__host__ __device__ __forceinline__ void stage_rc(int b, int& R, int& C) { const int st = b / 1024, sb = b % 1024, swz = sb ^ (((sb >> 9) & 1) << 5); R = (st >> 1) * 16 + swz / 64; C = (st & 1) * 32 + (swz % 64) / 2; }
__host__ __device__ __forceinline__ int perm32(int rho) { const int n = rho >> 4, i = rho & 15; return 8 * (i >> 2) + 4 * n + (i & 3); }

struct Unit { int pm, pn, k0, nt, ks; };
struct Gemm { const bf16_t* A; const bf16_t* Bt; int M, N, K; };

struct StaticOrder {
    int nM, nN, nwg, G, c;
    __host__ __device__ void init(int M, int N, int G_, int c_) { nM = M / BM; nN = N / BM; nwg = nM * nN; G = G_; c = c_; }
    __host__ __device__ bool next(int i, Unit& u) const {
        const long L = (long)i * G + c; if (L >= nwg) return false;
        int wgid = (int)L; { const int q = nwg / NXCD, r = nwg % NXCD, xcd = wgid % NXCD, off = wgid / NXCD; wgid = (xcd < r ? xcd * (q + 1) : r * (q + 1) + (xcd - r) * q) + off; }
        const int nig = WGM * nN, gid = wgid / nig, fm = gid * WGM, gsz = (nM - fm) < WGM ? (nM - fm) : WGM;
        u.pm = fm + ((wgid % nig) % gsz); u.pn = (wgid % nig) / gsz; return true;
    }
    __device__ __forceinline__ void a_ready(const Unit&) const {}
    __device__ __forceinline__ void done(const Unit&) const {}
};

__device__ __forceinline__ unsigned cvt_pk_bf16(float lo, float hi) { unsigned r; asm volatile("v_cvt_pk_bf16_f32 %0, %1, %2" : "=v"(r) : "v"(lo), "v"(hi)); return r; }
struct TileOrder {
    int nM, nN, nmain, nwg, G, c, lat, split, kt, ioff = 0, ilim = 1 << 30;
    __host__ __device__ void init(int nM_, int nN_, int G_, int c_, int lat_, int split_, int kt_) { nM = nM_; nN = nN_; nmain = nM * nN; G = G_; c = c_; lat = lat_; split = split_; kt = kt_; nwg = nmain + 4 * nN * split; }
    __host__ __device__ __forceinline__ bool next(int i, Unit& u) const {
        if (i + ioff >= ilim) return false;
        const long L = (long)(i + ioff) * G + c; if (L >= nwg) return false;
        const bool sp = L >= nmain;
        const int e = (int)L - nmain, sdiv = split > 0 ? split : 1, tile = e / sdiv, sl = e - tile * sdiv, snt = kt / sdiv;
        int wgid = sp ? 0 : (int)L; { const int q = nmain / NXCD, r = nmain % NXCD, xcd = wgid % NXCD, off = wgid / NXCD; wgid = (xcd < r ? xcd * (q + 1) : r * (q + 1) + (xcd - r) * q) + off; }
        const int nig = WGM * nN, gid = wgid / nig, fm = gid * WGM, gsz = (nM - fm) < WGM ? (nM - fm) : WGM;
        int pm = fm + ((wgid % nig) % gsz); const int pn = (wgid % nig) / gsz; if (lat) pm += pm >> 4;
        Unit r; r.pm = sp ? 17 * (tile & 3) + 16 : pm; r.pn = sp ? (tile >> 2) : pn; r.k0 = sp ? sl * snt : 0; r.nt = sp ? snt : kt; r.ks = sp ? sl : -1;
        u = r; return true;
    }
    __device__ __forceinline__ void a_ready(const Unit&) const {}
    __device__ __forceinline__ void done(const Unit&) const {}
};
template <class Epi, class Sched, bool ALIGN_EPI = false, bool SP2 = false>
__device__ __forceinline__ void gemm_phase(PG8_LAS unsigned char* lds, const Gemm g, const Sched& S, const Epi& E, int tid_in) {
    int tid_ = tid_in; asm volatile("" : "+v"(tid_));
    const int tid = tid_, wid = __builtin_amdgcn_readfirstlane(tid >> 6), lane = tid & 63, wr = wid >> 2, wc = wid & 3, fr = lane & 15, fq = lane >> 4;
    const int K = g.K;
    unsigned voffA[2], voffB[2];
#pragma unroll
    for (int i = 0; i < 2; ++i) { int R, C; stage_rc(tid * 16 + i * 8192, R, C); const int Rb = Epi::PERM ? ((R & ~31) + perm32(R & 31)) : R;
        voffA[i] = (unsigned)(R * K + C) * 2u; voffB[i] = (unsigned)(Rb * K + C) * 2u; }
    const size_t kstep = (size_t)(BK * 2);
    const size_t hstep = (size_t)HALF * K * 2;
    const size_t tstep = 2 * hstep;
    const unsigned ldsw = (unsigned)wid * 1024u;
    const int aoff = lds_byte(wr * 64 + fr, fq * 8), boff = lds_byte(wc * 32 + fr, fq * 8);
#define PG8_SA(b, h) (((b) * 2 + (h)) * HTB)
#define PG8_SB(b, h) ((4 + (b) * 2 + (h)) * HTB)
#define PG8_STAGE(bufoff, gbase, voff) do { _Pragma("unroll") for (int _i = 0; _i < 2; ++_i) \
        __builtin_amdgcn_global_load_lds((const unsigned*)((const char*)(gbase) + (voff)[_i]), (PG8_LAS unsigned*)(lds + (bufoff) + ldsw + _i * 8192), 16, 0, 0); } while (0)
#define PG8_LDA(dst, b, h) do { _Pragma("unroll") for (int m = 0; m < 4; ++m) _Pragma("unroll") for (int k = 0; k < 2; ++k) dst[m][k] = *(const PG8_LAS bf16x8*)(lds + PG8_SA(b, h) + aoff + m * 2048 + k * 1024); } while (0)
#define PG8_LDB(dst, b, h) do { _Pragma("unroll") for (int n = 0; n < 2; ++n) _Pragma("unroll") for (int k = 0; k < 2; ++k) dst[n][k] = *(const PG8_LAS bf16x8*)(lds + PG8_SB(b, h) + boff + n * 2048 + k * 1024); } while (0)
#define PG8_MMA(ai, bj, At, Bt) do { __builtin_amdgcn_s_setprio(1); _Pragma("unroll") for (int m = 0; m < 4; ++m) _Pragma("unroll") for (int n = 0; n < 2; ++n) _Pragma("unroll") for (int k = 0; k < 2; ++k) \
        acc[ai][bj][m][n] = __builtin_amdgcn_mfma_f32_16x16x32_bf16(Bt[n][k], At[m][k], acc[ai][bj][m][n], 0, 0, 0); __builtin_amdgcn_s_setprio(0); } while (0)
#define PG8_WAIT_V(n) asm volatile("s_waitcnt vmcnt(" #n ")" ::: "memory")
#define PG8_WAIT_L(n) asm volatile("s_waitcnt lgkmcnt(" #n ")" ::: "memory")
#define PG8_BAR __builtin_amdgcn_s_barrier()
#define PG8_SCHED __builtin_amdgcn_sched_barrier(0)
    Unit cur, nxt; int ui = 0;
    if (!S.next(0, cur)) return;
    f32x4 acc[2][2][4][2];
#pragma unroll
    for (int a = 0; a < 2; ++a)
#pragma unroll
        for (int b = 0; b < 2; ++b)
#pragma unroll
            for (int m = 0; m < 4; ++m)
#pragma unroll
                for (int n = 0; n < 2; ++n) acc[a][b][m][n] = (f32x4){0.f, 0.f, 0.f, 0.f};
    bf16x8 At[4][2], B0[2][2], B1[2][2];
    const char* cA = (const char*)g.A + (size_t)cur.pm * tstep + (size_t)cur.k0 * kstep; const char* cB = (const char*)g.Bt + (size_t)cur.pn * tstep + (size_t)cur.k0 * kstep;
    S.a_ready(cur);
    if constexpr (SP2) {
        PG8_STAGE(PG8_SB(0, 0), cB, voffB); PG8_STAGE(PG8_SB(0, 1), cB + hstep, voffB); PG8_STAGE(PG8_SA(0, 0), cA, voffA); PG8_STAGE(PG8_SA(0, 1), cA + hstep, voffA);
        if (wr == 1) PG8_BAR;
        PG8_WAIT_V(2); PG8_BAR;
        PG8_STAGE(PG8_SB(1, 0), cB + kstep, voffB); PG8_STAGE(PG8_SA(1, 0), cA + kstep, voffA); PG8_STAGE(PG8_SB(1, 1), cB + hstep + kstep, voffB);
        PG8_WAIT_V(6); PG8_BAR;
    } else {
        PG8_STAGE(PG8_SB(0, 0), cB, voffB); PG8_STAGE(PG8_SA(0, 0), cA, voffA); PG8_STAGE(PG8_SB(0, 1), cB + hstep, voffB); PG8_STAGE(PG8_SA(0, 1), cA + hstep, voffA);
        if (wr == 1) PG8_BAR;
        PG8_WAIT_V(4); PG8_BAR;
        PG8_STAGE(PG8_SB(1, 0), cB + kstep, voffB); PG8_STAGE(PG8_SA(1, 0), cA + kstep, voffA); PG8_STAGE(PG8_SB(1, 1), cB + hstep + kstep, voffB);
        PG8_WAIT_V(6); PG8_BAR;
    }
    for (;;) {
        const bool has_next = S.next(ui + 1, nxt);
        const char* nA = has_next ? (const char*)g.A + (size_t)nxt.pm * tstep + (size_t)nxt.k0 * kstep : cA; const char* nB = has_next ? (const char*)g.Bt + (size_t)nxt.pn * tstep + (size_t)nxt.k0 * kstep : cB;
        const int nt = cur.nt;
        for (int t = 0; t < nt; t += 2) {
            const bool last = (t == nt - 2);
            const char* a1 = cA + (size_t)(t + 1) * kstep;
            const char* a2 = last ? nA : cA + (size_t)(t + 2) * kstep; const char* b2 = last ? nB : cB + (size_t)(t + 2) * kstep;
            const char* a3 = a2 + kstep; const char* b3 = b2 + kstep;
            if (last && has_next) S.a_ready(nxt);
            if constexpr (SP2) {
            PG8_LDB(B0, 0, 0); PG8_LDB(B1, 0, 1); PG8_SCHED; PG8_LDA(At, 0, 0); PG8_STAGE(PG8_SA(1, 1), a1 + hstep, voffA);
            PG8_WAIT_V(8); PG8_WAIT_L(0); PG8_BAR; PG8_MMA(0, 0, At, B0); PG8_MMA(0, 1, At, B1); PG8_BAR; PG8_SCHED;
            PG8_LDA(At, 0, 1); PG8_STAGE(PG8_SB(0, 0), b2, voffB); PG8_STAGE(PG8_SB(0, 1), b2 + hstep, voffB); PG8_STAGE(PG8_SA(0, 0), a2, voffA);
            PG8_WAIT_V(8); PG8_WAIT_L(0); PG8_BAR; PG8_MMA(1, 0, At, B0); PG8_MMA(1, 1, At, B1); PG8_BAR; PG8_SCHED;
            PG8_LDB(B0, 1, 0); PG8_LDB(B1, 1, 1); PG8_SCHED; PG8_LDA(At, 1, 0); PG8_STAGE(PG8_SA(0, 1), a2 + hstep, voffA);
            PG8_WAIT_V(8); PG8_WAIT_L(0); PG8_BAR; PG8_MMA(0, 0, At, B0); PG8_MMA(0, 1, At, B1); PG8_BAR; PG8_SCHED;
            PG8_LDA(At, 1, 1); PG8_STAGE(PG8_SB(1, 0), b3, voffB); PG8_STAGE(PG8_SB(1, 1), b3 + hstep, voffB); PG8_STAGE(PG8_SA(1, 0), a3, voffA);
            PG8_WAIT_V(8); PG8_WAIT_L(0); PG8_BAR; PG8_MMA(1, 0, At, B0); PG8_MMA(1, 1, At, B1); PG8_BAR; PG8_SCHED;
            } else {
            PG8_LDB(B0, 0, 0); PG8_SCHED; PG8_LDA(At, 0, 0); PG8_STAGE(PG8_SA(1, 1), a1 + hstep, voffA);
            PG8_WAIT_L(8); PG8_BAR; PG8_WAIT_L(0); PG8_MMA(0, 0, At, B0); PG8_BAR; PG8_SCHED;
            PG8_LDB(B1, 0, 1); PG8_STAGE(PG8_SB(0, 0), b2, voffB);
            PG8_BAR; PG8_WAIT_L(0); PG8_MMA(0, 1, At, B1); PG8_BAR;
            PG8_LDA(At, 0, 1); PG8_STAGE(PG8_SA(0, 0), a2, voffA);
            PG8_BAR; PG8_WAIT_L(0); PG8_MMA(1, 0, At, B0); PG8_BAR; PG8_SCHED;
            PG8_STAGE(PG8_SB(0, 1), b2 + hstep, voffB);
            PG8_WAIT_V(6); PG8_BAR; PG8_MMA(1, 1, At, B1); PG8_BAR;
            PG8_LDB(B0, 1, 0); PG8_SCHED; PG8_LDA(At, 1, 0); PG8_STAGE(PG8_SA(0, 1), a2 + hstep, voffA);
            PG8_WAIT_L(8); PG8_BAR; PG8_WAIT_L(0); PG8_MMA(0, 0, At, B0); PG8_BAR; PG8_SCHED;
            PG8_LDB(B1, 1, 1); PG8_STAGE(PG8_SB(1, 0), b3, voffB);
            PG8_BAR; PG8_WAIT_L(0); PG8_MMA(0, 1, At, B1); PG8_BAR;
            PG8_LDA(At, 1, 1); PG8_STAGE(PG8_SA(1, 0), a3, voffA);
            PG8_BAR; PG8_WAIT_L(0); PG8_MMA(1, 0, At, B0); PG8_BAR; PG8_SCHED;
            PG8_STAGE(PG8_SB(1, 1), b3 + hstep, voffB);
            PG8_WAIT_V(6); PG8_BAR; PG8_MMA(1, 1, At, B1); PG8_BAR;
            }
        }
        if constexpr (ALIGN_EPI) { if (wr == 0) PG8_BAR; }
        asm volatile("s_nop 15\n\ts_nop 15" ::: "memory");
        if constexpr (!Epi::AFTER_DRAIN) { E(acc, cur, wr, wc, fr, fq); S.done(cur); }
        if (!has_next) break;
#pragma unroll
        for (int a = 0; a < 2; ++a)
#pragma unroll
            for (int b = 0; b < 2; ++b)
#pragma unroll
                for (int m = 0; m < 4; ++m)
#pragma unroll
                    for (int n = 0; n < 2; ++n) acc[a][b][m][n] = (f32x4){0.f, 0.f, 0.f, 0.f};
        cur = nxt; cA = nA; cB = nB; ++ui;
        if constexpr (ALIGN_EPI) { if (wr == 1) PG8_BAR; }
    }
    PG8_WAIT_V(0);
    if constexpr (!ALIGN_EPI) { if (wr == 0) PG8_BAR; }
    PG8_BAR;
    if constexpr (Epi::AFTER_DRAIN) { E.fused(acc, cur, wr, wc, fr, fq, lds, wid, lane); S.done(cur); }
#undef PG8_SA
#undef PG8_SB
#undef PG8_STAGE
#undef PG8_LDA
#undef PG8_LDB
#undef PG8_MMA
#undef PG8_WAIT_V
#undef PG8_WAIT_L
#undef PG8_BAR
#undef PG8_SCHED
}
}

constexpr int D = 2048, BATCH = 4, SEQ = 4096, CTXL = 256, DEPTH = 4, FF = 5632;
constexpr int TPB = SEQ + CTXL;
constexpr int M = BATCH * TPB;
constexpr int NTM = M / 256;
constexpr int NTL = BATCH * SEQ / 256;
constexpr float ALPHA = 1.6817928305074290f;
constexpr float LN_EPS = 1e-5f, GN_EPS = 1e-6f, RMS_EPS = 1e-6f;
constexpr float MLA_SCALE = 0.07216878364870322f;
constexpr int NWAVES = 8;

constexpr size_t MiB = 1u << 20;
constexpr size_t WS_CTL = 0, CTL_ZERO_BYTES = 64 * 1024;
constexpr size_t WS_MOD = 1 * MiB;
constexpr size_t WS_RCS = 2 * MiB;
constexpr size_t WS_ACS = 6 * MiB;
constexpr size_t WS_WQKV = 8 * MiB;
constexpr size_t WS_WG = 72 * MiB;
constexpr size_t WS_WOR = 136 * MiB;
constexpr size_t WS_WD = 168 * MiB;
constexpr size_t WS_WUQ = 178 * MiB;
constexpr size_t WS_WUKV = 184 * MiB;
constexpr size_t WS_WOM = 192 * MiB;
constexpr size_t WS_WIN = 208 * MiB;
constexpr size_t WS_WOUT = 384 * MiB;
constexpr size_t WS_H = 472 * MiB;
constexpr size_t WS_U = 608 * MiB;
constexpr size_t WS_Y = 676 * MiB;
constexpr size_t WS_S = 744 * MiB;
constexpr size_t WS_RQ = WS_S, WS_RK = WS_S + 68 * MiB, WS_RV = WS_S + 136 * MiB, WS_OF = WS_S + 272 * MiB, WS_OB = WS_S + 408 * MiB, WS_PART = WS_S + 544 * MiB;
constexpr size_t WS_YG = WS_S;
constexpr size_t WS_SSQ = WS_S  , WS_CQKV = WS_S, WS_CQN = WS_S + 85 * MiB, WS_CKVN = WS_S + 102 * MiB, WS_KR = WS_S + 119 * MiB, WS_QB = WS_S + 122 * MiB,
                 WS_KN = WS_S + 224 * MiB, WS_VB = WS_S + 292 * MiB, WS_AO = WS_S + 360 * MiB;
constexpr size_t WS_HID = WS_S;
constexpr size_t WS_YP = 1297 * MiB;
constexpr size_t WS_END = 1329 * MiB;
constexpr int KSPLIT = 4;

constexpr int CW_BAR = 4096;

constexpr int RING_BYTES = 131072;
constexpr int LDSCTL_OFF = RING_BYTES, MISC_OFF = LDSCTL_OFF + 320;
constexpr int LDS_BYTES = 147456;

#define GAS __attribute__((address_space(1)))
#define LAS __attribute__((address_space(3)))
typedef unsigned short bf16;
typedef unsigned v4u __attribute__((ext_vector_type(4)));
typedef unsigned v2u __attribute__((ext_vector_type(2)));
typedef float f32x4 __attribute__((ext_vector_type(4)));
typedef float f32x2 __attribute__((ext_vector_type(2)));
typedef float f32x16 __attribute__((ext_vector_type(16)));
typedef short bf16x8 __attribute__((ext_vector_type(8)));
typedef short s16x4 __attribute__((ext_vector_type(4)));
typedef _Float16 h16;
typedef _Float16 h16x4 __attribute__((ext_vector_type(4)));
#define LDS_WAIT() asm volatile("s_waitcnt lgkmcnt(0)" ::: "memory")
#define VM_WAIT() asm volatile("s_waitcnt vmcnt(0)" ::: "memory")
#define SBAR() __builtin_amdgcn_sched_barrier(0)
using pg8::cvt_pk_bf16;
__device__ __forceinline__ float bf2f(unsigned short b) { return __uint_as_float(((unsigned)b) << 16); }
__device__ __forceinline__ float bflo(unsigned w) { return __uint_as_float(w << 16); }
__device__ __forceinline__ float bfhi(unsigned w) { return __uint_as_float(w & 0xffff0000u); }
__device__ __forceinline__ float silu_f(float x) { return x * __builtin_amdgcn_rcpf(1.0f + __expf(-x)); }

#define XB_TMO      128
#define XB_XCNT(j)  (256  + 64 * (j))
#define XB_XSUB(j)  (1280 + 64 * (j))
#define XB_XGEN(j)  (2304 + 64 * (j))
#define XB_TOP      3328
#define XB_TOPGEN   3392
#define XCD_BAR_WORDS 3456
#define XB_SPIN_CAP (1u << 20)

__device__ __forceinline__ unsigned xb_ld(unsigned* p)              { return __hip_atomic_load(p, __ATOMIC_RELAXED, __HIP_MEMORY_SCOPE_AGENT); }
__device__ __forceinline__ unsigned xb_add(unsigned* p, unsigned v) { return __hip_atomic_fetch_add(p, v, __ATOMIC_RELAXED, __HIP_MEMORY_SCOPE_AGENT); }
__device__ __forceinline__ unsigned xb_xcc_id() { return (unsigned)__builtin_amdgcn_s_getreg((3 << 11) | 20) & 0xFu; }
#define XB_SPIN(cond, bar) do { unsigned _sp = 0; while (cond) { __builtin_amdgcn_s_sleep(1); \
    if ((++_sp & 255u) == 0u) { if (xb_ld(&(bar)[XB_TMO])) break; if (_sp > XB_SPIN_CAP) { atomicAdd(&(bar)[XB_TMO], 1u); break; } } } } while (0)

struct XcdBarrier { unsigned* bar; unsigned x; volatile LAS unsigned* st; };
__device__ __forceinline__ XcdBarrier xcd_barrier_post(unsigned* bar, volatile LAS unsigned* st) {
    XcdBarrier b; b.bar = bar; b.x = xb_xcc_id(); b.st = st;
    if (threadIdx.x == 0) (void)xb_add(&bar[XB_XCNT(b.x)], 1u);
    return b;
}
__device__ __forceinline__ void xcd_barrier_complete(unsigned* bar, unsigned x, unsigned& nloc, unsigned& nx) {
    const unsigned G = gridDim.x * gridDim.y * gridDim.z;
    unsigned sum, cnt, mine, sp = 0u;
    for (;;) {
        sum = 0u; cnt = 0u; mine = 0u;
#pragma unroll
        for (unsigned j = 0; j < 16; ++j) { const unsigned c = xb_ld(&bar[XB_XCNT(j)]); sum += c; cnt += (c > 0u) ? 1u : 0u; mine = (j == x) ? c : mine; }
        if (sum == G) break;
        __builtin_amdgcn_s_sleep(1);
        if ((++sp & 255u) == 0u) { if (xb_ld(&bar[XB_TMO])) break; if (sp > XB_SPIN_CAP) { atomicAdd(&bar[XB_TMO], 1u); break; } }
    }
    nloc = mine > 0u ? mine : 1u; nx = cnt > 0u ? cnt : 1u;
}
__device__ __forceinline__ void xcd_barrier(const XcdBarrier& b, int wave) {
    asm volatile("s_waitcnt vmcnt(0)" ::: "memory");
    __syncthreads();
    int l_; asm volatile("v_mbcnt_lo_u32_b32 %0, -1, 0\n\tv_mbcnt_hi_u32_b32 %0, -1, %0" : "=v"(l_));
    if (l_ == 0 && wave == 0) {
        unsigned* bar = b.bar;
        __builtin_amdgcn_s_waitcnt(0);
        unsigned nloc = b.st[0], nx = b.st[1];
        if (nloc == 0u) { xcd_barrier_complete(bar, b.x, nloc, nx); b.st[0] = nloc; b.st[1] = nx; }
        const unsigned old = xb_add(&bar[XB_XSUB(b.x)], 1u);
        const unsigned gen = old / nloc;
        if (old + 1u == (gen + 1u) * nloc) {
            __builtin_amdgcn_fence(__ATOMIC_RELEASE, "agent");
            asm volatile("s_waitcnt vmcnt(0)" ::: "memory");
            const unsigned og = xb_add(&bar[XB_TOP], 1u);
            const unsigned tg = og / nx;
            if (og + 1u == (tg + 1u) * nx) xb_add(&bar[XB_TOPGEN], 1u);
            else XB_SPIN(xb_ld(&bar[XB_TOPGEN]) == tg, bar);
            __builtin_amdgcn_fence(__ATOMIC_ACQUIRE, "agent");
            xb_add(&bar[XB_XGEN(b.x)], 1u);
            asm volatile("s_waitcnt vmcnt(0)" ::: "memory");
        } else {
            XB_SPIN(xb_ld(&bar[XB_XGEN(b.x)]) == gen, bar);
            __builtin_amdgcn_fence(__ATOMIC_ACQUIRE, "agent");
            asm volatile("s_waitcnt vmcnt(0)" ::: "memory");
        }
    }
    __syncthreads();
}

__device__ __forceinline__ float shx(float v, int mask, int lane) { return __int_as_float(__builtin_amdgcn_ds_bpermute((lane ^ mask) << 2, __float_as_int(v))); }
__device__ __forceinline__ float wave_sum(float v, int lane) {
#pragma unroll
    for (int o = 1; o < 64; o <<= 1) v += shx(v, o, lane);
    return v;
}

typedef const pg8::f32x4 (&AccRef)[2][2][4][2];

struct EpiQKV {
    static constexpr bool PERM = true, AFTER_DRAIN = false;
    bf16 *Q, *K, *V; const float* cs;
    __device__ __forceinline__ void operator()(AccRef acc, const pg8::Unit& u, int wr, int wc, int fr, int fq) const {
        const int pn = u.pn, row0 = u.pm * 256 + wr * 64 + fr, tj = u.pm % 17; const bool isctx = (tj == 16); const int t0 = tj * 256 + wr * 64 + fr;
        if (pn < 16) {
            bf16* dst = (pn < 8) ? Q : K; const float sc = (pn < 8) ? 1.0f : 0.0625f; const int hc = (pn & 7) * 256 + wc * 32 + 8 * fq;
#pragma unroll
            for (int ai = 0; ai < 2; ++ai)
#pragma unroll
                for (int m = 0; m < 4; ++m) { const int r = row0 + ai * 128 + m * 16, t = t0 + ai * 128 + m * 16;
#pragma unroll
                    for (int bj = 0; bj < 2; ++bj) { f32x4 v0 = acc[ai][bj][m][0], v1 = acc[ai][bj][m][1];
                        if (!isctx) { const f32x4* cp = (const f32x4*)(cs + ((size_t)t * 128 + bj * 64 + wc * 16 + 4 * fq) * 2); const f32x4 c0 = cp[0], c1 = cp[1];
                            v0 = (f32x4){v0[0] * c0[0] - v0[1] * c0[1], v0[0] * c0[1] + v0[1] * c0[0], v0[2] * c0[2] - v0[3] * c0[3], v0[2] * c0[3] + v0[3] * c0[2]};
                            v1 = (f32x4){v1[0] * c1[0] - v1[1] * c1[1], v1[0] * c1[1] + v1[1] * c1[0], v1[2] * c1[2] - v1[3] * c1[3], v1[2] * c1[3] + v1[3] * c1[2]}; }
                        v0 = v0 * sc; v1 = v1 * sc;
                        v4u w; w.x = cvt_pk_bf16(v0[0], v0[1]); w.y = cvt_pk_bf16(v0[2], v0[3]); w.z = cvt_pk_bf16(v1[0], v1[1]); w.w = cvt_pk_bf16(v1[2], v1[3]);
                        *(v4u*)(dst + (size_t)r * 2048 + hc + bj * 128) = w; } }
        } else {
            const int vc = (pn - 16) * 256 + wc * 32 + 8 * fq;
#pragma unroll
            for (int ai = 0; ai < 2; ++ai)
#pragma unroll
                for (int m = 0; m < 4; ++m) { const int r = row0 + ai * 128 + m * 16;
#pragma unroll
                    for (int bj = 0; bj < 2; ++bj) { const f32x4 v0 = acc[ai][bj][m][0], v1 = acc[ai][bj][m][1];
                        v4u w; w.x = cvt_pk_bf16(v0[0], v0[1]); w.y = cvt_pk_bf16(v0[2], v0[3]); w.z = cvt_pk_bf16(v1[0], v1[1]); w.w = cvt_pk_bf16(v1[2], v1[3]);
                        *(v4u*)(V + (size_t)r * 4096 + vc + bj * 128) = w; } }
        }
    }
};
struct EpiGate {
    static constexpr bool PERM = true, AFTER_DRAIN = false;
    const bf16 *OF, *OB; const float* part; bf16* YG;
    __device__ __forceinline__ void operator()(AccRef acc, const pg8::Unit& u, int wr, int wc, int fr, int fq) const {
        const int head = u.pn >> 2, col = u.pn * 128 + wc * 32 + 8 * fq, row0 = u.pm * 256 + wr * 64 + fr;
#pragma unroll
        for (int hb = 0; hb < 4; ++hb) { const int ai = hb >> 1, mb = (hb & 1) * 2;
            f32x4 pa[2][4]; v4u of[2], ob[2];
#pragma unroll
            for (int mm = 0; mm < 2; ++mm) { const int r = row0 + ai * 128 + (mb + mm) * 16; const f32x4* pp = (const f32x4*)(part + ((size_t)r * 8 + head) * 16);
                pa[mm][0] = pp[0]; pa[mm][1] = pp[1]; pa[mm][2] = pp[2]; pa[mm][3] = pp[3];
                of[mm] = *(const v4u*)(OF + (size_t)r * 4096 + col); ob[mm] = *(const v4u*)(OB + (size_t)r * 4096 + col); }
#pragma unroll
            for (int mm = 0; mm < 2; ++mm) { const int m = mb + mm; const int r = row0 + ai * 128 + m * 16;
                const f32x4 a0 = pa[mm][0], a1 = pa[mm][1], b0 = pa[mm][2], b1 = pa[mm][3];
                const float mf = ((a0[0] + a0[2]) + (a1[0] + a1[2])) * (1.0f / 512.0f), qf = ((a0[1] + a0[3]) + (a1[1] + a1[3])) * (1.0f / 512.0f);
                const float mbb = ((b0[0] + b0[2]) + (b1[0] + b1[2])) * (1.0f / 512.0f), qb = ((b0[1] + b0[3]) + (b1[1] + b1[3])) * (1.0f / 512.0f);
                const float rf = rsqrtf(fmaxf(qf - mf * mf, 0.f) + GN_EPS), rb = rsqrtf(fmaxf(qb - mbb * mbb, 0.f) + GN_EPS);
                float y[8];
#pragma unroll
                for (int n = 0; n < 2; ++n) { const f32x4 gf = acc[ai][0][m][n], gb = acc[ai][1][m][n];
#pragma unroll
                    for (int e = 0; e < 4; ++e) { const int idx = n * 4 + e; const unsigned wf = of[mm][idx >> 1], wb = ob[mm][idx >> 1];
                        const float xf = (idx & 1) ? bfhi(wf) : bflo(wf), xb = (idx & 1) ? bfhi(wb) : bflo(wb);
                        y[idx] = silu_f(gf[e]) * ((xf - mf) * rf) + silu_f(gb[e]) * ((xb - mbb) * rb); } }
                v4u w; w.x = cvt_pk_bf16(y[0], y[1]); w.y = cvt_pk_bf16(y[2], y[3]); w.z = cvt_pk_bf16(y[4], y[5]); w.w = cvt_pk_bf16(y[6], y[7]);
                *(v4u*)(YG + (size_t)r * 4096 + col) = w; } }
    }
};
struct EpiSwiglu {
    static constexpr bool PERM = true, AFTER_DRAIN = false;
    bf16* HID;
    __device__ __forceinline__ void operator()(AccRef acc, const pg8::Unit& u, int wr, int wc, int fr, int fq) const {
        const int col = u.pn * 128 + wc * 32 + 8 * fq, row0 = u.pm * 256 + wr * 64 + fr;
#pragma unroll
        for (int ai = 0; ai < 2; ++ai)
#pragma unroll
            for (int m = 0; m < 4; ++m) { const int r = row0 + ai * 128 + m * 16; float y[8];
#pragma unroll
                for (int n = 0; n < 2; ++n) { const f32x4 a = acc[ai][0][m][n], b = acc[ai][1][m][n];
#pragma unroll
                    for (int e = 0; e < 4; ++e) y[n * 4 + e] = silu_f(a[e]) * b[e]; }
                v4u w; w.x = cvt_pk_bf16(y[0], y[1]); w.y = cvt_pk_bf16(y[2], y[3]); w.z = cvt_pk_bf16(y[4], y[5]); w.w = cvt_pk_bf16(y[6], y[7]);
                *(v4u*)(HID + (size_t)r * FF + col) = w; }
    }
};
struct EpiBf {
    static constexpr bool PERM = true, AFTER_DRAIN = false;
    bf16 *O0, *O1; int ldc, split; float* YP;
    __device__ __forceinline__ void operator()(AccRef acc, const pg8::Unit& u, int wr, int wc, int fr, int fq) const {
        const int row0 = u.pm * 256 + wr * 64 + fr, cw = wc * 32 + 8 * fq;
        if (u.ks >= 0) {
            const int crow0 = ((u.pm - 16) / 17) * 256 + wr * 64 + fr;
#pragma unroll
            for (int ai = 0; ai < 2; ++ai)
#pragma unroll
                for (int m = 0; m < 4; ++m) { float* rp = YP + ((size_t)u.ks * 1024 + crow0 + ai * 128 + m * 16) * 2048 + u.pn * 256 + cw;
#pragma unroll
                    for (int bj = 0; bj < 2; ++bj) { *(f32x4*)(rp + bj * 128) = acc[ai][bj][m][0]; *(f32x4*)(rp + bj * 128 + 4) = acc[ai][bj][m][1]; } }
            return; }
#pragma unroll
        for (int ai = 0; ai < 2; ++ai)
#pragma unroll
            for (int m = 0; m < 4; ++m) { const int r = row0 + ai * 128 + m * 16;
#pragma unroll
                for (int bj = 0; bj < 2; ++bj) { const f32x4 v0 = acc[ai][bj][m][0], v1 = acc[ai][bj][m][1];
                    v4u w; w.x = cvt_pk_bf16(v0[0], v0[1]); w.y = cvt_pk_bf16(v0[2], v0[3]); w.z = cvt_pk_bf16(v1[0], v1[1]); w.w = cvt_pk_bf16(v1[2], v1[3]);
                    bf16* dst = split ? ((bj ? O1 : O0) + (size_t)r * ldc + u.pn * 128 + cw) : (O0 + (size_t)r * ldc + u.pn * 256 + bj * 128 + cw);
                    *(v4u*)dst = w; } }
    }
};
struct EpiF32 {
    static constexpr bool PERM = false, AFTER_DRAIN = false;
    float* C; int ldc;
    __device__ __forceinline__ void operator()(AccRef acc, const pg8::Unit& u, int wr, int wc, int fr, int fq) const {
        const int row0 = u.pm * 256 + wr * 64 + fr, col0 = u.pn * 256 + wc * 32 + 4 * fq;
#pragma unroll
        for (int ai = 0; ai < 2; ++ai)
#pragma unroll
            for (int m = 0; m < 4; ++m) { float* rowp = C + (size_t)(row0 + ai * 128 + m * 16) * ldc + col0;
#pragma unroll
                for (int bj = 0; bj < 2; ++bj)
#pragma unroll
                    for (int n = 0; n < 2; ++n) *(f32x4*)(rowp + bj * 128 + n * 16) = acc[ai][bj][m][n]; }
    }
};
struct EpiDQKV {
    static constexpr bool PERM = true, AFTER_DRAIN = false;
    bf16 *CQ, *CKV, *KR; float* ssq; const float* acs;
    __device__ __forceinline__ void operator()(AccRef acc, const pg8::Unit& u, int wr, int wc, int fr, int fq) const {
        const int row0 = u.pm * 256 + wr * 64 + fr, tj = u.pm % 17; const bool isctx = (tj == 16); const int t0 = tj * 256 + wr * 64 + fr;
        if (u.pn < 4) { bf16* dst = (u.pn < 2) ? CQ : CKV; const int colb = (u.pn & 1) * 256 + wc * 32 + 8 * fq;
#pragma unroll
            for (int ai = 0; ai < 2; ++ai)
#pragma unroll
                for (int m = 0; m < 4; ++m) { const int r = row0 + ai * 128 + m * 16; float q = 0.f;
#pragma unroll
                    for (int bj = 0; bj < 2; ++bj) { const f32x4 v0 = acc[ai][bj][m][0], v1 = acc[ai][bj][m][1];
                        q += (v0[0] * v0[0] + v0[1] * v0[1]) + (v0[2] * v0[2] + v0[3] * v0[3]) + (v1[0] * v1[0] + v1[1] * v1[1]) + (v1[2] * v1[2] + v1[3] * v1[3]);
                        v4u w; w.x = cvt_pk_bf16(v0[0], v0[1]); w.y = cvt_pk_bf16(v0[2], v0[3]); w.z = cvt_pk_bf16(v1[0], v1[1]); w.w = cvt_pk_bf16(v1[2], v1[3]);
                        *(v4u*)(dst + (size_t)r * 512 + colb + bj * 128) = w; }
                    { const int ln = fq * 16 + fr;
                      q += shx(q, 16, ln); q += shx(q, 32, ln); }
                    if (fq == 0) ssq[(size_t)r * 16 + u.pn * 4 + wc] = q; }
        } else if (wc < 2) {
#pragma unroll
            for (int ai = 0; ai < 2; ++ai)
#pragma unroll
                for (int m = 0; m < 4; ++m) { const int r = row0 + ai * 128 + m * 16, t = t0 + ai * 128 + m * 16;
                    f32x4 v0 = acc[ai][0][m][0], v1 = acc[ai][0][m][1];
                    if (!isctx) { const f32x4* cp = (const f32x4*)(acs + ((size_t)t * 32 + 16 * wc + 4 * fq) * 2); const f32x4 c0 = cp[0], c1 = cp[1];
                        v0 = (f32x4){v0[0] * c0[0] - v0[1] * c0[1], v0[0] * c0[1] + v0[1] * c0[0], v0[2] * c0[2] - v0[3] * c0[3], v0[2] * c0[3] + v0[3] * c0[2]};
                        v1 = (f32x4){v1[0] * c1[0] - v1[1] * c1[1], v1[0] * c1[1] + v1[1] * c1[0], v1[2] * c1[2] - v1[3] * c1[3], v1[2] * c1[3] + v1[3] * c1[2]}; }
                    v4u w; w.x = cvt_pk_bf16(v0[0], v0[1]); w.y = cvt_pk_bf16(v0[2], v0[3]); w.z = cvt_pk_bf16(v1[0], v1[1]); w.w = cvt_pk_bf16(v1[2], v1[3]);
                    *(v4u*)(KR + (size_t)r * 64 + wc * 32 + 8 * fq) = w; }
        }
    }
};
__device__ __forceinline__ float rms_rstd(const float* p) { const f32x4 a = *(const f32x4*)p, b = *(const f32x4*)(p + 4); return rsqrtf(((a[0] + a[1]) + (a[2] + a[3]) + (b[0] + b[1]) + (b[2] + b[3])) * (1.0f / 512.0f) + RMS_EPS); }
struct EpiUKV {
    static constexpr bool PERM = true, AFTER_DRAIN = false;
    bf16 *KN, *VB; const float* ssq;
    __device__ __forceinline__ void operator()(AccRef acc, const pg8::Unit& u, int wr, int wc, int fr, int fq) const {
        const int row0 = u.pm * 256 + wr * 64 + fr, cw = u.pn * 128 + wc * 32 + 8 * fq;
#pragma unroll
        for (int ai = 0; ai < 2; ++ai)
#pragma unroll
            for (int m = 0; m < 4; ++m) { const int r = row0 + ai * 128 + m * 16; const float rs = rms_rstd(ssq + (size_t)r * 16 + 8);
#pragma unroll
                for (int bj = 0; bj < 2; ++bj) { const f32x4 v0 = acc[ai][bj][m][0] * rs, v1 = acc[ai][bj][m][1] * rs;
                    v4u w; w.x = cvt_pk_bf16(v0[0], v0[1]); w.y = cvt_pk_bf16(v0[2], v0[3]); w.z = cvt_pk_bf16(v1[0], v1[1]); w.w = cvt_pk_bf16(v1[2], v1[3]);
                    *(v4u*)((bj ? VB : KN) + (size_t)r * 2048 + cw) = w; } }
    }
};
struct EpiUQ {
    static constexpr bool PERM = true, AFTER_DRAIN = false;
    bf16* QB; const float* acs; const float* ssq;
    __device__ __forceinline__ void operator()(AccRef acc, const pg8::Unit& u, int wr, int wc, int fr, int fq) const {
        const int row0 = u.pm * 256 + wr * 64 + fr, tj = u.pm % 17; const bool isctx = (tj == 16); const int t0 = tj * 256 + wr * 64 + fr;
#pragma unroll
        for (int bj = 0; bj < 2; ++bj) { const int blk = 4 * u.pn + 2 * bj + (wc >> 1); const bool rope = ((blk % 3) == 2) && !isctx;
            const int col = u.pn * 256 + bj * 128 + wc * 32 + 8 * fq, p0 = 16 * (wc & 1) + 4 * fq;
#pragma unroll
            for (int ai = 0; ai < 2; ++ai)
#pragma unroll
                for (int m = 0; m < 4; ++m) { const int r = row0 + ai * 128 + m * 16, t = t0 + ai * 128 + m * 16; const float rs = rms_rstd(ssq + (size_t)r * 16);
                    f32x4 v0 = acc[ai][bj][m][0] * rs, v1 = acc[ai][bj][m][1] * rs;
                    if (rope) { const f32x4* cp = (const f32x4*)(acs + ((size_t)t * 32 + p0) * 2); const f32x4 c0 = cp[0], c1 = cp[1];
                        v0 = (f32x4){v0[0] * c0[0] - v0[1] * c0[1], v0[0] * c0[1] + v0[1] * c0[0], v0[2] * c0[2] - v0[3] * c0[3], v0[2] * c0[3] + v0[3] * c0[2]};
                        v1 = (f32x4){v1[0] * c1[0] - v1[1] * c1[1], v1[0] * c1[1] + v1[1] * c1[0], v1[2] * c1[2] - v1[3] * c1[3], v1[2] * c1[3] + v1[3] * c1[2]}; }
                    v4u w; w.x = cvt_pk_bf16(v0[0], v0[1]); w.y = cvt_pk_bf16(v0[2], v0[3]); w.z = cvt_pk_bf16(v1[0], v1[1]); w.w = cvt_pk_bf16(v1[2], v1[3]);
                    *(v4u*)(QB + (size_t)r * 3072 + col) = w; } }
    }
};

__device__ __forceinline__ int srccol(int mode, int n, int halfn) {
    if (mode == 1) { if (n >= 4096) return n; const int d = n & 255; return (n & ~255) + ((d & 1) ? 128 + (d >> 1) : (d >> 1)); }
    if (mode == 2) { const int t = n >> 8, r = n & 255; return (r < 128) ? t * 128 + r : halfn + t * 128 + (r - 128); }
    if (mode == 4) { const int h = n / 192, d = n - h * 192; if (d < 128) return n; const int p = d - 128, hf = p >> 5, dd = p & 31; return h * 192 + 128 + hf * 32 + ((dd & 1) ? 16 + (dd >> 1) : (dd >> 1)); }
    if (mode == 5) { const int hf = n >> 5, dd = n & 31; return 512 + hf * 32 + ((dd & 1) ? 16 + (dd >> 1) : (dd >> 1)); }
    return n;
}
struct CvtJob { const float* W; bf16* WT; int ldw, K, Nd, mode, halfn; const float* kscale; };
template <bool KS> __device__ __forceinline__ void transpose_item(const CvtJob& J, LAS float* scr, int item, int lane) {
    const int nblk = J.Nd / 32, kb = item / nblk, nb = item - kb * nblk, k0 = 64 * kb, n0 = 32 * nb;
    const int sc = srccol(J.mode, n0 + (lane & 31), J.halfn);
#pragma unroll
    for (int i = 0; i < 32; ++i) { const int kk = 2 * i + (lane >> 5); float w = J.W[(size_t)(k0 + kk) * J.ldw + sc]; if (KS) w *= J.kscale[k0 + kk]; scr[kk * 33 + (lane & 31)] = w; }
    LDS_WAIT(); asm volatile("" ::: "memory");
    const int c = lane & 7;
#pragma unroll
    for (int j = 0; j < 4; ++j) { const int n = (lane >> 3) + 8 * j; const LAS float* s = scr + (8 * c) * 33 + n;
        v4u o; o.x = cvt_pk_bf16(s[0 * 33], s[1 * 33]); o.y = cvt_pk_bf16(s[2 * 33], s[3 * 33]); o.z = cvt_pk_bf16(s[4 * 33], s[5 * 33]); o.w = cvt_pk_bf16(s[6 * 33], s[7 * 33]);
        *(v4u*)(J.WT + (size_t)(n0 + n) * J.K + k0 + 8 * c) = o; }
    LDS_WAIT(); asm volatile("" ::: "memory");
}

struct Args { const float* in[21]; float* out; unsigned char* ws; int ph_lo, ph_hi; };
enum { I_X = 0, I_C, I_CTX, I_CCTX, I_ADAW, I_ADAB, I_LNG, I_LNB, I_RWQKV, I_RWG, I_RDEC, I_RWO, I_MWDQ, I_MGQ, I_MWUQ, I_MWDKV, I_MGKV, I_MWUKV, I_MWO, I_FWIN, I_FWOUT };

__device__ __forceinline__ CvtJob cvt_job(const Args& a, int j) {
    unsigned char* ws = a.ws; CvtJob J; J.mode = 0; J.halfn = 0; J.kscale = nullptr;
    if (j < 6) { const int l = j / 3, k = j - 3 * l;
        if (k == 0) { J.W = a.in[I_RWQKV] + (size_t)l * 2048 * 8192; J.WT = (bf16*)(ws + WS_WQKV) + (size_t)l * 8192 * 2048; J.ldw = 8192; J.K = 2048; J.Nd = 8192; J.mode = 1; }
        else if (k == 1) { J.W = a.in[I_RWG] + (size_t)l * 2048 * 8192; J.WT = (bf16*)(ws + WS_WG) + (size_t)l * 8192 * 2048; J.ldw = 8192; J.K = 2048; J.Nd = 8192; J.mode = 2; J.halfn = 4096; }
        else { J.W = a.in[I_RWO] + (size_t)l * 4096 * 2048; J.WT = (bf16*)(ws + WS_WOR) + (size_t)l * 2048 * 4096; J.ldw = 2048; J.K = 4096; J.Nd = 2048; }
    } else if (j < 18) { const int jj = j - 6, l = jj / 6, k = jj - 6 * l; bf16* wd = (bf16*)(ws + WS_WD) + (size_t)l * 1280 * 2048;
        if (k == 0) { J.W = a.in[I_MWDQ] + (size_t)l * 2048 * 512; J.WT = wd; J.ldw = 512; J.K = 2048; J.Nd = 512; }
        else if (k == 1) { J.W = a.in[I_MWDKV] + (size_t)l * 2048 * 576; J.WT = wd + (size_t)512 * 2048; J.ldw = 576; J.K = 2048; J.Nd = 512; }
        else if (k == 2) { J.W = a.in[I_MWDKV] + (size_t)l * 2048 * 576; J.WT = wd + (size_t)1024 * 2048; J.ldw = 576; J.K = 2048; J.Nd = 64; J.mode = 5; }
        else if (k == 3) { J.W = a.in[I_MWUQ] + (size_t)l * 512 * 3072; J.WT = (bf16*)(ws + WS_WUQ) + (size_t)l * 3072 * 512; J.ldw = 3072; J.K = 512; J.Nd = 3072; J.mode = 4; J.kscale = a.in[I_MGQ] + (size_t)l * 512; }
        else if (k == 4) { J.W = a.in[I_MWUKV] + (size_t)l * 512 * 4096; J.WT = (bf16*)(ws + WS_WUKV) + (size_t)l * 4096 * 512; J.ldw = 4096; J.K = 512; J.Nd = 4096; J.kscale = a.in[I_MGKV] + (size_t)l * 512; }
        else { J.W = a.in[I_MWO] + (size_t)l * 2048 * 2048; J.WT = (bf16*)(ws + WS_WOM) + (size_t)l * 2048 * 2048; J.ldw = 2048; J.K = 2048; J.Nd = 2048; }
    } else { const int jj = j - 18, l = jj >> 1;
        if ((jj & 1) == 0) { J.W = a.in[I_FWIN] + (size_t)l * 2048 * 11264; J.WT = (bf16*)(ws + WS_WIN) + (size_t)l * 11264 * 2048; J.ldw = 11264; J.K = 2048; J.Nd = 11264; J.mode = 2; J.halfn = 5632; }
        else { J.W = a.in[I_FWOUT] + (size_t)l * 5632 * 2048; J.WT = (bf16*)(ws + WS_WOUT) + (size_t)l * 2048 * 5632; J.ldw = 2048; J.K = 5632; J.Nd = 2048; }
    }
    return J;
}
constexpr int N_CVT_JOBS = 26;

__device__ __forceinline__ void phase_pro_a(const Args& a, LAS unsigned char* lds, int tid, int lane, int wave, int vcu, int G) {
    unsigned char* ws = a.ws;
    const int gw = vcu * NWAVES + wave, NGW = G * NWAVES;
#ifndef PROA_REP_CVT
#define PROA_REP_CVT 1
#endif
#ifndef PROA_REP_GEMV
#define PROA_REP_GEMV 1
#endif
    for (int rep_c = 0; rep_c < PROA_REP_CVT; ++rep_c)
    { LAS float* scr = (LAS float*)(lds + wave * 16384);
      int cum = 0;
      for (int j = 0; j < N_CVT_JOBS; ++j) { const CvtJob J = cvt_job(a, j); const int nit = (J.K / 64) * (J.Nd / 32);
          int start = (gw - cum) % NGW; if (start < 0) start += NGW;
          if (J.kscale) { for (int it = start; it < nit; it += NGW) transpose_item<true>(J, scr, it, lane); }
          else { for (int it = start; it < nit; it += NGW) transpose_item<false>(J, scr, it, lane); }
          cum = (cum + nit) % NGW; }
      const int gt = vcu * 512 + tid, NT = G * 512;
      for (int l = 0; l < 2; ++l) { v4u* z = (v4u*)((bf16*)(ws + WS_WD) + (size_t)l * 1280 * 2048 + (size_t)1088 * 2048);
          for (int i = gt; i < 192 * 2048 / 8; i += NT) z[i] = (v4u){0u, 0u, 0u, 0u}; }
    }
    __syncthreads();
    { const int gt = vcu * 512 + tid, NT = G * 512; f32x2* rcs = (f32x2*)(ws + WS_RCS); f32x2* acs = (f32x2*)(ws + WS_ACS);
      for (int e = gt; e < 4096 * 128; e += NT) { const int t = e >> 7, j = e & 127; const float inv = exp2f(-((float)j * (1.0f / 127.0f)) * 13.287712379549449f);
          const float ang = (float)t * inv; rcs[e] = (f32x2){cosf(ang), sinf(ang)}; }
      for (int e = gt; e < 4096 * 32; e += NT) { const int t = e >> 5, p = e & 31; const int j = p & 15; const float inv = exp2f(-((float)j * (1.0f / 16.0f)) * 13.287712379549449f);
          const float pos = (p < 16) ? (float)(t >> 6) : (float)(t & 63); const float ang = pos * inv; acs[e] = (f32x2){cosf(ang), sinf(ang)}; }
    }
    { LAS float* sc = (LAS float*)lds;
      LAS float* red = (LAS float*)(lds + 5 * 2048 * 4);
      for (int i = tid; i < 5 * 2048; i += 512) { const float v = (i < 4 * 2048) ? a.in[I_C][i] : a.in[I_CCTX][i - 4 * 2048]; sc[i] = silu_f(v); }
      __syncthreads();
      float* mod = (float*)(ws + WS_MOD);
      const int kq = lane >> 4, c4 = lane & 15;
      for (int rep_g = 0; rep_g < PROA_REP_GEMV; ++rep_g)
      for (int it = vcu; it < 4 * 192; it += G) { const int layer = it / 192, col0 = (it - layer * 192) * 64;
          const float* Wl = a.in[I_ADAW] + (size_t)layer * 2048 * 12288 + col0 + 4 * c4;
          float acc[5][4];
#pragma unroll
          for (int r = 0; r < 5; ++r)
#pragma unroll
              for (int e = 0; e < 4; ++e) acc[r][e] = 0.f;
#pragma unroll 8
          for (int j = 0; j < 64; ++j) { const int k = wave * 256 + 4 * j + kq; const f32x4 w = *(const f32x4*)(Wl + (size_t)k * 12288);
#pragma unroll
              for (int r = 0; r < 5; ++r) { const float s = sc[r * 2048 + k]; acc[r][0] += s * w[0]; acc[r][1] += s * w[1]; acc[r][2] += s * w[2]; acc[r][3] += s * w[3]; } }
#pragma unroll
          for (int r = 0; r < 5; ++r)
#pragma unroll
              for (int e = 0; e < 4; ++e) { float v = acc[r][e]; v += shx(v, 16, lane); v += shx(v, 32, lane); acc[r][e] = v; }
          if (lane < 16) {
#pragma unroll
              for (int r = 0; r < 5; ++r)
#pragma unroll
                  for (int e = 0; e < 4; ++e) red[(wave * 5 + r) * 64 + 4 * c4 + e] = acc[r][e]; }
          __syncthreads();
          if (tid < 320) { const int r = tid >> 6, c = tid & 63; float s = 0.f;
#pragma unroll
              for (int w = 0; w < 8; ++w) s += red[(w * 5 + r) * 64 + c];
              mod[((size_t)layer * 5 + r) * 12288 + col0 + c] = s + a.in[I_ADAB][(size_t)layer * 12288 + col0 + c]; }
          __syncthreads(); }
    }
}

__device__ __forceinline__ const float* src_row(const Args& a, int r, int& r5) {
    const int b = r / TPB, t = r - b * TPB;
    if (t < SEQ) { r5 = b; return a.in[I_X] + ((size_t)b * SEQ + t) * D; }
    r5 = 4; return a.in[I_CTX] + ((size_t)b * CTXL + (t - SEQ)) * D;
}
__device__ __forceinline__ void phase_pro_b(const Args& a, int lane, int wave, int vcu, int G) {
    const int gw = vcu * NWAVES + wave, NGW = G * NWAVES; const float* mod = (const float*)(a.ws + WS_MOD);
    bf16* U = (bf16*)(a.ws + WS_U);
    for (int r = gw; r < M; r += NGW) { int r5; const float* src = src_row(a, r, r5); const float* sh = mod + (size_t)r5 * 12288, *scl = sh + 2048;
#pragma unroll
        for (int j = 0; j < 8; ++j) { const int c = 4 * lane + 256 * j; const f32x4 v = *(const f32x4*)(src + c), s = *(const f32x4*)(scl + c), t = *(const f32x4*)(sh + c);
            const f32x4 uu = v * (1.0f + s) + t;
            v2u w; w.x = cvt_pk_bf16(uu[0], uu[1]); w.y = cvt_pk_bf16(uu[2], uu[3]); *(v2u*)(U + (size_t)r * D + c) = w; } }
}
template <bool FIRST> __device__ __forceinline__ void phase_ln_t(const Args& a, int layer, int which, LAS unsigned char* lds, int tid, int lane, int wave, int vcu, int G, bool dry) {
    const float* mod = (const float*)(a.ws + WS_MOD);
    const h16* H = (const h16*)(a.ws + WS_H); h16* Hw = (h16*)(a.ws + (dry ? WS_END : WS_H)); bf16* U = (bf16*)(a.ws + (dry ? WS_END + 136 * MiB : WS_U)); const bf16* Y = (const bf16*)(a.ws + WS_Y);
    const bool latonly = (layer == DEPTH - 1), final = (layer == DEPTH - 1) && which == 1; const bool ysplit = !latonly; const float* YP = (const float*)(a.ws + WS_YP);
    const float* lg = a.in[I_LNG] + ((size_t)layer * 2 + which) * D; const float* lb = a.in[I_LNB] + ((size_t)layer * 2 + which) * D;
    const int gch = which ? 5 : 2; const int nlayer = final ? 0 : (which ? layer + 1 : layer), nsh = which ? 0 : 3;
    const int nrows = latonly ? BATCH * SEQ : M, rpc = nrows / G;
    LAS float* V = (LAS float*)lds;
    if (G != 256) return;
    const int bb = vcu >> 6, c6 = vcu & 63; const int i0 = 0;
    __syncthreads();
    {
        const int i4 = 4 * tid; f32x4 v8[8];
#pragma unroll
        for (int v = 0; v < 2; ++v) { const int r5 = v ? 4 : bb;
            v8[v * 3 + 0] = *(const f32x4*)(mod + ((size_t)layer * 5 + r5) * 12288 + gch * 2048 + i4);
            v8[v * 3 + 1] = *(const f32x4*)(mod + ((size_t)nlayer * 5 + r5) * 12288 + nsh * 2048 + i4);
            v8[v * 3 + 2] = *(const f32x4*)(mod + ((size_t)nlayer * 5 + r5) * 12288 + (nsh + 1) * 2048 + i4); }
        v8[6] = *(const f32x4*)(lg + i4); v8[7] = *(const f32x4*)(lb + i4);
#pragma unroll
        for (int v = 0; v < 8; ++v) *(LAS f32x4*)(V + v * 2048 + i4) = v8[v]; }

    __syncthreads();
    for (int k = wave; k < rpc; k += 2 * NWAVES) {
        f32x4 z[2][8]; int rr[2], tt[2]; bool ok[2];
#pragma unroll
        for (int q = 0; q < 2; ++q) { const int kk = k + q * NWAVES; ok[q] = kk < rpc; const int ii = ok[q] ? kk : 0;
            const int t = (ii < 64) ? c6 * 64 + ii : SEQ + c6 * 4 + (ii - 64); const int r = bb * TPB + t; rr[q] = r; tt[q] = t;
            const LAS float* gate = V + (t < SEQ ? 0 : 3) * 2048;
            const float* xrow = (t < SEQ) ? a.in[I_X] + ((size_t)bb * SEQ + t) * D : a.in[I_CTX] + ((size_t)bb * CTXL + (t - SEQ)) * D; const h16* hrow = H + (size_t)r * D;
            f32x4 hv[8], yv[8];
            if (FIRST) {
#pragma unroll
                for (int j = 0; j < 8; ++j) hv[j] = *(const f32x4*)(xrow + 4 * lane + 256 * j);
            } else {
#pragma unroll
                for (int j = 0; j < 8; ++j) hv[j] = __builtin_convertvector(*(const h16x4*)(hrow + 4 * lane + 256 * j), f32x4);
            }
            if (ysplit && t >= SEQ) { const float* yp = YP + ((size_t)bb * CTXL + (t - SEQ)) * D + 4 * lane;
#pragma unroll
                for (int jh = 0; jh < 2; ++jh) { f32x4 p[4][4];
#pragma unroll
                    for (int jj = 0; jj < 4; ++jj)
#pragma unroll
                        for (int s4 = 0; s4 < 4; ++s4) p[jj][s4] = *(const f32x4*)(yp + 256 * (4 * jh + jj) + (size_t)s4 * 1024 * D);
#pragma unroll
                    for (int jj = 0; jj < 4; ++jj) yv[4 * jh + jj] = (p[jj][0] + p[jj][1]) + (p[jj][2] + p[jj][3]); }
            } else {
#pragma unroll
                for (int j = 0; j < 8; ++j) { const v2u yw = *(const v2u*)(Y + (size_t)r * D + 4 * lane + 256 * j); yv[j] = (f32x4){bflo(yw.x), bfhi(yw.x), bflo(yw.y), bfhi(yw.y)}; }
            }
#pragma unroll
            for (int j = 0; j < 8; ++j) { const int c = 4 * lane + 256 * j; const f32x4 g = *(const LAS f32x4*)(gate + c);
                z[q][j] = hv[j] * ALPHA + g * yv[j]; } }
        float s0 = 0.f, s1 = 0.f;
#pragma unroll
        for (int j = 0; j < 8; ++j) { s0 += (z[0][j][0] + z[0][j][1]) + (z[0][j][2] + z[0][j][3]); s1 += (z[1][j][0] + z[1][j][1]) + (z[1][j][2] + z[1][j][3]); }
#pragma unroll
        for (int o = 1; o < 64; o <<= 1) { s0 += shx(s0, o, lane); s1 += shx(s1, o, lane); }
        const float m0 = s0 * (1.0f / D), m1 = s1 * (1.0f / D); float q0 = 0.f, q1 = 0.f;
#pragma unroll
        for (int j = 0; j < 8; ++j) { z[0][j] = z[0][j] - m0; z[1][j] = z[1][j] - m1;
            q0 += (z[0][j][0] * z[0][j][0] + z[0][j][1] * z[0][j][1]) + (z[0][j][2] * z[0][j][2] + z[0][j][3] * z[0][j][3]);
            q1 += (z[1][j][0] * z[1][j][0] + z[1][j][1] * z[1][j][1]) + (z[1][j][2] * z[1][j][2] + z[1][j][3] * z[1][j][3]); }
#pragma unroll
        for (int o = 1; o < 64; o <<= 1) { q0 += shx(q0, o, lane); q1 += shx(q1, o, lane); }
        const float rs[2] = {rsqrtf(q0 * (1.0f / D) + LN_EPS), rsqrtf(q1 * (1.0f / D) + LN_EPS)};
#pragma unroll
        for (int q = 0; q < 2; ++q) { if (!ok[q]) continue; const int r = rr[q], t = tt[q]; const LAS float* nm = V + ((t < SEQ ? 0 : 3) + 1) * 2048;
#pragma unroll
            for (int j = 0; j < 8; ++j) { const int c = 4 * lane + 256 * j; const f32x4 gg = *(const LAS f32x4*)(V + 6 * 2048 + c), bv = *(const LAS f32x4*)(V + 7 * 2048 + c);
                const f32x4 hn = z[q][j] * rs[q] * gg + bv;
                if (final) { if (!dry) *(f32x4*)(a.out + ((size_t)bb * SEQ + t) * D + c) = hn; else *(h16x4*)(Hw + (size_t)r * D + c) = __builtin_convertvector(hn, h16x4); }
                else { *(h16x4*)(Hw + (size_t)r * D + c) = __builtin_convertvector(hn, h16x4); const f32x4 sh = *(const LAS f32x4*)(nm + c), sc = *(const LAS f32x4*)(nm + 2048 + c); const f32x4 uu = hn * (1.0f + sc) + sh;
                    v2u w; w.x = cvt_pk_bf16(uu[0], uu[1]); w.y = cvt_pk_bf16(uu[2], uu[3]); *(v2u*)(U + (size_t)r * D + c) = w; } } }
    }
    __syncthreads();
}
__device__ __forceinline__ void phase_ln(const Args& a, int layer, int which, LAS unsigned char* lds, int tid, int lane, int wave, int vcu, int G, bool dry = false) {
    if (layer == 0 && which == 0) phase_ln_t<true>(a, layer, which, lds, tid, lane, wave, vcu, G, dry); else phase_ln_t<false>(a, layer, which, lds, tid, lane, wave, vcu, G, dry);
}
__device__ __forceinline__ void phase_mla_norm(const Args& a, int ml, int lane, int wave, int vcu, int G) {
    const int gw = vcu * NWAVES + wave, NGW = G * NWAVES;
    const float* C = (const float*)(a.ws + WS_CQKV); bf16* CQN = (bf16*)(a.ws + WS_CQN); bf16* CKVN = (bf16*)(a.ws + WS_CKVN); bf16* KR = (bf16*)(a.ws + WS_KR);
    const float* gq = a.in[I_MGQ] + (size_t)ml * 512; const float* gkv = a.in[I_MGKV] + (size_t)ml * 512; const f32x2* acs = (const f32x2*)(a.ws + WS_ACS);
    for (int r = gw; r < M; r += NGW) { const float* row = C + (size_t)r * 1280; const int b = r / TPB, t = r - b * TPB;
        f32x4 q0 = *(const f32x4*)(row + 4 * lane), q1 = *(const f32x4*)(row + 256 + 4 * lane), k0 = *(const f32x4*)(row + 512 + 4 * lane), k1 = *(const f32x4*)(row + 768 + 4 * lane);
        float sq = (q0[0] * q0[0] + q0[1] * q0[1]) + (q0[2] * q0[2] + q0[3] * q0[3]) + (q1[0] * q1[0] + q1[1] * q1[1]) + (q1[2] * q1[2] + q1[3] * q1[3]);
        float sk = (k0[0] * k0[0] + k0[1] * k0[1]) + (k0[2] * k0[2] + k0[3] * k0[3]) + (k1[0] * k1[0] + k1[1] * k1[1]) + (k1[2] * k1[2] + k1[3] * k1[3]);
        const float rq = rsqrtf(wave_sum(sq, lane) * (1.0f / 512.0f) + RMS_EPS), rk = rsqrtf(wave_sum(sk, lane) * (1.0f / 512.0f) + RMS_EPS);
        const f32x4 g0 = *(const f32x4*)(gq + 4 * lane), g1 = *(const f32x4*)(gq + 256 + 4 * lane), h0 = *(const f32x4*)(gkv + 4 * lane), h1 = *(const f32x4*)(gkv + 256 + 4 * lane);
        q0 = q0 * rq * g0; q1 = q1 * rq * g1; k0 = k0 * rk * h0; k1 = k1 * rk * h1;
        v2u w; w.x = cvt_pk_bf16(q0[0], q0[1]); w.y = cvt_pk_bf16(q0[2], q0[3]); *(v2u*)(CQN + (size_t)r * 512 + 4 * lane) = w;
        w.x = cvt_pk_bf16(q1[0], q1[1]); w.y = cvt_pk_bf16(q1[2], q1[3]); *(v2u*)(CQN + (size_t)r * 512 + 256 + 4 * lane) = w;
        w.x = cvt_pk_bf16(k0[0], k0[1]); w.y = cvt_pk_bf16(k0[2], k0[3]); *(v2u*)(CKVN + (size_t)r * 512 + 4 * lane) = w;
        w.x = cvt_pk_bf16(k1[0], k1[1]); w.y = cvt_pk_bf16(k1[2], k1[3]); *(v2u*)(CKVN + (size_t)r * 512 + 256 + 4 * lane) = w;
        if (lane < 32) { f32x2 kr = *(const f32x2*)(row + 1024 + 2 * lane);
            if (t < SEQ) { const f32x2 cs = acs[(size_t)t * 32 + lane]; kr = (f32x2){kr[0] * cs[0] - kr[1] * cs[1], kr[0] * cs[1] + kr[1] * cs[0]}; }
            *(unsigned*)(KR + (size_t)r * 64 + 2 * lane) = cvt_pk_bf16(kr[0], kr[1]); } }
}

constexpr int RQ_RS = 528, RV_RS = 288, RP_RS = 144;
__device__ __forceinline__ int koff(int row, int ch32) { const int f = ((row & 3) << 2) | ((row >> 2) & 3); return (ch32 >> 4) * 16384 + row * 256 + (((ch32 & 15) ^ f) << 4); }
constexpr int RL_Q = 0, RL_K = RL_Q + 64 * RQ_RS, RL_V = RL_K + 32768, RL_P = RL_V + 64 * RV_RS, RL_OT = RL_P + 64 * RP_RS, RL_FAC = RL_OT + 64 * 272, RL_END = RL_FAC + 4 * 64 * 4;
constexpr int ROT_RS = 272;
static_assert(RL_END <= RING_BYTES, "retention LDS map");
template <int OFF> __device__ __forceinline__ s16x4 tr_read(int addr) {
    s16x4 r; asm volatile("ds_read_b64_tr_b16 %0, %1 offset:%2" : "=&v"(r) : "v"(addr), "i"(OFF) : "memory"); return r;
}
template <int CTL> __device__ __forceinline__ float dpp_ctl(float v) { return __int_as_float(__builtin_amdgcn_update_dpp(0, __float_as_int(v), CTL, 0xf, 0xf, false)); }
template <int N> __device__ __forceinline__ float dpp_ror(float v) { return __int_as_float(__builtin_amdgcn_update_dpp(0, __float_as_int(v), 0x120 + N, 0xf, 0xf, false)); }
__device__ __forceinline__ bf16x8 cat4(s16x4 l, s16x4 h) { return (bf16x8){l[0], l[1], l[2], l[3], h[0], h[1], h[2], h[3]}; }

__device__ __forceinline__ void phase_ret_scan(const Args& a, int rl, LAS unsigned char* lds, int tid, int lane, int wave, int vcu, int G) {
    const bf16* Qg = (const bf16*)(a.ws + WS_RQ); const bf16* Kg = (const bf16*)(a.ws + WS_RK); const bf16* Vg = (const bf16*)(a.ws + WS_RV);
    bf16* OFg = (bf16*)(a.ws + WS_OF); bf16* OBg = (bf16*)(a.ws + WS_OB); f32x2* part = (f32x2*)(a.ws + WS_PART);
    LAS float* fac = (LAS float*)(lds + RL_FAC);
    const int ldsb = (int)(uintptr_t)lds;
    for (int item = vcu; item < 256; item += G) {
        const int slice = item & 3, dir = (item >> 2) & 1, h = (item >> 3) & 7, b = item >> 6;
        __syncthreads();
        if (tid < 64) { const float x = a.in[I_RDEC][(size_t)rl * 16 + dir * 8 + h]; const float lg = -log1pf(expf(-x));
            const int i = tid;
            fac[i] = dir ? expf(-lg * (float)i) : expf(lg * (float)(i - 63));
            fac[64 + i] = dir ? expf(lg * (float)(64 - i)) : expf(lg * (float)(i + 1));
            fac[128 + i] = dir ? expf(lg * (float)i) : expf(lg * (float)(63 - i));
            if (i == 0) fac[192] = expf(lg * 64.0f); }
        __syncthreads();
#define RET_ROWBASE(n) ({ int _cc, _rb; if ((n) < 4) { _cc = dir ? 3 - (n) : (n); _rb = b * TPB + SEQ + 64 * _cc; } else { _cc = dir ? 63 - ((n) - 4) : (n) - 4; _rb = b * TPB + 64 * _cc; } _rb; })
        if (wave < 4) {
            __builtin_amdgcn_s_setprio(2);
            int lane_c = lane; asm volatile("" : "+v"(lane_c));
            const int g = lane_c >> 4, c16 = lane_c & 15, q4 = c16 >> 2, p4 = lane_c & 3;
            const int cw = wave, sa = cw >> 1, sb = cw & 1;
            const float cdec = fac[192];
            const float pf[2] = {fac[16 * (2 * sa) + c16], fac[16 * (2 * sa + 1) + c16]};
            int kb[4][2];
#pragma unroll
            for (int u = 0; u < 4; ++u)
#pragma unroll
                for (int t = 0; t < 2; ++t) { const int row = 8 * g + 4 * t + q4, f = ((row & 3) << 2) | ((row >> 2) & 3); kb[u][t] = ldsb + RL_K + row * 256 + (((4 * u + p4) ^ f) << 4); }
            pg8::f32x4 S[2][16];
#pragma unroll
            for (int nb = 0; nb < 2; ++nb)
#pragma unroll
                for (int T = 0; T < 16; ++T) S[nb][T] = (pg8::f32x4){0.f, 0.f, 0.f, 0.f};
            for (int n = 0; n < 68; ++n) {
                __syncthreads();
                { pg8::f32x4 sc[2][2];
#pragma unroll
                  for (int ti = 0; ti < 2; ++ti)
#pragma unroll
                      for (int tj = 0; tj < 2; ++tj) sc[ti][tj] = (pg8::f32x4){0.f, 0.f, 0.f, 0.f};
                  bf16x8 fq_[2][2], fa_[2][2];
#pragma unroll
                  for (int t = 0; t < 2; ++t) { fq_[0][t] = *(const LAS bf16x8*)(lds + RL_Q + (16 * (2 * sa + t) + c16) * RQ_RS + (8 * g) * 2); fa_[0][t] = *(const LAS bf16x8*)(lds + RL_K + koff(16 * (2 * sb + t) + c16, g)); }
#pragma unroll
                  for (int s = 0; s < 8; ++s) {
                      if (s < 7) {
#pragma unroll
                          for (int t = 0; t < 2; ++t) { fq_[(s + 1) & 1][t] = *(const LAS bf16x8*)(lds + RL_Q + (16 * (2 * sa + t) + c16) * RQ_RS + (32 * (s + 1) + 8 * g) * 2);
                              fa_[(s + 1) & 1][t] = *(const LAS bf16x8*)(lds + RL_K + koff(16 * (2 * sb + t) + c16, 4 * (s + 1) + g)); } }
#pragma unroll
                      for (int ti = 0; ti < 2; ++ti)
#pragma unroll
                          for (int tj = 0; tj < 2; ++tj) sc[ti][tj] = __builtin_amdgcn_mfma_f32_16x16x32_bf16(fa_[s & 1][tj], fq_[s & 1][ti], sc[ti][tj], 0, 0, 0); }
#pragma unroll
                  for (int ti = 0; ti < 2; ++ti) { const int i = 16 * (2 * sa + ti) + c16;
#pragma unroll
                      for (int tj = 0; tj < 2; ++tj) { const pg8::f32x4 scv = sc[ti][tj]; const int j0 = 16 * (2 * sb + tj) + 4 * g; float pv[4];
#pragma unroll
                          for (int r = 0; r < 4; ++r) { const int j = j0 + r; const bool keep = dir ? (j >= i) : (j <= i); pv[r] = keep ? scv[r] * pf[ti] : 0.f; }
                          v2u w; w.x = cvt_pk_bf16(pv[0], pv[1]); w.y = cvt_pk_bf16(pv[2], pv[3]);
                          *(LAS v2u*)(lds + RL_P + i * RP_RS + j0 * 2) = w; } } }
                pg8::f32x4 o[2][4];
#pragma unroll
                for (int nb = 0; nb < 2; ++nb)
#pragma unroll
                    for (int ib = 0; ib < 4; ++ib) o[nb][ib] = (pg8::f32x4){0.f, 0.f, 0.f, 0.f};
                { bf16x8 aq[2][4];
#pragma unroll
                  for (int ib = 0; ib < 4; ++ib) aq[0][ib] = *(const LAS bf16x8*)(lds + RL_Q + (16 * ib + c16) * RQ_RS + (8 * g) * 2);
#pragma unroll
                  for (int s = 0; s < 8; ++s) {
                      if (s < 7) {
#pragma unroll
                          for (int ib = 0; ib < 4; ++ib) aq[(s + 1) & 1][ib] = *(const LAS bf16x8*)(lds + RL_Q + (16 * ib + c16) * RQ_RS + (32 * (s + 1) + 8 * g) * 2); }
                      bf16x8 bs[2];
#pragma unroll
                      for (int nb = 0; nb < 2; ++nb) { v4u bw; bw.x = cvt_pk_bf16(S[nb][2 * s][0], S[nb][2 * s][1]); bw.y = cvt_pk_bf16(S[nb][2 * s][2], S[nb][2 * s][3]); bw.z = cvt_pk_bf16(S[nb][2 * s + 1][0], S[nb][2 * s + 1][1]); bw.w = cvt_pk_bf16(S[nb][2 * s + 1][2], S[nb][2 * s + 1][3]);
                          bs[nb] = __builtin_bit_cast(bf16x8, bw); }
#pragma unroll
                      for (int ib = 0; ib < 4; ++ib)
#pragma unroll
                          for (int nb = 0; nb < 2; ++nb) o[nb][ib] = __builtin_amdgcn_mfma_f32_16x16x32_bf16(aq[s & 1][ib], bs[nb], o[nb][ib], 0, 0, 0); } }
#pragma unroll
                for (int ib = 0; ib < 4; ++ib)
#pragma unroll
                    for (int r = 0; r < 4; ++r) { const float qf = fac[64 + 16 * ib + 4 * g + r]; o[0][ib][r] *= qf; o[1][ib][r] *= qf; }
                bf16x8 bv[2][2];
                { const int va = ldsb + RL_V + (8 * g + q4) * RV_RS + (32 * cw + 4 * p4) * 2;
                  const s16x4 l0 = tr_read<0>(va), h0 = tr_read<4 * RV_RS>(va), l1 = tr_read<32 * RV_RS>(va), h1 = tr_read<36 * RV_RS>(va);
                  const s16x4 m0 = tr_read<32>(va), n0 = tr_read<32 + 4 * RV_RS>(va), m1 = tr_read<32 + 32 * RV_RS>(va), n1 = tr_read<32 + 36 * RV_RS>(va);
                  LDS_WAIT(); SBAR();
                  bv[0][0] = cat4(l0, h0); bv[0][1] = cat4(l1, h1); bv[1][0] = cat4(m0, n0); bv[1][1] = cat4(m1, n1); }
                {
#define KTR(T, ks, t) tr_read<(ks) * 8192 + ((T) >> 3) * 16384 + ((T) & 1) * 8>(kb[((T) >> 1) & 3][t])
#define KLOAD(T, L0, H0, L1, H1) do { L0 = KTR(T, 0, 0); H0 = KTR(T, 0, 1); L1 = KTR(T, 1, 0); H1 = KTR(T, 1, 1); } while (0)
#define KMMA(T, L0, H0, L1, H1) do { const bf16x8 A0_ = cat4(L0, H0), A1_ = cat4(L1, H1); \
                      pg8::f32x4 ac0_ = S[0][T] * cdec, ac1_ = S[1][T] * cdec; \
                      ac0_ = __builtin_amdgcn_mfma_f32_16x16x32_bf16(A0_, bv[0][0], ac0_, 0, 0, 0); ac1_ = __builtin_amdgcn_mfma_f32_16x16x32_bf16(A0_, bv[1][0], ac1_, 0, 0, 0); \
                      ac0_ = __builtin_amdgcn_mfma_f32_16x16x32_bf16(A1_, bv[0][1], ac0_, 0, 0, 0); ac1_ = __builtin_amdgcn_mfma_f32_16x16x32_bf16(A1_, bv[1][1], ac1_, 0, 0, 0); \
                      S[0][T] = ac0_; S[1][T] = ac1_; } while (0)
                  s16x4 xa0, xa1, xa2, xa3, ya0, ya1, ya2, ya3;
                  KLOAD(0, xa0, xa1, xa2, xa3);
#define KGROUP(T, LAST) do { KLOAD(T + 1, ya0, ya1, ya2, ya3); \
                      asm volatile("s_waitcnt lgkmcnt(4)" ::: "memory"); SBAR(); \
                      KMMA(T, xa0, xa1, xa2, xa3); \
                      if (!(LAST)) { KLOAD(((T) + 2) & 15, xa0, xa1, xa2, xa3); asm volatile("s_waitcnt lgkmcnt(4)" ::: "memory"); } \
                      else asm volatile("s_waitcnt lgkmcnt(0)" ::: "memory"); \
                      SBAR(); \
                      KMMA(T + 1, ya0, ya1, ya2, ya3); } while (0)
                  KGROUP(0, false); KGROUP(2, false); KGROUP(4, false); KGROUP(6, false); KGROUP(8, false); KGROUP(10, false); KGROUP(12, false); KGROUP(14, true);
#undef KGROUP
#undef KTR
#undef KLOAD
#undef KMMA
                }
                __syncthreads();
#pragma unroll
                for (int ks = 0; ks < 2; ++ks)
#pragma unroll
                    for (int ib = 0; ib < 4; ++ib) { const bf16x8 ap = *(const LAS bf16x8*)(lds + RL_P + (16 * ib + c16) * RP_RS + (32 * ks + 8 * g) * 2);
                        o[0][ib] = __builtin_amdgcn_mfma_f32_16x16x32_bf16(ap, bv[0][ks], o[0][ib], 0, 0, 0); o[1][ib] = __builtin_amdgcn_mfma_f32_16x16x32_bf16(ap, bv[1][ks], o[1][ib], 0, 0, 0); }
#pragma unroll
                for (int nb = 0; nb < 2; ++nb)
#pragma unroll
                    for (int ib = 0; ib < 4; ++ib)
#pragma unroll
                        for (int r = 0; r < 4; ++r) *(LAS unsigned short*)(lds + RL_OT + (16 * ib + 4 * g + r) * ROT_RS + (32 * cw + 16 * nb + c16) * 2) = __builtin_bit_cast(unsigned short, (__bf16)o[nb][ib][r]);
            }
            __builtin_amdgcn_s_setprio(0);
            __syncthreads();
        } else {
            int lt_ = tid - 256; asm volatile("" : "+v"(lt_)); const int lt = lt_; bf16* Og = dir ? OBg : OFg;
            const int qrow = lt >> 5, qch = lt & 31, vrow = lt >> 4, vch = lt & 15;
            v4u sq[8], sk[8], sv[4];
#define RET_LOAD(n) do { const int _rb = RET_ROWBASE(n); \
            _Pragma("unroll") for (int e = 0; e < 8; ++e) { sq[e] = *(const v4u*)(Qg + (size_t)(_rb + qrow + 8 * e) * 2048 + h * 256 + qch * 8); sk[e] = *(const v4u*)(Kg + (size_t)(_rb + qrow + 8 * e) * 2048 + h * 256 + qch * 8); } \
            _Pragma("unroll") for (int e = 0; e < 4; ++e) sv[e] = *(const v4u*)(Vg + (size_t)(_rb + vrow + 16 * e) * 4096 + h * 512 + slice * 128 + vch * 8); } while (0)
#define RET_STAGE() do { \
            _Pragma("unroll") for (int e = 0; e < 8; ++e) { *(LAS v4u*)(lds + RL_Q + (qrow + 8 * e) * RQ_RS + qch * 16) = sq[e]; *(LAS v4u*)(lds + RL_K + koff(qrow + 8 * e, qch)) = sk[e]; } \
            _Pragma("unroll") for (int e = 0; e < 4; ++e) { const float vf = fac[128 + vrow + 16 * e]; v4u w; \
                w.x = cvt_pk_bf16(bflo(sv[e].x) * vf, bfhi(sv[e].x) * vf); w.y = cvt_pk_bf16(bflo(sv[e].y) * vf, bfhi(sv[e].y) * vf); \
                w.z = cvt_pk_bf16(bflo(sv[e].z) * vf, bfhi(sv[e].z) * vf); w.w = cvt_pk_bf16(bflo(sv[e].w) * vf, bfhi(sv[e].w) * vf); \
                *(LAS v4u*)(lds + RL_V + (vrow + 16 * e) * RV_RS + vch * 16) = w; } } while (0)
#define RET_OSTORE(n) do { const int rowprev = RET_ROWBASE(n); \
            _Pragma("unroll") for (int e = 0; e < 2; ++e) { const int orow = (lt >> 3) + 32 * e, ocg = lt & 7; const LAS v4u* op = (const LAS v4u*)(lds + RL_OT + orow * ROT_RS + ocg * 32); const v4u w0 = op[0], w1 = op[1]; \
              float s1 = 0.f, s2 = 0.f; \
              _Pragma("unroll") for (int q = 0; q < 4; ++q) { const float a0 = bflo(w0[q]), a1 = bfhi(w0[q]), b0 = bflo(w1[q]), b1 = bfhi(w1[q]); s1 += (a0 + a1) + (b0 + b1); s2 += (a0 * a0 + a1 * a1) + (b0 * b0 + b1 * b1); } \
              s1 += dpp_ctl<0xB1>(s1); s2 += dpp_ctl<0xB1>(s2); s1 += dpp_ctl<0x4E>(s1); s2 += dpp_ctl<0x4E>(s2); s1 += dpp_ctl<0x141>(s1); s2 += dpp_ctl<0x141>(s2); \
              v4u* gp = (v4u*)(Og + (size_t)(rowprev + orow) * 4096 + h * 512 + slice * 128 + ocg * 16); gp[0] = w0; gp[1] = w1; \
              if (ocg == 0) part[(size_t)(rowprev + orow) * 64 + h * 8 + dir * 4 + slice] = (f32x2){s1, s2}; } } while (0)
            RET_LOAD(0);
            RET_STAGE();
            for (int n = 0; n < 68; ++n) {
                __syncthreads();
                if (n + 1 < 68) RET_LOAD(n + 1);
                if (n > 0) RET_OSTORE(n - 1);
                __syncthreads();
                if (n + 1 < 68) RET_STAGE();
            }
            __syncthreads();
            RET_OSTORE(67);
#undef RET_LOAD
#undef RET_STAGE
#undef RET_OSTORE
        }
#undef RET_ROWBASE
    }
}

namespace att {
constexpr int KVBLK = 64, QBLK = 32;
constexpr int LDQ = 3072, LDKN = 2048, LDKR = 64, LDV = 2048, LDO = 2048;
constexpr float SCALE = MLA_SCALE;
constexpr float THR = 8.f;
constexpr int SHM_V = KVBLK * 128 * 2, SHM_K = KVBLK * 128 * 2, SHM_R = KVBLK * 64 * 2;
constexpr int L_V = 0, L_K = 2 * SHM_V, L_R = L_K + 2 * SHM_K, L_WS = L_R + 2 * SHM_R, L_END = L_WS + NWAVES * 64 * 4;
static_assert(L_END <= RING_BYTES, "attention LDS map");
#define KSWZ(row, colB) ((row) * 256 + ((colB) ^ (((row) & 7) << 4)))
#define RSWZ(row, colB) ((row) * 128 + ((colB) ^ (((row) & 7) << 4)))
__device__ __forceinline__ int crow(int r, int hi) { return (r & 3) + 8 * (r >> 2) + 4 * hi; }
__device__ __forceinline__ void partialSM(f32x16& p0, f32x16& p1, float& m_reg, float& mn, float& alpha) {
  constexpr float C = SCALE * 1.4426950408889634f;
  float pmax = p0[0];
#pragma unroll
  for (int r = 1; r < 16; ++r) pmax = fmaxf(pmax, p0[r]);
#pragma unroll
  for (int r = 0; r < 16; ++r) pmax = fmaxf(pmax, p1[r]);
  { auto rr = __builtin_amdgcn_permlane32_swap(__float_as_uint(pmax), __float_as_uint(pmax), false, false);
    pmax = fmaxf(__uint_as_float(rr[0]), __uint_as_float(rr[1])); }
  if (__builtin_expect(__all(pmax - m_reg <= THR / SCALE), 1)) { mn = m_reg; alpha = 1.f; }
  else { mn = fmaxf(m_reg, pmax); alpha = __builtin_amdgcn_exp2f((m_reg - mn) * C); m_reg = mn; }
  const float mnC = -mn * C;
#pragma unroll
  for (int r = 0; r < 16; ++r) p0[r] = fmaf(p0[r], C, mnC);
#pragma unroll
  for (int r = 0; r < 16; ++r) p1[r] = fmaf(p1[r], C, mnC);
#pragma unroll
  for (int r = 0; r < 16; ++r) p0[r] = __builtin_amdgcn_exp2f(p0[r]);
}
__device__ __forceinline__ void finishSM(f32x16& p0, f32x16& p1, float alpha, float& l_reg, bf16x8& pa0, bf16x8& pa1, bf16x8& pa2, bf16x8& pa3) {
#pragma unroll
  for (int r = 0; r < 16; ++r) p1[r] = __builtin_amdgcn_exp2f(p1[r]);
  float ps = 0;
#pragma unroll
  for (int r = 0; r < 16; ++r) ps += p0[r];
#pragma unroll
  for (int r = 0; r < 16; ++r) ps += p1[r];
  { auto rr = __builtin_amdgcn_permlane32_swap(__float_as_uint(ps), __float_as_uint(ps), false, false);
    ps = __uint_as_float(rr[0]) + __uint_as_float(rr[1]); }
  l_reg = l_reg * alpha + ps;
#define PK4(P, BASE, OUT) do { unsigned a0 = cvt_pk_bf16(P[BASE + 0], P[BASE + 1]), a1 = cvt_pk_bf16(P[BASE + 2], P[BASE + 3]);   \
    unsigned b0 = cvt_pk_bf16(P[BASE + 4], P[BASE + 5]), b1 = cvt_pk_bf16(P[BASE + 6], P[BASE + 7]);                              \
    auto r0 = __builtin_amdgcn_permlane32_swap(a0, b0, false, false); auto r1 = __builtin_amdgcn_permlane32_swap(a1, b1, false, false); \
    v4u w = {r0[0], r1[0], r0[1], r1[1]}; OUT = __builtin_bit_cast(bf16x8, w); } while (0)
  PK4(p0, 0, pa0); PK4(p0, 8, pa1); PK4(p1, 0, pa2); PK4(p1, 8, pa3);
#undef PK4
}
__device__ __forceinline__ void qkt(f32x16& p0, f32x16& p1, const LAS unsigned char* Ks, const LAS unsigned char* Rs, const bf16x8 (&qr)[12], int r32, int hi) {
  p0 = f32x16{}; p1 = f32x16{};
#pragma unroll
  for (int d0 = 0; d0 < 8; ++d0) { const int cb = (d0 * 16 + hi * 8) * 2;
    const bf16x8 b0 = *(const LAS bf16x8*)(Ks + KSWZ(r32, cb));
    const bf16x8 b1 = *(const LAS bf16x8*)(Ks + KSWZ(32 + r32, cb));
    p0 = __builtin_amdgcn_mfma_f32_32x32x16_bf16(b0, qr[d0], p0, 0, 0, 0);
    p1 = __builtin_amdgcn_mfma_f32_32x32x16_bf16(b1, qr[d0], p1, 0, 0, 0); }
#pragma unroll
  for (int d0 = 0; d0 < 4; ++d0) { const int cb = (d0 * 16 + hi * 8) * 2;
    const bf16x8 b0 = *(const LAS bf16x8*)(Rs + RSWZ(r32, cb));
    const bf16x8 b1 = *(const LAS bf16x8*)(Rs + RSWZ(32 + r32, cb));
    p0 = __builtin_amdgcn_mfma_f32_32x32x16_bf16(b0, qr[8 + d0], p0, 0, 0, 0);
    p1 = __builtin_amdgcn_mfma_f32_32x32x16_bf16(b1, qr[8 + d0], p1, 0, 0, 0); }
}
__device__ __forceinline__ int v_st(int k, int c) { const int kk = (k & ~0xC) | ((k & 4) << 1) | ((k & 8) >> 1); return ((kk >> 3) * 4 + (c >> 5)) * 512 + ((kk & 7) * 32 + (c & 31)) * 2; }
__device__ __forceinline__ int v_rd_base(int lane) { return ((lane & 3) << 3) | (((lane >> 2) & 3) << 6) | (((lane >> 4) & 1) << 5) | (((lane >> 5) & 1) << 8); }
constexpr int v_rd_off(int d0, int ks, int half) { return d0 * 512 + ks * 4096 + half * 2048; }
template <int D0> __device__ __forceinline__ void pv_one(f32x16& od, int vb, bf16x8 pa0, bf16x8 pa1, bf16x8 pa2, bf16x8 pa3) {
  const s16x4 l0 = tr_read<v_rd_off(D0, 0, 0)>(vb), h0 = tr_read<v_rd_off(D0, 0, 1)>(vb), l1 = tr_read<v_rd_off(D0, 1, 0)>(vb), h1 = tr_read<v_rd_off(D0, 1, 1)>(vb);
  const s16x4 l2 = tr_read<v_rd_off(D0, 2, 0)>(vb), h2 = tr_read<v_rd_off(D0, 2, 1)>(vb), l3 = tr_read<v_rd_off(D0, 3, 0)>(vb), h3 = tr_read<v_rd_off(D0, 3, 1)>(vb);
  asm volatile("s_waitcnt lgkmcnt(0)" ::: "memory"); SBAR();
  od = __builtin_amdgcn_mfma_f32_32x32x16_bf16(pa0, cat4(l0, h0), od, 0, 0, 0);
  od = __builtin_amdgcn_mfma_f32_32x32x16_bf16(pa1, cat4(l1, h1), od, 0, 0, 0);
  od = __builtin_amdgcn_mfma_f32_32x32x16_bf16(pa2, cat4(l2, h2), od, 0, 0, 0);
  od = __builtin_amdgcn_mfma_f32_32x32x16_bf16(pa3, cat4(l3, h3), od, 0, 0, 0);
}
__device__ __forceinline__ void pv_d0(f32x16* o, int vb, bf16x8 pa0, bf16x8 pa1, bf16x8 pa2, bf16x8 pa3) {
  pv_one<0>(o[0], vb, pa0, pa1, pa2, pa3); pv_one<1>(o[1], vb, pa0, pa1, pa2, pa3); pv_one<2>(o[2], vb, pa0, pa1, pa2, pa3); pv_one<3>(o[3], vb, pa0, pa1, pa2, pa3);
}
__device__ __forceinline__ void attn_body(const bf16* __restrict__ Qb, const bf16* __restrict__ Kn, const bf16* __restrict__ Kr, const bf16* __restrict__ Vh,
                                          bf16* __restrict__ Ob, int seq, LAS unsigned char* lds, int tid_in) {
  int tid_ = tid_in; asm volatile("" : "+v"(tid_));
  const int tid = tid_, wid = tid >> 6, lane = tid & 63, r32 = lane & 31, hi = lane >> 5;
  LAS unsigned char* V_lds = lds + L_V; LAS unsigned char* K_lds = lds + L_K; LAS unsigned char* R_lds = lds + L_R;
  LAS float* wsf = (LAS float*)(lds + L_WS) + wid * 64; LAS float* li_l = wsf; LAS float* al_l = wsf + 32;
  float m_reg = -1e30f, l_reg = 0; f32x16 o[4] = {}; bf16x8 qr[12];
  const bf16* Qw = Qb + (size_t)(wid * QBLK + r32) * LDQ + hi * 8;
#pragma unroll
  for (int d0 = 0; d0 < 12; ++d0) qr[d0] = *(const bf16x8*)(Qw + d0 * 16);
  const int sr = tid >> 4, sc = (tid & 15) * 8, vst0 = v_st(sr, sc), vst1 = v_st(32 + sr, sc);
  const int rr = tid >> 3, rc = (tid & 7) * 8;
  const int vb0 = (int)(uintptr_t)V_lds + v_rd_base(lane);
  bf16x8 vs0, vs1, ks0, ks1, rs0;
#define SLOAD(k0) do { vs0 = *(const bf16x8*)(Vh + (size_t)((k0) + sr) * LDV + sc); vs1 = *(const bf16x8*)(Vh + (size_t)((k0) + 32 + sr) * LDV + sc); \
    ks0 = *(const bf16x8*)(Kn + (size_t)((k0) + sr) * LDKN + sc); ks1 = *(const bf16x8*)(Kn + (size_t)((k0) + 32 + sr) * LDKN + sc); \
    rs0 = *(const bf16x8*)(Kr + (size_t)((k0) + rr) * LDKR + rc); } while (0)
#define SWRITE(b) do { *(LAS bf16x8*)(V_lds + (b) * SHM_V + vst0) = vs0; *(LAS bf16x8*)(V_lds + (b) * SHM_V + vst1) = vs1; const int kc = sc * 2; \
    *(LAS bf16x8*)(K_lds + (b) * SHM_K + KSWZ(sr, kc)) = ks0; *(LAS bf16x8*)(K_lds + (b) * SHM_K + KSWZ(32 + sr, kc)) = ks1; \
    *(LAS bf16x8*)(R_lds + (b) * SHM_R + RSWZ(rr, rc * 2)) = rs0; } while (0)
#define RESC(a) do { if (__any((a) < 1.f)) { if (hi == 0) al_l[r32] = (a); asm volatile("s_waitcnt lgkmcnt(0)" ::: "memory"); \
    _Pragma("unroll") for (int d = 0; d < 4; ++d) _Pragma("unroll") for (int r = 0; r < 16; ++r) o[d][r] *= al_l[crow(r, hi)]; } } while (0)
  f32x16 pA0, pA1, pB0, pB1; float mnA, mnB, alA, alB; bf16x8 pa0, pa1, pa2, pa3; const int NT = seq / KVBLK;
  SLOAD(0); VM_WAIT(); SWRITE(0); __syncthreads();
  qkt(pA0, pA1, K_lds, R_lds, qr, r32, hi); partialSM(pA0, pA1, m_reg, mnA, alA);
  SLOAD(KVBLK);
  VM_WAIT(); SWRITE(1); __syncthreads();
  for (int j = 1; j + 1 < NT; j += 2) {
    SBAR(); qkt(pB0, pB1, K_lds + SHM_K, R_lds + SHM_R, qr, r32, hi);
    finishSM(pA0, pA1, alA, l_reg, pa0, pa1, pa2, pa3); SBAR();
    SLOAD((j + 1) * KVBLK); SBAR();
    pv_d0(o, vb0, pa0, pa1, pa2, pa3); partialSM(pB0, pB1, m_reg, mnB, alB);
    __syncthreads(); VM_WAIT(); SWRITE(0);
    RESC(alB); __syncthreads();
    SBAR(); qkt(pA0, pA1, K_lds, R_lds, qr, r32, hi);
    finishSM(pB0, pB1, alB, l_reg, pa0, pa1, pa2, pa3); SBAR();
    SLOAD((j + 2) * KVBLK); SBAR();
    pv_d0(o, vb0 + SHM_V, pa0, pa1, pa2, pa3); partialSM(pA0, pA1, m_reg, mnA, alA);
    __syncthreads(); VM_WAIT(); SWRITE(1);
    RESC(alA); __syncthreads();
  }
  SBAR(); qkt(pB0, pB1, K_lds + SHM_K, R_lds + SHM_R, qr, r32, hi);
  finishSM(pA0, pA1, alA, l_reg, pa0, pa1, pa2, pa3); SBAR();
  pv_d0(o, vb0, pa0, pa1, pa2, pa3); partialSM(pB0, pB1, m_reg, mnB, alB);
  __syncthreads(); RESC(alB);
  finishSM(pB0, pB1, alB, l_reg, pa0, pa1, pa2, pa3); SBAR();
  pv_d0(o, vb0 + SHM_V, pa0, pa1, pa2, pa3);
  if (hi == 0) li_l[r32] = l_reg; asm volatile("s_waitcnt lgkmcnt(0)" ::: "memory");
  float rli[16];
#pragma unroll
  for (int r = 0; r < 16; ++r) rli[r] = __builtin_amdgcn_rcpf(li_l[crow(r, hi)]);
  bf16* Ow = Ob + (size_t)(wid * QBLK) * LDO;
#pragma unroll
  for (int r = 0; r < 16; ++r) { const int orow = crow(r, hi);
#pragma unroll
    for (int d0 = 0; d0 < 4; ++d0) Ow[(size_t)orow * LDO + d0 * 32 + r32] = (bf16)(cvt_pk_bf16(o[d0][r] * rli[r], 0.f) & 0xffffu); }
  __syncthreads();
#undef SLOAD
#undef SWRITE
#undef RESC
}
}

__device__ __forceinline__ void phase_attn(const Args& a, bool withctx, LAS unsigned char* lds, int tid, int vcu, int G) {
    const bf16* QB = (const bf16*)(a.ws + WS_QB); const bf16* KN = (const bf16*)(a.ws + WS_KN); const bf16* KR = (const bf16*)(a.ws + WS_KR); const bf16* VB = (const bf16*)(a.ws + WS_VB);
    bf16* AO = (bf16*)(a.ws + WS_AO);
    const int nunits = 1024 + (withctx ? 64 : 0);
    for (int u = vcu; u < nunits; u += G) {
        int b, h, qrow0, krow0, seq;
        if (u < 1024) { const int bh = u >> 4, qb = u & 15; b = bh >> 4; h = bh & 15; qrow0 = b * TPB + qb * 256; krow0 = b * TPB; seq = TPB; }
        else { const int v = u - 1024; b = v >> 4; h = v & 15; qrow0 = b * TPB + SEQ; krow0 = b * TPB + SEQ; seq = CTXL; }
        att::attn_body(QB + (size_t)qrow0 * 3072 + h * 192, KN + (size_t)krow0 * 2048 + h * 128, KR + (size_t)krow0 * 64, VB + (size_t)krow0 * 2048 + h * 128,
                       AO + (size_t)qrow0 * 2048 + h * 128, seq, lds, tid);
    }
}

constexpr int PH_PER_LAYER = 10, PH_TOTAL = 2 + DEPTH * PH_PER_LAYER;
#ifndef MK_LAUNCH_PER_PHASE
#define MK_LAUNCH_PER_PHASE 0
#endif

__global__ void __launch_bounds__(NWAVES * 64, 2) fwd(Args a) {
    extern __shared__ __attribute__((aligned(16))) unsigned char lds_raw[];
    LAS unsigned char* lds = (LAS unsigned char*)lds_raw;
    const int tid = threadIdx.x, lane = tid & 63, wave = __builtin_amdgcn_readfirstlane(tid >> 6);
    const int G = gridDim.x; const int bx = blockIdx.x; const int vcu = (G % 8 == 0) ? (bx % 8) * (G / 8) + bx / 8 : bx;
    volatile LAS unsigned* MISC = (volatile LAS unsigned*)(lds + MISC_OFF);
    for (int u = tid; u < (LDS_BYTES - LDSCTL_OFF) / 4; u += NWAVES * 64) ((LAS unsigned*)(lds + LDSCTL_OFF))[u] = 0u;
    __syncthreads();
    const int lo = a.ph_lo, hi = a.ph_hi; const bool use_bar = (hi - lo) > 1;
    XcdBarrier bar; bar.bar = (unsigned*)(a.ws + WS_CTL) + CW_BAR; bar.x = 0; bar.st = MISC + 8;
    if (use_bar) bar = xcd_barrier_post((unsigned*)(a.ws + WS_CTL) + CW_BAR, MISC + 8);
#ifndef DBLMASK
#define DBLMASK 0u
#endif
#define REP(k) (((DBLMASK >> (k)) & 1) ? 2 : 1)
#ifndef PHMASK
#define PHMASK 0xFFFFFFFFu
#endif
#define IN(k) (lo <= (k) && (k) < hi)
#define SEAM(k) do { if ((k) + 1 < hi) xcd_barrier(bar, wave); } while (0)
#define U ((const bf16*)(ws + WS_U))
#define Y ((bf16*)(ws + WS_Y))
#define FRESH_TID() int lane_l; asm volatile("v_mbcnt_lo_u32_b32 %0, -1, 0\n\tv_mbcnt_hi_u32_b32 %0, -1, %0" : "=v"(lane_l));     const int wave_l = wave, tid_l = (wave << 6) | lane_l; (void)tid_l; (void)wave_l; size_t wz_ = 0; asm volatile("" : "+s"(wz_)); Args al = a; al.ws = a.ws + wz_; unsigned char* ws = al.ws; (void)ws;     int bxl = bx, vcul = vcu; asm volatile("" : "+s"(bxl), "+s"(vcul)); (void)bxl; (void)vcul

    if (((PHMASK >> 0) & 1) && IN(0)) { for (int rep = 0; rep < REP(0); ++rep) { FRESH_TID(); phase_pro_a(al, lds, tid_l, lane_l, wave_l, vcul, G); __syncthreads(); } SEAM(0); }
    if (((PHMASK >> 1) & 1) && IN(1)) { FRESH_TID(); phase_pro_b(al, lane_l, wave_l, vcul, G); SEAM(1); }

    for (int layer = 0; layer < DEPTH; ++layer) {
        const int pb = 2 + layer * PH_PER_LAYER; const int j = layer >> 1; const bool last = (layer == DEPTH - 1);
        if ((layer & 1) == 0) {
            if (((PHMASK >> 2) & 1) && IN(pb + 0)) { FRESH_TID();
                pg8::Gemm g{U, (const bf16*)(ws + WS_WQKV) + (size_t)j * 8192 * 2048, M, 8192, 2048}; pg8::TileOrder S; S.init(NTM, 32, G, bxl, 0, 0, 32);
                EpiQKV E{(bf16*)(ws + WS_RQ), (bf16*)(ws + WS_RK), (bf16*)(ws + WS_RV), (const float*)(ws + WS_RCS)};
                for (int rep = 0; rep < REP(2); ++rep) { pg8::gemm_phase<EpiQKV, pg8::TileOrder, true, true>(lds, g, S, E, tid_l); __syncthreads(); } SEAM(pb + 0); }
            if (((PHMASK >> 3) & 1) && IN(pb + 1)) { for (int rep = 0; rep < REP(3); ++rep) { FRESH_TID(); phase_ret_scan(al, j, lds, tid_l, lane_l, wave_l, vcul, G); __syncthreads(); } SEAM(pb + 1); }
            if (((PHMASK >> 4) & 1) && IN(pb + 2)) { FRESH_TID();
                pg8::Gemm g{U, (const bf16*)(ws + WS_WG) + (size_t)j * 8192 * 2048, M, 8192, 2048}; pg8::TileOrder S; S.init(NTM, 32, G, bxl, 0, 0, 32);
                EpiGate E{(const bf16*)(ws + WS_OF), (const bf16*)(ws + WS_OB), (const float*)(ws + WS_PART), (bf16*)(ws + WS_YG)};
                for (int rep = 0; rep < REP(4); ++rep) { pg8::gemm_phase<EpiGate, pg8::TileOrder, true, true>(lds, g, S, E, tid_l); __syncthreads(); } SEAM(pb + 2); }
            if (((PHMASK >> 5) & 1) && IN(pb + 3)) { FRESH_TID();
                pg8::Gemm g{(const bf16*)(ws + WS_YG), (const bf16*)(ws + WS_WOR) + (size_t)j * 2048 * 4096, M, 2048, 4096}; pg8::TileOrder S; S.init(NTL, 8, G, bxl, 1, KSPLIT, 64);
                EpiBf E{Y, Y, 2048, 0, (float*)(ws + WS_YP)};
                for (int rep = 0; rep < REP(5); ++rep) { pg8::gemm_phase<EpiBf, pg8::TileOrder, true, true>(lds, g, S, E, tid_l); __syncthreads(); } SEAM(pb + 3); }
        } else {
            if (((PHMASK >> 6) & 1) && IN(pb + 0)) { FRESH_TID();
                pg8::Gemm g{U, (const bf16*)(ws + WS_WD) + (size_t)j * 1280 * 2048, M, 1280, 2048}; pg8::TileOrder S; S.init(NTM, 5, G, bxl, 0, 0, 32);
                EpiDQKV E{(bf16*)(ws + WS_CQN), (bf16*)(ws + WS_CKVN), (bf16*)(ws + WS_KR), (float*)(ws + WS_SSQ), (const float*)(ws + WS_ACS)};
                for (int rep = 0; rep < REP(6); ++rep) { pg8::gemm_phase<EpiDQKV, pg8::TileOrder, true, true>(lds, g, S, E, tid_l); __syncthreads(); } SEAM(pb + 0); }
            if (((PHMASK >> 8) & 1) && IN(pb + 2)) { FRESH_TID();
                { pg8::Gemm g{(const bf16*)(ws + WS_CQN), (const bf16*)(ws + WS_WUQ) + (size_t)j * 3072 * 512, M, 3072, 512}; pg8::TileOrder S; S.init(last ? NTL : NTM, 12, G, bxl, last ? 1 : 0, 0, 8);
                  EpiUQ E{(bf16*)(ws + WS_QB), (const float*)(ws + WS_ACS), (const float*)(ws + WS_SSQ)};
                  for (int rep = 0; rep < REP(8); ++rep) { pg8::gemm_phase<EpiUQ, pg8::TileOrder, true, true>(lds, g, S, E, tid_l); __syncthreads(); } }
                __syncthreads();
                { pg8::Gemm g{(const bf16*)(ws + WS_CKVN), (const bf16*)(ws + WS_WUKV) + (size_t)j * 4096 * 512, M, 4096, 512}; pg8::TileOrder S; S.init(NTM, 16, G, bxl, 0, 0, 8);
                  EpiUKV E{(bf16*)(ws + WS_KN), (bf16*)(ws + WS_VB), (const float*)(ws + WS_SSQ)};
                  for (int rep = 0; rep < REP(8); ++rep) { pg8::gemm_phase<EpiUKV, pg8::TileOrder, true, true>(lds, g, S, E, tid_l); __syncthreads(); } }
                SEAM(pb + 2); }
            if (((PHMASK >> 9) & 1) && IN(pb + 3)) { FRESH_TID(); for (int rep = 0; rep < REP(9); ++rep) phase_attn(al, !last, lds, tid_l, vcul, G); SEAM(pb + 3); }
            if (((PHMASK >> 10) & 1) && IN(pb + 4)) { FRESH_TID();
                pg8::Gemm g{(const bf16*)(ws + WS_AO), (const bf16*)(ws + WS_WOM) + (size_t)j * 2048 * 2048, M, 2048, 2048}; pg8::TileOrder S; S.init(NTL, 8, G, bxl, 1, last ? 0 : KSPLIT, 32);
                EpiBf E{Y, Y, 2048, 0, (float*)(ws + WS_YP)};
                for (int rep = 0; rep < REP(10); ++rep) { pg8::gemm_phase<EpiBf, pg8::TileOrder, true, true>(lds, g, S, E, tid_l); __syncthreads(); } SEAM(pb + 4); }
        }
        if (((PHMASK >> 11) & 1) && IN(pb + 5)) { if (REP(11) > 1) { FRESH_TID(); phase_ln(al, layer, 0, lds, tid_l, lane_l, wave_l, vcul, G, true); } FRESH_TID(); phase_ln(al, layer, 0, lds, tid_l, lane_l, wave_l, vcul, G); SEAM(pb + 5); }
        if (((PHMASK >> 12) & 1) && IN(pb + 6)) { FRESH_TID();
            pg8::Gemm g{U, (const bf16*)(ws + WS_WIN) + (size_t)layer * 11264 * 2048, M, 11264, 2048}; pg8::TileOrder S; S.init(last ? NTL : NTM, 44, G, bxl, last ? 1 : 0, 0, 32);
            EpiSwiglu E{(bf16*)(ws + WS_HID)};
#if defined(SPLIT_WIN_PROBE)
            { pg8::TileOrder S1 = S; S1.ilim = 6; pg8::gemm_phase<EpiSwiglu, pg8::TileOrder, true, true>(lds, g, S1, E, tid_l); __syncthreads(); xcd_barrier(bar, wave);
              pg8::TileOrder S2 = S; S2.ioff = 6; pg8::gemm_phase<EpiSwiglu, pg8::TileOrder, true, true>(lds, g, S2, E, tid_l); __syncthreads(); } SEAM(pb + 6); }
#else
            for (int rep = 0; rep < REP(12); ++rep) { pg8::gemm_phase<EpiSwiglu, pg8::TileOrder, true, true>(lds, g, S, E, tid_l); __syncthreads(); } SEAM(pb + 6); }
#endif
        if (((PHMASK >> 13) & 1) && IN(pb + 7)) { FRESH_TID();
            pg8::Gemm g{(const bf16*)(ws + WS_HID), (const bf16*)(ws + WS_WOUT) + (size_t)layer * 2048 * 5632, M, 2048, 5632}; pg8::TileOrder S; S.init(NTL, 8, G, bxl, 1, last ? 0 : KSPLIT, 88);
            EpiBf E{Y, Y, 2048, 0, (float*)(ws + WS_YP)};
            for (int rep = 0; rep < REP(13); ++rep) { pg8::gemm_phase<EpiBf, pg8::TileOrder, true, true>(lds, g, S, E, tid_l); __syncthreads(); } SEAM(pb + 7); }
        if (((PHMASK >> 14) & 1) && IN(pb + 8)) { if (REP(11) > 1) { FRESH_TID(); phase_ln(al, layer, 1, lds, tid_l, lane_l, wave_l, vcul, G, true); } FRESH_TID(); phase_ln(al, layer, 1, lds, tid_l, lane_l, wave_l, vcul, G); SEAM(pb + 8); }
    }
#undef IN
#undef SEAM
#undef U
#undef Y
}

extern "C" void kernel_launch(void* const* d_in, const int* in_sizes, int n_in, void* d_out, int out_size, void* d_ws, size_t ws_size, hipStream_t stream) {
    static int grid = 0;
    if (grid == 0) {
        if (n_in != 21 || ws_size < WS_END) { fprintf(stderr, "kernel_launch: need 21 inputs and %zu bytes of workspace; got %d, %zu\n", (size_t)WS_END, n_in, ws_size); grid = -1; return; }
        int dev = 0, cus = 0, per_cu = 0;
        if (hipGetDevice(&dev) != hipSuccess || hipDeviceGetAttribute(&cus, hipDeviceAttributeMultiprocessorCount, dev) != hipSuccess) { grid = -1; return; }
        if (hipFuncSetAttribute((const void*)fwd, hipFuncAttributeMaxDynamicSharedMemorySize, LDS_BYTES) != hipSuccess) { fprintf(stderr, "kernel_launch: hipFuncSetAttribute failed\n"); grid = -1; return; }
        if (hipOccupancyMaxActiveBlocksPerMultiprocessor(&per_cu, (const void*)fwd, NWAVES * 64, LDS_BYTES) != hipSuccess || per_cu < 1)
            fprintf(stderr, "kernel_launch: occupancy query reports %d workgroups per CU\n", per_cu);
        (void)hipGetLastError();
        grid = cus;
    }
    if (grid < 0) return;
    if (hipMemsetAsync((char*)d_ws + WS_CTL, 0, CTL_ZERO_BYTES, stream) != hipSuccess) return;
    Args a{};
    for (int i = 0; i < 21; ++i) a.in[i] = (const float*)d_in[i];
    a.out = (float*)d_out; a.ws = (unsigned char*)d_ws;
#if MK_LAUNCH_PER_PHASE
    for (int p = 0; p < PH_TOTAL; ++p) {
        const int pl = (p - 2) % PH_PER_LAYER, layer = (p - 2) / PH_PER_LAYER;
        if (p >= 2 && (pl == 9 || (pl == 4 && (layer & 1) == 0))) continue;
        a.ph_lo = p; a.ph_hi = p + 1;
        hipLaunchKernelGGL(fwd, dim3(grid), dim3(NWAVES * 64), LDS_BYTES, stream, a);
    }
#else
    a.ph_lo = 0; a.ph_hi = PH_TOTAL;
    hipLaunchKernelGGL(fwd, dim3(grid), dim3(NWAVES * 64), LDS_BYTES, stream, a);
#endif
    const hipError_t le = hipPeekAtLastError();
    if (le != hipSuccess) fprintf(stderr, "kernel_launch: launch failed: %s\n", hipGetErrorName(le));
}
```

```cpp
#include <hip/hip_runtime.h>
#include <cstdio>
#include <cstdint>
#define MK_LAUNCH_PER_PHASE 0
namespace pg8 {
#define PG8_LAS __attribute__((address_space(3)))
typedef unsigned short bf16_t;
typedef short bf16x8 __attribute__((ext_vector_type(8)));
typedef float f32x4 __attribute__((ext_vector_type(4)));
typedef unsigned u32x4 __attribute__((ext_vector_type(4)));
constexpr int BM = 256, BK = 64, HALF = 128, HTB = HALF * BK * 2  , STAGE_BYTES = 8 * HTB, NXCD = 8, WGM = 8;

__host__ __device__ __forceinline__ int lds_byte(int r, int c) { const int st = (r >> 4) * 2 + (c >> 5), rr = r & 15, cc = c & 31, ob = rr * 64 + cc * 2; return st * 1024 + (ob ^ (((ob >> 9) & 1) << 5)); }
__host__ __device__ __forceinline__ void stage_rc(int b, int& R, int& C) { const int st = b / 1024, sb = b % 1024, swz = sb ^ (((sb >> 9) & 1) << 5); R = (st >> 1) * 16 + swz / 64; C = (st & 1) * 32 + (swz % 64) / 2; }
__host__ __device__ __forceinline__ int perm32(int rho) { const int n = rho >> 4, i = rho & 15; return 8 * (i >> 2) + 4 * n + (i & 3); }

struct Unit { int pm, pn, k0, nt, ks; };
struct Gemm { const bf16_t* A; const bf16_t* Bt; int M, N, K; };

struct StaticOrder {
    int nM, nN, nwg, G, c;
    __host__ __device__ void init(int M, int N, int G_, int c_) { nM = M / BM; nN = N / BM; nwg = nM * nN; G = G_; c = c_; }
    __host__ __device__ bool next(int i, Unit& u) const {
        const long L = (long)i * G + c; if (L >= nwg) return false;
        int wgid = (int)L; { const int q = nwg / NXCD, r = nwg % NXCD, xcd = wgid % NXCD, off = wgid / NXCD; wgid = (xcd < r ? xcd * (q + 1) : r * (q + 1) + (xcd - r) * q) + off; }
        const int nig = WGM * nN, gid = wgid / nig, fm = gid * WGM, gsz = (nM - fm) < WGM ? (nM - fm) : WGM;
        u.pm = fm + ((wgid % nig) % gsz); u.pn = (wgid % nig) / gsz; return true;
    }
    __device__ __forceinline__ void a_ready(const Unit&) const {}
    __device__ __forceinline__ void done(const Unit&) const {}
};

__device__ __forceinline__ unsigned cvt_pk_bf16(float lo, float hi) { unsigned r; asm volatile("v_cvt_pk_bf16_f32 %0, %1, %2" : "=v"(r) : "v"(lo), "v"(hi)); return r; }
struct TileOrder {
    int nM, nN, nmain, nwg, G, c, lat, split, kt, ioff = 0, ilim = 1 << 30;
    __host__ __device__ void init(int nM_, int nN_, int G_, int c_, int lat_, int split_, int kt_) { nM = nM_; nN = nN_; nmain = nM * nN; G = G_; c = c_; lat = lat_; split = split_; kt = kt_; nwg = nmain + 4 * nN * split; }
    __host__ __device__ __forceinline__ bool next(int i, Unit& u) const {
        if (i + ioff >= ilim) return false;
        const long L = (long)(i + ioff) * G + c; if (L >= nwg) return false;
        const bool sp = L >= nmain;
        const int e = (int)L - nmain, sdiv = split > 0 ? split : 1, tile = e / sdiv, sl = e - tile * sdiv, snt = kt / sdiv;
        int wgid = sp ? 0 : (int)L; { const int q = nmain / NXCD, r = nmain % NXCD, xcd = wgid % NXCD, off = wgid / NXCD; wgid = (xcd < r ? xcd * (q + 1) : r * (q + 1) + (xcd - r) * q) + off; }
        const int nig = WGM * nN, gid = wgid / nig, fm = gid * WGM, gsz = (nM - fm) < WGM ? (nM - fm) : WGM;
        int pm = fm + ((wgid % nig) % gsz); const int pn = (wgid % nig) / gsz; if (lat) pm += pm >> 4;
        Unit r; r.pm = sp ? 17 * (tile & 3) + 16 : pm; r.pn = sp ? (tile >> 2) : pn; r.k0 = sp ? sl * snt : 0; r.nt = sp ? snt : kt; r.ks = sp ? sl : -1;
        u = r; return true;
    }
    __device__ __forceinline__ void a_ready(const Unit&) const {}
    __device__ __forceinline__ void done(const Unit&) const {}
};
template <class Epi, class Sched, bool ALIGN_EPI = false, bool SP2 = false>
__device__ __forceinline__ void gemm_phase(PG8_LAS unsigned char* lds, const Gemm g, const Sched& S, const Epi& E, int tid_in) {
    int tid_ = tid_in; asm volatile("" : "+v"(tid_));
    const int tid = tid_, wid = __builtin_amdgcn_readfirstlane(tid >> 6), lane = tid & 63, wr = wid >> 2, wc = wid & 3, fr = lane & 15, fq = lane >> 4;
    const int K = g.K;
    unsigned voffA[2], voffB[2];
#pragma unroll
    for (int i = 0; i < 2; ++i) { int R, C; stage_rc(tid * 16 + i * 8192, R, C); const int Rb = Epi::PERM ? ((R & ~31) + perm32(R & 31)) : R;
        voffA[i] = (unsigned)(R * K + C) * 2u; voffB[i] = (unsigned)(Rb * K + C) * 2u; }
    const size_t kstep = (size_t)(BK * 2);
    const size_t hstep = (size_t)HALF * K * 2;
    const size_t tstep = 2 * hstep;
    const unsigned ldsw = (unsigned)wid * 1024u;
    const int aoff = lds_byte(wr * 64 + fr, fq * 8), boff = lds_byte(wc * 32 + fr, fq * 8);
#define PG8_SA(b, h) (((b) * 2 + (h)) * HTB)
#define PG8_SB(b, h) ((4 + (b) * 2 + (h)) * HTB)
#define PG8_STAGE(bufoff, gbase, voff) do { _Pragma("unroll") for (int _i = 0; _i < 2; ++_i) \
        __builtin_amdgcn_global_load_lds((const unsigned*)((const char*)(gbase) + (voff)[_i]), (PG8_LAS unsigned*)(lds + (bufoff) + ldsw + _i * 8192), 16, 0, 0); } while (0)
#define PG8_LDA(dst, b, h) do { _Pragma("unroll") for (int m = 0; m < 4; ++m) _Pragma("unroll") for (int k = 0; k < 2; ++k) dst[m][k] = *(const PG8_LAS bf16x8*)(lds + PG8_SA(b, h) + aoff + m * 2048 + k * 1024); } while (0)
#define PG8_LDB(dst, b, h) do { _Pragma("unroll") for (int n = 0; n < 2; ++n) _Pragma("unroll") for (int k = 0; k < 2; ++k) dst[n][k] = *(const PG8_LAS bf16x8*)(lds + PG8_SB(b, h) + boff + n * 2048 + k * 1024); } while (0)
#define PG8_MMA(ai, bj, At, Bt) do { __builtin_amdgcn_s_setprio(1); _Pragma("unroll") for (int m = 0; m < 4; ++m) _Pragma("unroll") for (int n = 0; n < 2; ++n) _Pragma("unroll") for (int k = 0; k < 2; ++k) \
        acc[ai][bj][m][n] = __builtin_amdgcn_mfma_f32_16x16x32_bf16(Bt[n][k], At[m][k], acc[ai][bj][m][n], 0, 0, 0); __builtin_amdgcn_s_setprio(0); } while (0)
#define PG8_WAIT_V(n) asm volatile("s_waitcnt vmcnt(" #n ")" ::: "memory")
#define PG8_WAIT_L(n) asm volatile("s_waitcnt lgkmcnt(" #n ")" ::: "memory")
#define PG8_BAR __builtin_amdgcn_s_barrier()
#define PG8_SCHED __builtin_amdgcn_sched_barrier(0)
    Unit cur, nxt; int ui = 0;
    if (!S.next(0, cur)) return;
    f32x4 acc[2][2][4][2];
#pragma unroll
    for (int a = 0; a < 2; ++a)
#pragma unroll
        for (int b = 0; b < 2; ++b)
#pragma unroll
            for (int m = 0; m < 4; ++m)
#pragma unroll
                for (int n = 0; n < 2; ++n) acc[a][b][m][n] = (f32x4){0.f, 0.f, 0.f, 0.f};
    bf16x8 At[4][2], B0[2][2], B1[2][2];
    const char* cA = (const char*)g.A + (size_t)cur.pm * tstep + (size_t)cur.k0 * kstep; const char* cB = (const char*)g.Bt + (size_t)cur.pn * tstep + (size_t)cur.k0 * kstep;
    S.a_ready(cur);
    if constexpr (SP2) {
        PG8_STAGE(PG8_SB(0, 0), cB, voffB); PG8_STAGE(PG8_SB(0, 1), cB + hstep, voffB); PG8_STAGE(PG8_SA(0, 0), cA, voffA); PG8_STAGE(PG8_SA(0, 1), cA + hstep, voffA);
        if (wr == 1) PG8_BAR;
        PG8_WAIT_V(2); PG8_BAR;
        PG8_STAGE(PG8_SB(1, 0), cB + kstep, voffB); PG8_STAGE(PG8_SA(1, 0), cA + kstep, voffA); PG8_STAGE(PG8_SB(1, 1), cB + hstep + kstep, voffB);
        PG8_WAIT_V(6); PG8_BAR;
    } else {
        PG8_STAGE(PG8_SB(0, 0), cB, voffB); PG8_STAGE(PG8_SA(0, 0), cA, voffA); PG8_STAGE(PG8_SB(0, 1), cB + hstep, voffB); PG8_STAGE(PG8_SA(0, 1), cA + hstep, voffA);
        if (wr == 1) PG8_BAR;
        PG8_WAIT_V(4); PG8_BAR;
        PG8_STAGE(PG8_SB(1, 0), cB + kstep, voffB); PG8_STAGE(PG8_SA(1, 0), cA + kstep, voffA); PG8_STAGE(PG8_SB(1, 1), cB + hstep + kstep, voffB);
        PG8_WAIT_V(6); PG8_BAR;
    }
    for (;;) {
        const bool has_next = S.next(ui + 1, nxt);
        const char* nA = has_next ? (const char*)g.A + (size_t)nxt.pm * tstep + (size_t)nxt.k0 * kstep : cA; const char* nB = has_next ? (const char*)g.Bt + (size_t)nxt.pn * tstep + (size_t)nxt.k0 * kstep : cB;
        const int nt = cur.nt;
        for (int t = 0; t < nt; t += 2) {
            const bool last = (t == nt - 2);
            const char* a1 = cA + (size_t)(t + 1) * kstep;
            const char* a2 = last ? nA : cA + (size_t)(t + 2) * kstep; const char* b2 = last ? nB : cB + (size_t)(t + 2) * kstep;
            const char* a3 = a2 + kstep; const char* b3 = b2 + kstep;
            if (last && has_next) S.a_ready(nxt);
            if constexpr (SP2) {
            PG8_LDB(B0, 0, 0); PG8_LDB(B1, 0, 1); PG8_SCHED; PG8_LDA(At, 0, 0); PG8_STAGE(PG8_SA(1, 1), a1 + hstep, voffA);
            PG8_WAIT_V(8); PG8_WAIT_L(0); PG8_BAR; PG8_MMA(0, 0, At, B0); PG8_MMA(0, 1, At, B1); PG8_BAR; PG8_SCHED;
            PG8_LDA(At, 0, 1); PG8_STAGE(PG8_SB(0, 0), b2, voffB); PG8_STAGE(PG8_SB(0, 1), b2 + hstep, voffB); PG8_STAGE(PG8_SA(0, 0), a2, voffA);
            PG8_WAIT_V(8); PG8_WAIT_L(0); PG8_BAR; PG8_MMA(1, 0, At, B0); PG8_MMA(1, 1, At, B1); PG8_BAR; PG8_SCHED;
            PG8_LDB(B0, 1, 0); PG8_LDB(B1, 1, 1); PG8_SCHED; PG8_LDA(At, 1, 0); PG8_STAGE(PG8_SA(0, 1), a2 + hstep, voffA);
            PG8_WAIT_V(8); PG8_WAIT_L(0); PG8_BAR; PG8_MMA(0, 0, At, B0); PG8_MMA(0, 1, At, B1); PG8_BAR; PG8_SCHED;
            PG8_LDA(At, 1, 1); PG8_STAGE(PG8_SB(1, 0), b3, voffB); PG8_STAGE(PG8_SB(1, 1), b3 + hstep, voffB); PG8_STAGE(PG8_SA(1, 0), a3, voffA);
            PG8_WAIT_V(8); PG8_WAIT_L(0); PG8_BAR; PG8_MMA(1, 0, At, B0); PG8_MMA(1, 1, At, B1); PG8_BAR; PG8_SCHED;
            } else {
            PG8_LDB(B0, 0, 0); PG8_SCHED; PG8_LDA(At, 0, 0); PG8_STAGE(PG8_SA(1, 1), a1 + hstep, voffA);
            PG8_WAIT_L(8); PG8_BAR; PG8_WAIT_L(0); PG8_MMA(0, 0, At, B0); PG8_BAR; PG8_SCHED;
            PG8_LDB(B1, 0, 1); PG8_STAGE(PG8_SB(0, 0), b2, voffB);
            PG8_BAR; PG8_WAIT_L(0); PG8_MMA(0, 1, At, B1); PG8_BAR;
            PG8_LDA(At, 0, 1); PG8_STAGE(PG8_SA(0, 0), a2, voffA);
            PG8_BAR; PG8_WAIT_L(0); PG8_MMA(1, 0, At, B0); PG8_BAR; PG8_SCHED;
            PG8_STAGE(PG8_SB(0, 1), b2 + hstep, voffB);
            PG8_WAIT_V(6); PG8_BAR; PG8_MMA(1, 1, At, B1); PG8_BAR;
            PG8_LDB(B0, 1, 0); PG8_SCHED; PG8_LDA(At, 1, 0); PG8_STAGE(PG8_SA(0, 1), a2 + hstep, voffA);
            PG8_WAIT_L(8); PG8_BAR; PG8_WAIT_L(0); PG8_MMA(0, 0, At, B0); PG8_BAR; PG8_SCHED;
            PG8_LDB(B1, 1, 1); PG8_STAGE(PG8_SB(1, 0), b3, voffB);
            PG8_BAR; PG8_WAIT_L(0); PG8_MMA(0, 1, At, B1); PG8_BAR;
            PG8_LDA(At, 1, 1); PG8_STAGE(PG8_SA(1, 0), a3, voffA);
            PG8_BAR; PG8_WAIT_L(0); PG8_MMA(1, 0, At, B0); PG8_BAR; PG8_SCHED;
            PG8_STAGE(PG8_SB(1, 1), b3 + hstep, voffB);
            PG8_WAIT_V(6); PG8_BAR; PG8_MMA(1, 1, At, B1); PG8_BAR;
            }
        }
        if constexpr (ALIGN_EPI) { if (wr == 0) PG8_BAR; }
        asm volatile("s_nop 15\n\ts_nop 15" ::: "memory");
        if constexpr (!Epi::AFTER_DRAIN) { E(acc, cur, wr, wc, fr, fq); S.done(cur); }
        if (!has_next) break;
#pragma unroll
        for (int a = 0; a < 2; ++a)
#pragma unroll
            for (int b = 0; b < 2; ++b)
#pragma unroll
                for (int m = 0; m < 4; ++m)
#pragma unroll
                    for (int n = 0; n < 2; ++n) acc[a][b][m][n] = (f32x4){0.f, 0.f, 0.f, 0.f};
        cur = nxt; cA = nA; cB = nB; ++ui;
        if constexpr (ALIGN_EPI) { if (wr == 1) PG8_BAR; }
    }
    PG8_WAIT_V(0);
    if constexpr (!ALIGN_EPI) { if (wr == 0) PG8_BAR; }
    PG8_BAR;
    if constexpr (Epi::AFTER_DRAIN) { E.fused(acc, cur, wr, wc, fr, fq, lds, wid, lane); S.done(cur); }
#undef PG8_SA
#undef PG8_SB
#undef PG8_STAGE
#undef PG8_LDA
#undef PG8_LDB
#undef PG8_MMA
#undef PG8_WAIT_V
#undef PG8_WAIT_L
#undef PG8_BAR
#undef PG8_SCHED
}
}

constexpr int D = 2048, BATCH = 4, SEQ = 4096, CTXL = 256, DEPTH = 4, FF = 5632;
constexpr int TPB = SEQ + CTXL;
constexpr int M = BATCH * TPB;
constexpr int NTM = M / 256;
constexpr int NTL = BATCH * SEQ / 256;
constexpr float ALPHA = 1.6817928305074290f;
constexpr float LN_EPS = 1e-5f, GN_EPS = 1e-6f, RMS_EPS = 1e-6f;
constexpr float MLA_SCALE = 0.07216878364870322f;
constexpr int NWAVES = 8;

constexpr size_t MiB = 1u << 20;
constexpr size_t WS_CTL = 0, CTL_ZERO_BYTES = 64 * 1024;
constexpr size_t WS_MOD = 1 * MiB;
constexpr size_t WS_RCS = 2 * MiB;
constexpr size_t WS_ACS = 6 * MiB;
constexpr size_t WS_WQKV = 8 * MiB;
constexpr size_t WS_WG = 72 * MiB;
constexpr size_t WS_WOR = 136 * MiB;
constexpr size_t WS_WD = 168 * MiB;
constexpr size_t WS_WUQ = 178 * MiB;
constexpr size_t WS_WUKV = 184 * MiB;
constexpr size_t WS_WOM = 192 * MiB;
constexpr size_t WS_WIN = 208 * MiB;
constexpr size_t WS_WOUT = 384 * MiB;
constexpr size_t WS_H = 472 * MiB;
constexpr size_t WS_U = 608 * MiB;
constexpr size_t WS_Y = 676 * MiB;
constexpr size_t WS_S = 744 * MiB;
constexpr size_t WS_RQ = WS_S, WS_RK = WS_S + 68 * MiB, WS_RV = WS_S + 136 * MiB, WS_OF = WS_S + 272 * MiB, WS_OB = WS_S + 408 * MiB, WS_PART = WS_S + 544 * MiB;
constexpr size_t WS_YG = WS_S;
constexpr size_t WS_SSQ = WS_S  , WS_CQKV = WS_S, WS_CQN = WS_S + 85 * MiB, WS_CKVN = WS_S + 102 * MiB, WS_KR = WS_S + 119 * MiB, WS_QB = WS_S + 122 * MiB,
                 WS_KN = WS_S + 224 * MiB, WS_VB = WS_S + 292 * MiB, WS_AO = WS_S + 360 * MiB;
constexpr size_t WS_HID = WS_S;
constexpr size_t WS_YP = 1297 * MiB;
constexpr size_t WS_END = 1329 * MiB;
constexpr int KSPLIT = 4;

constexpr int CW_BAR = 4096;

constexpr int RING_BYTES = 131072;
constexpr int LDSCTL_OFF = RING_BYTES, MISC_OFF = LDSCTL_OFF + 320;
constexpr int LDS_BYTES = 147456;

#define GAS __attribute__((address_space(1)))
#define LAS __attribute__((address_space(3)))
typedef unsigned short bf16;
typedef unsigned v4u __attribute__((ext_vector_type(4)));
typedef unsigned v2u __attribute__((ext_vector_type(2)));
typedef float f32x4 __attribute__((ext_vector_type(4)));
typedef float f32x2 __attribute__((ext_vector_type(2)));
typedef float f32x16 __attribute__((ext_vector_type(16)));
typedef short bf16x8 __attribute__((ext_vector_type(8)));
typedef short s16x4 __attribute__((ext_vector_type(4)));
typedef _Float16 h16;
typedef _Float16 h16x4 __attribute__((ext_vector_type(4)));
#define LDS_WAIT() asm volatile("s_waitcnt lgkmcnt(0)" ::: "memory")
#define VM_WAIT() asm volatile("s_waitcnt vmcnt(0)" ::: "memory")
#define SBAR() __builtin_amdgcn_sched_barrier(0)
using pg8::cvt_pk_bf16;
__device__ __forceinline__ float bf2f(unsigned short b) { return __uint_as_float(((unsigned)b) << 16); }
__device__ __forceinline__ float bflo(unsigned w) { return __uint_as_float(w << 16); }
__device__ __forceinline__ float bfhi(unsigned w) { return __uint_as_float(w & 0xffff0000u); }
__device__ __forceinline__ float silu_f(float x) { return x * __builtin_amdgcn_rcpf(1.0f + __expf(-x)); }

#define XB_TMO      128
#define XB_XCNT(j)  (256  + 64 * (j))
#define XB_XSUB(j)  (1280 + 64 * (j))
#define XB_XGEN(j)  (2304 + 64 * (j))
#define XB_TOP      3328
#define XB_TOPGEN   3392
#define XCD_BAR_WORDS 3456
#define XB_SPIN_CAP (1u << 20)

__device__ __forceinline__ unsigned xb_ld(unsigned* p)              { return __hip_atomic_load(p, __ATOMIC_RELAXED, __HIP_MEMORY_SCOPE_AGENT); }
__device__ __forceinline__ unsigned xb_add(unsigned* p, unsigned v) { return __hip_atomic_fetch_add(p, v, __ATOMIC_RELAXED, __HIP_MEMORY_SCOPE_AGENT); }
__device__ __forceinline__ unsigned xb_xcc_id() { return (unsigned)__builtin_amdgcn_s_getreg((3 << 11) | 20) & 0xFu; }
#define XB_SPIN(cond, bar) do { unsigned _sp = 0; while (cond) { __builtin_amdgcn_s_sleep(1); \
    if ((++_sp & 255u) == 0u) { if (xb_ld(&(bar)[XB_TMO])) break; if (_sp > XB_SPIN_CAP) { atomicAdd(&(bar)[XB_TMO], 1u); break; } } } } while (0)

struct XcdBarrier { unsigned* bar; unsigned x; volatile LAS unsigned* st; };
__device__ __forceinline__ XcdBarrier xcd_barrier_post(unsigned* bar, volatile LAS unsigned* st) {
    XcdBarrier b; b.bar = bar; b.x = xb_xcc_id(); b.st = st;
    if (threadIdx.x == 0) (void)xb_add(&bar[XB_XCNT(b.x)], 1u);
    return b;
}
__device__ __forceinline__ void xcd_barrier_complete(unsigned* bar, unsigned x, unsigned& nloc, unsigned& nx) {
    const unsigned G = gridDim.x * gridDim.y * gridDim.z;
    unsigned sum, cnt, mine, sp = 0u;
    for (;;) {
        sum = 0u; cnt = 0u; mine = 0u;
#pragma unroll
        for (unsigned j = 0; j < 16; ++j) { const unsigned c = xb_ld(&bar[XB_XCNT(j)]); sum += c; cnt += (c > 0u) ? 1u : 0u; mine = (j == x) ? c : mine; }
        if (sum == G) break;
        __builtin_amdgcn_s_sleep(1);
        if ((++sp & 255u) == 0u) { if (xb_ld(&bar[XB_TMO])) break; if (sp > XB_SPIN_CAP) { atomicAdd(&bar[XB_TMO], 1u); break; } }
    }
    nloc = mine > 0u ? mine : 1u; nx = cnt > 0u ? cnt : 1u;
}
__device__ __forceinline__ void xcd_barrier(const XcdBarrier& b, int wave) {
    asm volatile("s_waitcnt vmcnt(0)" ::: "memory");
    __syncthreads();
    int l_; asm volatile("v_mbcnt_lo_u32_b32 %0, -1, 0\n\tv_mbcnt_hi_u32_b32 %0, -1, %0" : "=v"(l_));
    if (l_ == 0 && wave == 0) {
        unsigned* bar = b.bar;
        __builtin_amdgcn_s_waitcnt(0);
        unsigned nloc = b.st[0], nx = b.st[1];
        if (nloc == 0u) { xcd_barrier_complete(bar, b.x, nloc, nx); b.st[0] = nloc; b.st[1] = nx; }
        const unsigned old = xb_add(&bar[XB_XSUB(b.x)], 1u);
        const unsigned gen = old / nloc;
        if (old + 1u == (gen + 1u) * nloc) {
            __builtin_amdgcn_fence(__ATOMIC_RELEASE, "agent");
            asm volatile("s_waitcnt vmcnt(0)" ::: "memory");
            const unsigned og = xb_add(&bar[XB_TOP], 1u);
            const unsigned tg = og / nx;
            if (og + 1u == (tg + 1u) * nx) xb_add(&bar[XB_TOPGEN], 1u);
            else XB_SPIN(xb_ld(&bar[XB_TOPGEN]) == tg, bar);
            __builtin_amdgcn_fence(__ATOMIC_ACQUIRE, "agent");
            xb_add(&bar[XB_XGEN(b.x)], 1u);
            asm volatile("s_waitcnt vmcnt(0)" ::: "memory");
        } else {
            XB_SPIN(xb_ld(&bar[XB_XGEN(b.x)]) == gen, bar);
            __builtin_amdgcn_fence(__ATOMIC_ACQUIRE, "agent");
            asm volatile("s_waitcnt vmcnt(0)" ::: "memory");
        }
    }
    __syncthreads();
}

__device__ __forceinline__ float shx(float v, int mask, int lane) { return __int_as_float(__builtin_amdgcn_ds_bpermute((lane ^ mask) << 2, __float_as_int(v))); }
__device__ __forceinline__ float wave_sum(float v, int lane) {
#pragma unroll
    for (int o = 1; o < 64; o <<= 1) v += shx(v, o, lane);
    return v;
}

typedef const pg8::f32x4 (&AccRef)[2][2][4][2];

struct EpiQKV {
    static constexpr bool PERM = true, AFTER_DRAIN = false;
    bf16 *Q, *K, *V; const float* cs;
    __device__ __forceinline__ void operator()(AccRef acc, const pg8::Unit& u, int wr, int wc, int fr, int fq) const {
        const int pn = u.pn, row0 = u.pm * 256 + wr * 64 + fr, tj = u.pm % 17; const bool isctx = (tj == 16); const int t0 = tj * 256 + wr * 64 + fr;
        if (pn < 16) {
            bf16* dst = (pn < 8) ? Q : K; const float sc = (pn < 8) ? 1.0f : 0.0625f; const int hc = (pn & 7) * 256 + wc * 32 + 8 * fq;
#pragma unroll
            for (int ai = 0; ai < 2; ++ai)
#pragma unroll
                for (int m = 0; m < 4; ++m) { const int r = row0 + ai * 128 + m * 16, t = t0 + ai * 128 + m * 16;
#pragma unroll
                    for (int bj = 0; bj < 2; ++bj) { f32x4 v0 = acc[ai][bj][m][0], v1 = acc[ai][bj][m][1];
                        if (!isctx) { const f32x4* cp = (const f32x4*)(cs + ((size_t)t * 128 + bj * 64 + wc * 16 + 4 * fq) * 2); const f32x4 c0 = cp[0], c1 = cp[1];
                            v0 = (f32x4){v0[0] * c0[0] - v0[1] * c0[1], v0[0] * c0[1] + v0[1] * c0[0], v0[2] * c0[2] - v0[3] * c0[3], v0[2] * c0[3] + v0[3] * c0[2]};
                            v1 = (f32x4){v1[0] * c1[0] - v1[1] * c1[1], v1[0] * c1[1] + v1[1] * c1[0], v1[2] * c1[2] - v1[3] * c1[3], v1[2] * c1[3] + v1[3] * c1[2]}; }
                        v0 = v0 * sc; v1 = v1 * sc;
                        v4u w; w.x = cvt_pk_bf16(v0[0], v0[1]); w.y = cvt_pk_bf16(v0[2], v0[3]); w.z = cvt_pk_bf16(v1[0], v1[1]); w.w = cvt_pk_bf16(v1[2], v1[3]);
                        *(v4u*)(dst + (size_t)r * 2048 + hc + bj * 128) = w; } }
        } else {
            const int vc = (pn - 16) * 256 + wc * 32 + 8 * fq;
#pragma unroll
            for (int ai = 0; ai < 2; ++ai)
#pragma unroll
                for (int m = 0; m < 4; ++m) { const int r = row0 + ai * 128 + m * 16;
#pragma unroll
                    for (int bj = 0; bj < 2; ++bj) { const f32x4 v0 = acc[ai][bj][m][0], v1 = acc[ai][bj][m][1];
                        v4u w; w.x = cvt_pk_bf16(v0[0], v0[1]); w.y = cvt_pk_bf16(v0[2], v0[3]); w.z = cvt_pk_bf16(v1[0], v1[1]); w.w = cvt_pk_bf16(v1[2], v1[3]);
                        *(v4u*)(V + (size_t)r * 4096 + vc + bj * 128) = w; } }
        }
    }
};
struct EpiGate {
    static constexpr bool PERM = true, AFTER_DRAIN = false;
    const bf16 *OF, *OB; const float* part; bf16* YG;
    __device__ __forceinline__ void operator()(AccRef acc, const pg8::Unit& u, int wr, int wc, int fr, int fq) const {
        const int head = u.pn >> 2, col = u.pn * 128 + wc * 32 + 8 * fq, row0 = u.pm * 256 + wr * 64 + fr;
#pragma unroll
        for (int hb = 0; hb < 4; ++hb) { const int ai = hb >> 1, mb = (hb & 1) * 2;
            f32x4 pa[2][4]; v4u of[2], ob[2];
#pragma unroll
            for (int mm = 0; mm < 2; ++mm) { const int r = row0 + ai * 128 + (mb + mm) * 16; const f32x4* pp = (const f32x4*)(part + ((size_t)r * 8 + head) * 16);
                pa[mm][0] = pp[0]; pa[mm][1] = pp[1]; pa[mm][2] = pp[2]; pa[mm][3] = pp[3];
                of[mm] = *(const v4u*)(OF + (size_t)r * 4096 + col); ob[mm] = *(const v4u*)(OB + (size_t)r * 4096 + col); }
#pragma unroll
            for (int mm = 0; mm < 2; ++mm) { const int m = mb + mm; const int r = row0 + ai * 128 + m * 16;
                const f32x4 a0 = pa[mm][0], a1 = pa[mm][1], b0 = pa[mm][2], b1 = pa[mm][3];
                const float mf = ((a0[0] + a0[2]) + (a1[0] + a1[2])) * (1.0f / 512.0f), qf = ((a0[1] + a0[3]) + (a1[1] + a1[3])) * (1.0f / 512.0f);
                const float mbb = ((b0[0] + b0[2]) + (b1[0] + b1[2])) * (1.0f / 512.0f), qb = ((b0[1] + b0[3]) + (b1[1] + b1[3])) * (1.0f / 512.0f);
                const float rf = rsqrtf(fmaxf(qf - mf * mf, 0.f) + GN_EPS), rb = rsqrtf(fmaxf(qb - mbb * mbb, 0.f) + GN_EPS);
                float y[8];
#pragma unroll
                for (int n = 0; n < 2; ++n) { const f32x4 gf = acc[ai][0][m][n], gb = acc[ai][1][m][n];
#pragma unroll
                    for (int e = 0; e < 4; ++e) { const int idx = n * 4 + e; const unsigned wf = of[mm][idx >> 1], wb = ob[mm][idx >> 1];
                        const float xf = (idx & 1) ? bfhi(wf) : bflo(wf), xb = (idx & 1) ? bfhi(wb) : bflo(wb);
                        y[idx] = silu_f(gf[e]) * ((xf - mf) * rf) + silu_f(gb[e]) * ((xb - mbb) * rb); } }
                v4u w; w.x = cvt_pk_bf16(y[0], y[1]); w.y = cvt_pk_bf16(y[2], y[3]); w.z = cvt_pk_bf16(y[4], y[5]); w.w = cvt_pk_bf16(y[6], y[7]);
                *(v4u*)(YG + (size_t)r * 4096 + col) = w; } }
    }
};
struct EpiSwiglu {
    static constexpr bool PERM = true, AFTER_DRAIN = false;
    bf16* HID;
    __device__ __forceinline__ void operator()(AccRef acc, const pg8::Unit& u, int wr, int wc, int fr, int fq) const {
        const int col = u.pn * 128 + wc * 32 + 8 * fq, row0 = u.pm * 256 + wr * 64 + fr;
#pragma unroll
        for (int ai = 0; ai < 2; ++ai)
#pragma unroll
            for (int m = 0; m < 4; ++m) { const int r = row0 + ai * 128 + m * 16; float y[8];
#pragma unroll
                for (int n = 0; n < 2; ++n) { const f32x4 a = acc[ai][0][m][n], b = acc[ai][1][m][n];
#pragma unroll
                    for (int e = 0; e < 4; ++e) y[n * 4 + e] = silu_f(a[e]) * b[e]; }
                v4u w; w.x = cvt_pk_bf16(y[0], y[1]); w.y = cvt_pk_bf16(y[2], y[3]); w.z = cvt_pk_bf16(y[4], y[5]); w.w = cvt_pk_bf16(y[6], y[7]);
                *(v4u*)(HID + (size_t)r * FF + col) = w; }
    }
};
struct EpiBf {
    static constexpr bool PERM = true, AFTER_DRAIN = false;
    bf16 *O0, *O1; int ldc, split; float* YP;
    __device__ __forceinline__ void operator()(AccRef acc, const pg8::Unit& u, int wr, int wc, int fr, int fq) const {
        const int row0 = u.pm * 256 + wr * 64 + fr, cw = wc * 32 + 8 * fq;
        if (u.ks >= 0) {
            const int crow0 = ((u.pm - 16) / 17) * 256 + wr * 64 + fr;
#pragma unroll
            for (int ai = 0; ai < 2; ++ai)
#pragma unroll
                for (int m = 0; m < 4; ++m) { float* rp = YP + ((size_t)u.ks * 1024 + crow0 + ai * 128 + m * 16) * 2048 + u.pn * 256 + cw;
#pragma unroll
                    for (int bj = 0; bj < 2; ++bj) { *(f32x4*)(rp + bj * 128) = acc[ai][bj][m][0]; *(f32x4*)(rp + bj * 128 + 4) = acc[ai][bj][m][1]; } }
            return; }
#pragma unroll
        for (int ai = 0; ai < 2; ++ai)
#pragma unroll
            for (int m = 0; m < 4; ++m) { const int r = row0 + ai * 128 + m * 16;
#pragma unroll
                for (int bj = 0; bj < 2; ++bj) { const f32x4 v0 = acc[ai][bj][m][0], v1 = acc[ai][bj][m][1];
                    v4u w; w.x = cvt_pk_bf16(v0[0], v0[1]); w.y = cvt_pk_bf16(v0[2], v0[3]); w.z = cvt_pk_bf16(v1[0], v1[1]); w.w = cvt_pk_bf16(v1[2], v1[3]);
                    bf16* dst = split ? ((bj ? O1 : O0) + (size_t)r * ldc + u.pn * 128 + cw) : (O0 + (size_t)r * ldc + u.pn * 256 + bj * 128 + cw);
                    *(v4u*)dst = w; } }
    }
};
struct EpiF32 {
    static constexpr bool PERM = false, AFTER_DRAIN = false;
    float* C; int ldc;
    __device__ __forceinline__ void operator()(AccRef acc, const pg8::Unit& u, int wr, int wc, int fr, int fq) const {
        const int row0 = u.pm * 256 + wr * 64 + fr, col0 = u.pn * 256 + wc * 32 + 4 * fq;
#pragma unroll
        for (int ai = 0; ai < 2; ++ai)
#pragma unroll
            for (int m = 0; m < 4; ++m) { float* rowp = C + (size_t)(row0 + ai * 128 + m * 16) * ldc + col0;
#pragma unroll
                for (int bj = 0; bj < 2; ++bj)
#pragma unroll
                    for (int n = 0; n < 2; ++n) *(f32x4*)(rowp + bj * 128 + n * 16) = acc[ai][bj][m][n]; }
    }
};
struct EpiDQKV {
    static constexpr bool PERM = true, AFTER_DRAIN = false;
    bf16 *CQ, *CKV, *KR; float* ssq; const float* acs;
    __device__ __forceinline__ void operator()(AccRef acc, const pg8::Unit& u, int wr, int wc, int fr, int fq) const {
        const int row0 = u.pm * 256 + wr * 64 + fr, tj = u.pm % 17; const bool isctx = (tj == 16); const int t0 = tj * 256 + wr * 64 + fr;
        if (u.pn < 4) { bf16* dst = (u.pn < 2) ? CQ : CKV; const int colb = (u.pn & 1) * 256 + wc * 32 + 8 * fq;
#pragma unroll
            for (int ai = 0; ai < 2; ++ai)
#pragma unroll
                for (int m = 0; m < 4; ++m) { const int r = row0 + ai * 128 + m * 16; float q = 0.f;
#pragma unroll
                    for (int bj = 0; bj < 2; ++bj) { const f32x4 v0 = acc[ai][bj][m][0], v1 = acc[ai][bj][m][1];
                        q += (v0[0] * v0[0] + v0[1] * v0[1]) + (v0[2] * v0[2] + v0[3] * v0[3]) + (v1[0] * v1[0] + v1[1] * v1[1]) + (v1[2] * v1[2] + v1[3] * v1[3]);
                        v4u w; w.x = cvt_pk_bf16(v0[0], v0[1]); w.y = cvt_pk_bf16(v0[2], v0[3]); w.z = cvt_pk_bf16(v1[0], v1[1]); w.w = cvt_pk_bf16(v1[2], v1[3]);
                        *(v4u*)(dst + (size_t)r * 512 + colb + bj * 128) = w; }
                    { const int ln = fq * 16 + fr;
                      q += shx(q, 16, ln); q += shx(q, 32, ln); }
                    if (fq == 0) ssq[(size_t)r * 16 + u.pn * 4 + wc] = q; }
        } else if (wc < 2) {
#pragma unroll
            for (int ai = 0; ai < 2; ++ai)
#pragma unroll
                for (int m = 0; m < 4; ++m) { const int r = row0 + ai * 128 + m * 16, t = t0 + ai * 128 + m * 16;
                    f32x4 v0 = acc[ai][0][m][0], v1 = acc[ai][0][m][1];
                    if (!isctx) { const f32x4* cp = (const f32x4*)(acs + ((size_t)t * 32 + 16 * wc + 4 * fq) * 2); const f32x4 c0 = cp[0], c1 = cp[1];
                        v0 = (f32x4){v0[0] * c0[0] - v0[1] * c0[1], v0[0] * c0[1] + v0[1] * c0[0], v0[2] * c0[2] - v0[3] * c0[3], v0[2] * c0[3] + v0[3] * c0[2]};
                        v1 = (f32x4){v1[0] * c1[0] - v1[1] * c1[1], v1[0] * c1[1] + v1[1] * c1[0], v1[2] * c1[2] - v1[3] * c1[3], v1[2] * c1[3] + v1[3] * c1[2]}; }
                    v4u w; w.x = cvt_pk_bf16(v0[0], v0[1]); w.y = cvt_pk_bf16(v0[2], v0[3]); w.z = cvt_pk_bf16(v1[0], v1[1]); w.w = cvt_pk_bf16(v1[2], v1[3]);
                    *(v4u*)(KR + (size_t)r * 64 + wc * 32 + 8 * fq) = w; }
        }
    }
};
__device__ __forceinline__ float rms_rstd(const float* p) { const f32x4 a = *(const f32x4*)p, b = *(const f32x4*)(p + 4); return rsqrtf(((a[0] + a[1]) + (a[2] + a[3]) + (b[0] + b[1]) + (b[2] + b[3])) * (1.0f / 512.0f) + RMS_EPS); }
struct EpiUKV {
    static constexpr bool PERM = true, AFTER_DRAIN = false;
    bf16 *KN, *VB; const float* ssq;
    __device__ __forceinline__ void operator()(AccRef acc, const pg8::Unit& u, int wr, int wc, int fr, int fq) const {
        const int row0 = u.pm * 256 + wr * 64 + fr, cw = u.pn * 128 + wc * 32 + 8 * fq;
#pragma unroll
        for (int ai = 0; ai < 2; ++ai)
#pragma unroll
            for (int m = 0; m < 4; ++m) { const int r = row0 + ai * 128 + m * 16; const float rs = rms_rstd(ssq + (size_t)r * 16 + 8);
#pragma unroll
                for (int bj = 0; bj < 2; ++bj) { const f32x4 v0 = acc[ai][bj][m][0] * rs, v1 = acc[ai][bj][m][1] * rs;
                    v4u w; w.x = cvt_pk_bf16(v0[0], v0[1]); w.y = cvt_pk_bf16(v0[2], v0[3]); w.z = cvt_pk_bf16(v1[0], v1[1]); w.w = cvt_pk_bf16(v1[2], v1[3]);
                    *(v4u*)((bj ? VB : KN) + (size_t)r * 2048 + cw) = w; } }
    }
};
struct EpiUQ {
    static constexpr bool PERM = true, AFTER_DRAIN = false;
    bf16* QB; const float* acs; const float* ssq;
    __device__ __forceinline__ void operator()(AccRef acc, const pg8::Unit& u, int wr, int wc, int fr, int fq) const {
        const int row0 = u.pm * 256 + wr * 64 + fr, tj = u.pm % 17; const bool isctx = (tj == 16); const int t0 = tj * 256 + wr * 64 + fr;
#pragma unroll
        for (int bj = 0; bj < 2; ++bj) { const int blk = 4 * u.pn + 2 * bj + (wc >> 1); const bool rope = ((blk % 3) == 2) && !isctx;
            const int col = u.pn * 256 + bj * 128 + wc * 32 + 8 * fq, p0 = 16 * (wc & 1) + 4 * fq;
#pragma unroll
            for (int ai = 0; ai < 2; ++ai)
#pragma unroll
                for (int m = 0; m < 4; ++m) { const int r = row0 + ai * 128 + m * 16, t = t0 + ai * 128 + m * 16; const float rs = rms_rstd(ssq + (size_t)r * 16);
                    f32x4 v0 = acc[ai][bj][m][0] * rs, v1 = acc[ai][bj][m][1] * rs;
                    if (rope) { const f32x4* cp = (const f32x4*)(acs + ((size_t)t * 32 + p0) * 2); const f32x4 c0 = cp[0], c1 = cp[1];
                        v0 = (f32x4){v0[0] * c0[0] - v0[1] * c0[1], v0[0] * c0[1] + v0[1] * c0[0], v0[2] * c0[2] - v0[3] * c0[3], v0[2] * c0[3] + v0[3] * c0[2]};
                        v1 = (f32x4){v1[0] * c1[0] - v1[1] * c1[1], v1[0] * c1[1] + v1[1] * c1[0], v1[2] * c1[2] - v1[3] * c1[3], v1[2] * c1[3] + v1[3] * c1[2]}; }
                    v4u w; w.x = cvt_pk_bf16(v0[0], v0[1]); w.y = cvt_pk_bf16(v0[2], v0[3]); w.z = cvt_pk_bf16(v1[0], v1[1]); w.w = cvt_pk_bf16(v1[2], v1[3]);
                    *(v4u*)(QB + (size_t)r * 3072 + col) = w; } }
    }
};

__device__ __forceinline__ int srccol(int mode, int n, int halfn) {
    if (mode == 1) { if (n >= 4096) return n; const int d = n & 255; return (n & ~255) + ((d & 1) ? 128 + (d >> 1) : (d >> 1)); }
    if (mode == 2) { const int t = n >> 8, r = n & 255; return (r < 128) ? t * 128 + r : halfn + t * 128 + (r - 128); }
    if (mode == 4) { const int h = n / 192, d = n - h * 192; if (d < 128) return n; const int p = d - 128, hf = p >> 5, dd = p & 31; return h * 192 + 128 + hf * 32 + ((dd & 1) ? 16 + (dd >> 1) : (dd >> 1)); }
    if (mode == 5) { const int hf = n >> 5, dd = n & 31; return 512 + hf * 32 + ((dd & 1) ? 16 + (dd >> 1) : (dd >> 1)); }
    return n;
}
struct CvtJob { const float* W; bf16* WT; int ldw, K, Nd, mode, halfn; const float* kscale; };
template <bool KS> __device__ __forceinline__ void transpose_item(const CvtJob& J, LAS float* scr, int item, int lane) {
    const int nblk = J.Nd / 32, kb = item / nblk, nb = item - kb * nblk, k0 = 64 * kb, n0 = 32 * nb;
    const int sc = srccol(J.mode, n0 + (lane & 31), J.halfn);
#pragma unroll
    for (int i = 0; i < 32; ++i) { const int kk = 2 * i + (lane >> 5); float w = J.W[(size_t)(k0 + kk) * J.ldw + sc]; if (KS) w *= J.kscale[k0 + kk]; scr[kk * 33 + (lane & 31)] = w; }
    LDS_WAIT(); asm volatile("" ::: "memory");
    const int c = lane & 7;
#pragma unroll
    for (int j = 0; j < 4; ++j) { const int n = (lane >> 3) + 8 * j; const LAS float* s = scr + (8 * c) * 33 + n;
        v4u o; o.x = cvt_pk_bf16(s[0 * 33], s[1 * 33]); o.y = cvt_pk_bf16(s[2 * 33], s[3 * 33]); o.z = cvt_pk_bf16(s[4 * 33], s[5 * 33]); o.w = cvt_pk_bf16(s[6 * 33], s[7 * 33]);
        *(v4u*)(J.WT + (size_t)(n0 + n) * J.K + k0 + 8 * c) = o; }
    LDS_WAIT(); asm volatile("" ::: "memory");
}

struct Args { const float* in[21]; float* out; unsigned char* ws; int ph_lo, ph_hi; };
enum { I_X = 0, I_C, I_CTX, I_CCTX, I_ADAW, I_ADAB, I_LNG, I_LNB, I_RWQKV, I_RWG, I_RDEC, I_RWO, I_MWDQ, I_MGQ, I_MWUQ, I_MWDKV, I_MGKV, I_MWUKV, I_MWO, I_FWIN, I_FWOUT };

__device__ __forceinline__ CvtJob cvt_job(const Args& a, int j) {
    unsigned char* ws = a.ws; CvtJob J; J.mode = 0; J.halfn = 0; J.kscale = nullptr;
    if (j < 6) { const int l = j / 3, k = j - 3 * l;
        if (k == 0) { J.W = a.in[I_RWQKV] + (size_t)l * 2048 * 8192; J.WT = (bf16*)(ws + WS_WQKV) + (size_t)l * 8192 * 2048; J.ldw = 8192; J.K = 2048; J.Nd = 8192; J.mode = 1; }
        else if (k == 1) { J.W = a.in[I_RWG] + (size_t)l * 2048 * 8192; J.WT = (bf16*)(ws + WS_WG) + (size_t)l * 8192 * 2048; J.ldw = 8192; J.K = 2048; J.Nd = 8192; J.mode = 2; J.halfn = 4096; }
        else { J.W = a.in[I_RWO] + (size_t)l * 4096 * 2048; J.WT = (bf16*)(ws + WS_WOR) + (size_t)l * 2048 * 4096; J.ldw = 2048; J.K = 4096; J.Nd = 2048; }
    } else if (j < 18) { const int jj = j - 6, l = jj / 6, k = jj - 6 * l; bf16* wd = (bf16*)(ws + WS_WD) + (size_t)l * 1280 * 2048;
        if (k == 0) { J.W = a.in[I_MWDQ] + (size_t)l * 2048 * 512; J.WT = wd; J.ldw = 512; J.K = 2048; J.Nd = 512; }
        else if (k == 1) { J.W = a.in[I_MWDKV] + (size_t)l * 2048 * 576; J.WT = wd + (size_t)512 * 2048; J.ldw = 576; J.K = 2048; J.Nd = 512; }
        else if (k == 2) { J.W = a.in[I_MWDKV] + (size_t)l * 2048 * 576; J.WT = wd + (size_t)1024 * 2048; J.ldw = 576; J.K = 2048; J.Nd = 64; J.mode = 5; }
        else if (k == 3) { J.W = a.in[I_MWUQ] + (size_t)l * 512 * 3072; J.WT = (bf16*)(ws + WS_WUQ) + (size_t)l * 3072 * 512; J.ldw = 3072; J.K = 512; J.Nd = 3072; J.mode = 4; J.kscale = a.in[I_MGQ] + (size_t)l * 512; }
        else if (k == 4) { J.W = a.in[I_MWUKV] + (size_t)l * 512 * 4096; J.WT = (bf16*)(ws + WS_WUKV) + (size_t)l * 4096 * 512; J.ldw = 4096; J.K = 512; J.Nd = 4096; J.kscale = a.in[I_MGKV] + (size_t)l * 512; }
        else { J.W = a.in[I_MWO] + (size_t)l * 2048 * 2048; J.WT = (bf16*)(ws + WS_WOM) + (size_t)l * 2048 * 2048; J.ldw = 2048; J.K = 2048; J.Nd = 2048; }
    } else { const int jj = j - 18, l = jj >> 1;
        if ((jj & 1) == 0) { J.W = a.in[I_FWIN] + (size_t)l * 2048 * 11264; J.WT = (bf16*)(ws + WS_WIN) + (size_t)l * 11264 * 2048; J.ldw = 11264; J.K = 2048; J.Nd = 11264; J.mode = 2; J.halfn = 5632; }
        else { J.W = a.in[I_FWOUT] + (size_t)l * 5632 * 2048; J.WT = (bf16*)(ws + WS_WOUT) + (size_t)l * 2048 * 5632; J.ldw = 2048; J.K = 5632; J.Nd = 2048; }
    }
    return J;
}
constexpr int N_CVT_JOBS = 26;
__host__ __device__ constexpr bool cvt_deferred(int j) { return (j >= 3 && j < 6) || (j >= 12 && j < 18) || (j >= 22); }
constexpr int N_DEF_ITEMS = 2 * 8192 + 4096 + (512 + 512 + 64 + 768 + 1024 + 2048) + 2 * (11264 + 5632);

__device__ __forceinline__ bool def_resolve(const Args& a, int idx, CvtJob& J, int& it) {
    if (idx >= N_DEF_ITEMS) return false;
    int cum = 0;
    for (int j = 0; j < N_CVT_JOBS; ++j) { if (!cvt_deferred(j)) continue; const CvtJob Jj = cvt_job(a, j); const int nit = (Jj.K / 64) * (Jj.Nd / 32);
        if (idx < cum + nit) { J = Jj; it = idx - cum; return true; }
        cum += nit; }
    return false;
}
__device__ __forceinline__ void convert_deferred(const Args& a, LAS float* scr, int lane, int first, int stride, int cnt) {
    for (int k0 = 0; k0 < cnt; k0 += 4) {
        CvtJob J[4]; int it[4]; bool ok[4]; float r[4][32];
#pragma unroll
        for (int q = 0; q < 4; ++q) { ok[q] = def_resolve(a, first + (k0 + q) * stride, J[q], it[q]);
            if (ok[q]) { const int nblk = J[q].Nd / 32, kb = it[q] / nblk, nb = it[q] - kb * nblk, kk0 = 64 * kb, n0 = 32 * nb; const int sc = srccol(J[q].mode, n0 + (lane & 31), J[q].halfn);
                const float* wp = J[q].W + (size_t)(kk0 + (lane >> 5)) * J[q].ldw + sc;
#pragma unroll
                for (int i = 0; i < 32; ++i) r[q][i] = wp[(size_t)(2 * i) * J[q].ldw]; } }
#pragma unroll
        for (int q = 0; q < 4; ++q) { if (!ok[q]) continue;
            const int nblk = J[q].Nd / 32, kb = it[q] / nblk, nb = it[q] - kb * nblk, kk0 = 64 * kb, n0 = 32 * nb;
#pragma unroll
            for (int i = 0; i < 32; ++i) { const int kk = 2 * i + (lane >> 5); float w = r[q][i]; if (J[q].kscale) w *= J[q].kscale[kk0 + kk]; scr[kk * 33 + (lane & 31)] = w; }
            LDS_WAIT(); asm volatile("" ::: "memory");
            const int c = lane & 7;
#pragma unroll
            for (int j = 0; j < 4; ++j) { const int n = (lane >> 3) + 8 * j; const LAS float* s = scr + (8 * c) * 33 + n;
                v4u o; o.x = cvt_pk_bf16(s[0 * 33], s[1 * 33]); o.y = cvt_pk_bf16(s[2 * 33], s[3 * 33]); o.z = cvt_pk_bf16(s[4 * 33], s[5 * 33]); o.w = cvt_pk_bf16(s[6 * 33], s[7 * 33]);
                *(v4u*)(J[q].WT + (size_t)(n0 + n) * J[q].K + kk0 + 8 * c) = o; }
            LDS_WAIT(); asm volatile("" ::: "memory"); }
    }
}
__device__ __forceinline__ void phase_pro_a(const Args& a, LAS unsigned char* lds, int tid, int lane, int wave, int vcu, int G) {
    unsigned char* ws = a.ws;
    const int gw = vcu * NWAVES + wave, NGW = G * NWAVES;
#ifndef PROA_REP_CVT
#define PROA_REP_CVT 1
#endif
#ifndef PROA_REP_GEMV
#define PROA_REP_GEMV 1
#endif
    for (int rep_c = 0; rep_c < PROA_REP_CVT; ++rep_c)
    { LAS float* scr = (LAS float*)(lds + wave * 16384);
      int cum = 0;
      for (int j = 0; j < N_CVT_JOBS; ++j) { if (cvt_deferred(j)) continue; const CvtJob J = cvt_job(a, j); const int nit = (J.K / 64) * (J.Nd / 32);
          int start = (gw - cum) % NGW; if (start < 0) start += NGW;
          if (J.kscale) { for (int it = start; it < nit; it += NGW) transpose_item<true>(J, scr, it, lane); }
          else { for (int it = start; it < nit; it += NGW) transpose_item<false>(J, scr, it, lane); }
          cum = (cum + nit) % NGW; }
      const int gt = vcu * 512 + tid, NT = G * 512;
      for (int l = 0; l < 2; ++l) { v4u* z = (v4u*)((bf16*)(ws + WS_WD) + (size_t)l * 1280 * 2048 + (size_t)1088 * 2048);
          for (int i = gt; i < 192 * 2048 / 8; i += NT) z[i] = (v4u){0u, 0u, 0u, 0u}; }
    }
    __syncthreads();
    { const int gt = vcu * 512 + tid, NT = G * 512; f32x2* rcs = (f32x2*)(ws + WS_RCS); f32x2* acs = (f32x2*)(ws + WS_ACS);
      for (int e = gt; e < 4096 * 128; e += NT) { const int t = e >> 7, j = e & 127; const float inv = exp2f(-((float)j * (1.0f / 127.0f)) * 13.287712379549449f);
          const float ang = (float)t * inv; rcs[e] = (f32x2){cosf(ang), sinf(ang)}; }
      for (int e = gt; e < 4096 * 32; e += NT) { const int t = e >> 5, p = e & 31; const int j = p & 15; const float inv = exp2f(-((float)j * (1.0f / 16.0f)) * 13.287712379549449f);
          const float pos = (p < 16) ? (float)(t >> 6) : (float)(t & 63); const float ang = pos * inv; acs[e] = (f32x2){cosf(ang), sinf(ang)}; }
    }
    { LAS float* sc = (LAS float*)lds;
      LAS float* red = (LAS float*)(lds + 5 * 2048 * 4);
      for (int i = tid; i < 5 * 2048; i += 512) { const float v = (i < 4 * 2048) ? a.in[I_C][i] : a.in[I_CCTX][i - 4 * 2048]; sc[i] = silu_f(v); }
      __syncthreads();
      float* mod = (float*)(ws + WS_MOD);
      const int kq = lane >> 4, c4 = lane & 15;
      for (int rep_g = 0; rep_g < PROA_REP_GEMV; ++rep_g)
      for (int it = vcu; it < 4 * 192; it += G) { const int layer = it / 192, col0 = (it - layer * 192) * 64;
          const float* Wl = a.in[I_ADAW] + (size_t)layer * 2048 * 12288 + col0 + 4 * c4;
          float acc[5][4];
#pragma unroll
          for (int r = 0; r < 5; ++r)
#pragma unroll
              for (int e = 0; e < 4; ++e) acc[r][e] = 0.f;
#pragma unroll 8
          for (int j = 0; j < 64; ++j) { const int k = wave * 256 + 4 * j + kq; const f32x4 w = *(const f32x4*)(Wl + (size_t)k * 12288);
#pragma unroll
              for (int r = 0; r < 5; ++r) { const float s = sc[r * 2048 + k]; acc[r][0] += s * w[0]; acc[r][1] += s * w[1]; acc[r][2] += s * w[2]; acc[r][3] += s * w[3]; } }
#pragma unroll
          for (int r = 0; r < 5; ++r)
#pragma unroll
              for (int e = 0; e < 4; ++e) { float v = acc[r][e]; v += shx(v, 16, lane); v += shx(v, 32, lane); acc[r][e] = v; }
          if (lane < 16) {
#pragma unroll
              for (int r = 0; r < 5; ++r)
#pragma unroll
                  for (int e = 0; e < 4; ++e) red[(wave * 5 + r) * 64 + 4 * c4 + e] = acc[r][e]; }
          __syncthreads();
          if (tid < 320) { const int r = tid >> 6, c = tid & 63; float s = 0.f;
#pragma unroll
              for (int w = 0; w < 8; ++w) s += red[(w * 5 + r) * 64 + c];
              mod[((size_t)layer * 5 + r) * 12288 + col0 + c] = s + a.in[I_ADAB][(size_t)layer * 12288 + col0 + c]; }
          __syncthreads(); }
    }
}

__device__ __forceinline__ const float* src_row(const Args& a, int r, int& r5) {
    const int b = r / TPB, t = r - b * TPB;
    if (t < SEQ) { r5 = b; return a.in[I_X] + ((size_t)b * SEQ + t) * D; }
    r5 = 4; return a.in[I_CTX] + ((size_t)b * CTXL + (t - SEQ)) * D;
}
__device__ __forceinline__ void phase_pro_b(const Args& a, int lane, int wave, int vcu, int G) {
    const int gw = vcu * NWAVES + wave, NGW = G * NWAVES; const float* mod = (const float*)(a.ws + WS_MOD);
    bf16* U = (bf16*)(a.ws + WS_U);
    for (int r = gw; r < M; r += NGW) { int r5; const float* src = src_row(a, r, r5); const float* sh = mod + (size_t)r5 * 12288, *scl = sh + 2048;
#pragma unroll
        for (int j = 0; j < 8; ++j) { const int c = 4 * lane + 256 * j; const f32x4 v = *(const f32x4*)(src + c), s = *(const f32x4*)(scl + c), t = *(const f32x4*)(sh + c);
            const f32x4 uu = v * (1.0f + s) + t;
            v2u w; w.x = cvt_pk_bf16(uu[0], uu[1]); w.y = cvt_pk_bf16(uu[2], uu[3]); *(v2u*)(U + (size_t)r * D + c) = w; } }
}
template <bool FIRST> __device__ __forceinline__ void phase_ln_t(const Args& a, int layer, int which, LAS unsigned char* lds, int tid, int lane, int wave, int vcu, int G, bool dry) {
    const float* mod = (const float*)(a.ws + WS_MOD);
    const h16* H = (const h16*)(a.ws + WS_H); h16* Hw = (h16*)(a.ws + (dry ? WS_END : WS_H)); bf16* U = (bf16*)(a.ws + (dry ? WS_END + 136 * MiB : WS_U)); const bf16* Y = (const bf16*)(a.ws + WS_Y);
    const bool latonly = (layer == DEPTH - 1), final = (layer == DEPTH - 1) && which == 1; const bool ysplit = !latonly; const float* YP = (const float*)(a.ws + WS_YP);
    const float* lg = a.in[I_LNG] + ((size_t)layer * 2 + which) * D; const float* lb = a.in[I_LNB] + ((size_t)layer * 2 + which) * D;
    const int gch = which ? 5 : 2; const int nlayer = final ? 0 : (which ? layer + 1 : layer), nsh = which ? 0 : 3;
    const int nrows = latonly ? BATCH * SEQ : M, rpc = nrows / G;
    LAS float* V = (LAS float*)lds;
    if (G != 256) return;
    const int bb = vcu >> 6, c6 = vcu & 63; const int i0 = 0;
    __syncthreads();
    {
        const int i4 = 4 * tid; f32x4 v8[8];
#pragma unroll
        for (int v = 0; v < 2; ++v) { const int r5 = v ? 4 : bb;
            v8[v * 3 + 0] = *(const f32x4*)(mod + ((size_t)layer * 5 + r5) * 12288 + gch * 2048 + i4);
            v8[v * 3 + 1] = *(const f32x4*)(mod + ((size_t)nlayer * 5 + r5) * 12288 + nsh * 2048 + i4);
            v8[v * 3 + 2] = *(const f32x4*)(mod + ((size_t)nlayer * 5 + r5) * 12288 + (nsh + 1) * 2048 + i4); }
        v8[6] = *(const f32x4*)(lg + i4); v8[7] = *(const f32x4*)(lb + i4);
#pragma unroll
        for (int v = 0; v < 8; ++v) *(LAS f32x4*)(V + v * 2048 + i4) = v8[v]; }

    __syncthreads();
    for (int k = wave; k < rpc; k += 2 * NWAVES) {
        f32x4 z[2][8]; int rr[2], tt[2]; bool ok[2];
#pragma unroll
        for (int q = 0; q < 2; ++q) { const int kk = k + q * NWAVES; ok[q] = kk < rpc; const int ii = ok[q] ? kk : 0;
            const int t = (ii < 64) ? c6 * 64 + ii : SEQ + c6 * 4 + (ii - 64); const int r = bb * TPB + t; rr[q] = r; tt[q] = t;
            const LAS float* gate = V + (t < SEQ ? 0 : 3) * 2048;
            const float* xrow = (t < SEQ) ? a.in[I_X] + ((size_t)bb * SEQ + t) * D : a.in[I_CTX] + ((size_t)bb * CTXL + (t - SEQ)) * D; const h16* hrow = H + (size_t)r * D;
            f32x4 hv[8], yv[8];
            if (FIRST) {
#pragma unroll
                for (int j = 0; j < 8; ++j) hv[j] = *(const f32x4*)(xrow + 4 * lane + 256 * j);
            } else {
#pragma unroll
                for (int j = 0; j < 8; ++j) hv[j] = __builtin_convertvector(*(const h16x4*)(hrow + 4 * lane + 256 * j), f32x4);
            }
            if (ysplit && t >= SEQ) { const float* yp = YP + ((size_t)bb * CTXL + (t - SEQ)) * D + 4 * lane;
#pragma unroll
                for (int jh = 0; jh < 2; ++jh) { f32x4 p[4][4];
#pragma unroll
                    for (int jj = 0; jj < 4; ++jj)
#pragma unroll
                        for (int s4 = 0; s4 < 4; ++s4) p[jj][s4] = *(const f32x4*)(yp + 256 * (4 * jh + jj) + (size_t)s4 * 1024 * D);
#pragma unroll
                    for (int jj = 0; jj < 4; ++jj) yv[4 * jh + jj] = (p[jj][0] + p[jj][1]) + (p[jj][2] + p[jj][3]); }
            } else {
#pragma unroll
                for (int j = 0; j < 8; ++j) { const v2u yw = *(const v2u*)(Y + (size_t)r * D + 4 * lane + 256 * j); yv[j] = (f32x4){bflo(yw.x), bfhi(yw.x), bflo(yw.y), bfhi(yw.y)}; }
            }
#pragma unroll
            for (int j = 0; j < 8; ++j) { const int c = 4 * lane + 256 * j; const f32x4 g = *(const LAS f32x4*)(gate + c);
                z[q][j] = hv[j] * ALPHA + g * yv[j]; } }
        float s0 = 0.f, s1 = 0.f;
#pragma unroll
        for (int j = 0; j < 8; ++j) { s0 += (z[0][j][0] + z[0][j][1]) + (z[0][j][2] + z[0][j][3]); s1 += (z[1][j][0] + z[1][j][1]) + (z[1][j][2] + z[1][j][3]); }
#pragma unroll
        for (int o = 1; o < 64; o <<= 1) { s0 += shx(s0, o, lane); s1 += shx(s1, o, lane); }
        const float m0 = s0 * (1.0f / D), m1 = s1 * (1.0f / D); float q0 = 0.f, q1 = 0.f;
#pragma unroll
        for (int j = 0; j < 8; ++j) { z[0][j] = z[0][j] - m0; z[1][j] = z[1][j] - m1;
            q0 += (z[0][j][0] * z[0][j][0] + z[0][j][1] * z[0][j][1]) + (z[0][j][2] * z[0][j][2] + z[0][j][3] * z[0][j][3]);
            q1 += (z[1][j][0] * z[1][j][0] + z[1][j][1] * z[1][j][1]) + (z[1][j][2] * z[1][j][2] + z[1][j][3] * z[1][j][3]); }
#pragma unroll
        for (int o = 1; o < 64; o <<= 1) { q0 += shx(q0, o, lane); q1 += shx(q1, o, lane); }
        const float rs[2] = {rsqrtf(q0 * (1.0f / D) + LN_EPS), rsqrtf(q1 * (1.0f / D) + LN_EPS)};
#pragma unroll
        for (int q = 0; q < 2; ++q) { if (!ok[q]) continue; const int r = rr[q], t = tt[q]; const LAS float* nm = V + ((t < SEQ ? 0 : 3) + 1) * 2048;
#pragma unroll
            for (int j = 0; j < 8; ++j) { const int c = 4 * lane + 256 * j; const f32x4 gg = *(const LAS f32x4*)(V + 6 * 2048 + c), bv = *(const LAS f32x4*)(V + 7 * 2048 + c);
                const f32x4 hn = z[q][j] * rs[q] * gg + bv;
                if (final) { if (!dry) *(f32x4*)(a.out + ((size_t)bb * SEQ + t) * D + c) = hn; else *(h16x4*)(Hw + (size_t)r * D + c) = __builtin_convertvector(hn, h16x4); }
                else { *(h16x4*)(Hw + (size_t)r * D + c) = __builtin_convertvector(hn, h16x4); const f32x4 sh = *(const LAS f32x4*)(nm + c), sc = *(const LAS f32x4*)(nm + 2048 + c); const f32x4 uu = hn * (1.0f + sc) + sh;
                    v2u w; w.x = cvt_pk_bf16(uu[0], uu[1]); w.y = cvt_pk_bf16(uu[2], uu[3]); *(v2u*)(U + (size_t)r * D + c) = w; } } }
    }
    __syncthreads();
}
__device__ __forceinline__ void phase_ln(const Args& a, int layer, int which, LAS unsigned char* lds, int tid, int lane, int wave, int vcu, int G, bool dry = false) {
    if (layer == 0 && which == 0) phase_ln_t<true>(a, layer, which, lds, tid, lane, wave, vcu, G, dry); else phase_ln_t<false>(a, layer, which, lds, tid, lane, wave, vcu, G, dry);
}
__device__ __forceinline__ void phase_mla_norm(const Args& a, int ml, int lane, int wave, int vcu, int G) {
    const int gw = vcu * NWAVES + wave, NGW = G * NWAVES;
    const float* C = (const float*)(a.ws + WS_CQKV); bf16* CQN = (bf16*)(a.ws + WS_CQN); bf16* CKVN = (bf16*)(a.ws + WS_CKVN); bf16* KR = (bf16*)(a.ws + WS_KR);
    const float* gq = a.in[I_MGQ] + (size_t)ml * 512; const float* gkv = a.in[I_MGKV] + (size_t)ml * 512; const f32x2* acs = (const f32x2*)(a.ws + WS_ACS);
    for (int r = gw; r < M; r += NGW) { const float* row = C + (size_t)r * 1280; const int b = r / TPB, t = r - b * TPB;
        f32x4 q0 = *(const f32x4*)(row + 4 * lane), q1 = *(const f32x4*)(row + 256 + 4 * lane), k0 = *(const f32x4*)(row + 512 + 4 * lane), k1 = *(const f32x4*)(row + 768 + 4 * lane);
        float sq = (q0[0] * q0[0] + q0[1] * q0[1]) + (q0[2] * q0[2] + q0[3] * q0[3]) + (q1[0] * q1[0] + q1[1] * q1[1]) + (q1[2] * q1[2] + q1[3] * q1[3]);
        float sk = (k0[0] * k0[0] + k0[1] * k0[1]) + (k0[2] * k0[2] + k0[3] * k0[3]) + (k1[0] * k1[0] + k1[1] * k1[1]) + (k1[2] * k1[2] + k1[3] * k1[3]);
        const float rq = rsqrtf(wave_sum(sq, lane) * (1.0f / 512.0f) + RMS_EPS), rk = rsqrtf(wave_sum(sk, lane) * (1.0f / 512.0f) + RMS_EPS);
        const f32x4 g0 = *(const f32x4*)(gq + 4 * lane), g1 = *(const f32x4*)(gq + 256 + 4 * lane), h0 = *(const f32x4*)(gkv + 4 * lane), h1 = *(const f32x4*)(gkv + 256 + 4 * lane);
        q0 = q0 * rq * g0; q1 = q1 * rq * g1; k0 = k0 * rk * h0; k1 = k1 * rk * h1;
        v2u w; w.x = cvt_pk_bf16(q0[0], q0[1]); w.y = cvt_pk_bf16(q0[2], q0[3]); *(v2u*)(CQN + (size_t)r * 512 + 4 * lane) = w;
        w.x = cvt_pk_bf16(q1[0], q1[1]); w.y = cvt_pk_bf16(q1[2], q1[3]); *(v2u*)(CQN + (size_t)r * 512 + 256 + 4 * lane) = w;
        w.x = cvt_pk_bf16(k0[0], k0[1]); w.y = cvt_pk_bf16(k0[2], k0[3]); *(v2u*)(CKVN + (size_t)r * 512 + 4 * lane) = w;
        w.x = cvt_pk_bf16(k1[0], k1[1]); w.y = cvt_pk_bf16(k1[2], k1[3]); *(v2u*)(CKVN + (size_t)r * 512 + 256 + 4 * lane) = w;
        if (lane < 32) { f32x2 kr = *(const f32x2*)(row + 1024 + 2 * lane);
            if (t < SEQ) { const f32x2 cs = acs[(size_t)t * 32 + lane]; kr = (f32x2){kr[0] * cs[0] - kr[1] * cs[1], kr[0] * cs[1] + kr[1] * cs[0]}; }
            *(unsigned*)(KR + (size_t)r * 64 + 2 * lane) = cvt_pk_bf16(kr[0], kr[1]); } }
}

constexpr int RQ_RS = 528, RV_RS = 288, RP_RS = 144;
__device__ __forceinline__ int koff(int row, int ch32) { const int f = ((row & 3) << 2) | ((row >> 2) & 3); return (ch32 >> 4) * 16384 + row * 256 + (((ch32 & 15) ^ f) << 4); }
constexpr int RL_Q = 0, RL_K = RL_Q + 64 * RQ_RS, RL_V = RL_K + 32768, RL_P = RL_V + 64 * RV_RS, RL_OT = RL_P + 64 * RP_RS, RL_FAC = RL_OT + 64 * 272, RL_END = RL_FAC + 4 * 64 * 4;
constexpr int ROT_RS = 272;
static_assert(RL_END <= RING_BYTES, "retention LDS map");
template <int OFF> __device__ __forceinline__ s16x4 tr_read(int addr) {
    s16x4 r; asm volatile("ds_read_b64_tr_b16 %0, %1 offset:%2" : "=&v"(r) : "v"(addr), "i"(OFF) : "memory"); return r;
}
template <int CTL> __device__ __forceinline__ float dpp_ctl(float v) { return __int_as_float(__builtin_amdgcn_update_dpp(0, __float_as_int(v), CTL, 0xf, 0xf, false)); }
template <int N> __device__ __forceinline__ float dpp_ror(float v) { return __int_as_float(__builtin_amdgcn_update_dpp(0, __float_as_int(v), 0x120 + N, 0xf, 0xf, false)); }
__device__ __forceinline__ bf16x8 cat4(s16x4 l, s16x4 h) { return (bf16x8){l[0], l[1], l[2], l[3], h[0], h[1], h[2], h[3]}; }

__device__ __forceinline__ void phase_ret_scan(const Args& a, int rl, LAS unsigned char* lds, int tid, int lane, int wave, int vcu, int G) {
    const bf16* Qg = (const bf16*)(a.ws + WS_RQ); const bf16* Kg = (const bf16*)(a.ws + WS_RK); const bf16* Vg = (const bf16*)(a.ws + WS_RV);
    bf16* OFg = (bf16*)(a.ws + WS_OF); bf16* OBg = (bf16*)(a.ws + WS_OB); f32x2* part = (f32x2*)(a.ws + WS_PART);
    LAS float* fac = (LAS float*)(lds + RL_FAC);
    const int ldsb = (int)(uintptr_t)lds;
    for (int item = vcu; item < 256; item += G) {
        const int slice = item & 3, dir = (item >> 2) & 1, h = (item >> 3) & 7, b = item >> 6;
        __syncthreads();
        if (tid < 64) { const float x = a.in[I_RDEC][(size_t)rl * 16 + dir * 8 + h]; const float lg = -log1pf(expf(-x));
            const int i = tid;
            fac[i] = dir ? expf(-lg * (float)i) : expf(lg * (float)(i - 63));
            fac[64 + i] = dir ? expf(lg * (float)(64 - i)) : expf(lg * (float)(i + 1));
            fac[128 + i] = dir ? expf(lg * (float)i) : expf(lg * (float)(63 - i));
            if (i == 0) fac[192] = expf(lg * 64.0f); }
        __syncthreads();
#define RET_ROWBASE(n) ({ int _cc, _rb; if ((n) < 4) { _cc = dir ? 3 - (n) : (n); _rb = b * TPB + SEQ + 64 * _cc; } else { _cc = dir ? 63 - ((n) - 4) : (n) - 4; _rb = b * TPB + 64 * _cc; } _rb; })
        if (wave < 4) {
            __builtin_amdgcn_s_setprio(2);
            int lane_c = lane; asm volatile("" : "+v"(lane_c));
            const int g = lane_c >> 4, c16 = lane_c & 15, q4 = c16 >> 2, p4 = lane_c & 3;
            const int cw = wave, sa = cw >> 1, sb = cw & 1;
            const float cdec = fac[192];
            const float pf[2] = {fac[16 * (2 * sa) + c16], fac[16 * (2 * sa + 1) + c16]};
            int kb[4][2];
#pragma unroll
            for (int u = 0; u < 4; ++u)
#pragma unroll
                for (int t = 0; t < 2; ++t) { const int row = 8 * g + 4 * t + q4, f = ((row & 3) << 2) | ((row >> 2) & 3); kb[u][t] = ldsb + RL_K + row * 256 + (((4 * u + p4) ^ f) << 4); }
            pg8::f32x4 S[2][16];
#pragma unroll
            for (int nb = 0; nb < 2; ++nb)
#pragma unroll
                for (int T = 0; T < 16; ++T) S[nb][T] = (pg8::f32x4){0.f, 0.f, 0.f, 0.f};
            for (int n = 0; n < 68; ++n) {
                __syncthreads();
                { pg8::f32x4 sc[2][2];
#pragma unroll
                  for (int ti = 0; ti < 2; ++ti)
#pragma unroll
                      for (int tj = 0; tj < 2; ++tj) sc[ti][tj] = (pg8::f32x4){0.f, 0.f, 0.f, 0.f};
                  bf16x8 fq_[2][2], fa_[2][2];
#pragma unroll
                  for (int t = 0; t < 2; ++t) { fq_[0][t] = *(const LAS bf16x8*)(lds + RL_Q + (16 * (2 * sa + t) + c16) * RQ_RS + (8 * g) * 2); fa_[0][t] = *(const LAS bf16x8*)(lds + RL_K + koff(16 * (2 * sb + t) + c16, g)); }
#pragma unroll
                  for (int s = 0; s < 8; ++s) {
                      if (s < 7) {
#pragma unroll
                          for (int t = 0; t < 2; ++t) { fq_[(s + 1) & 1][t] = *(const LAS bf16x8*)(lds + RL_Q + (16 * (2 * sa + t) + c16) * RQ_RS + (32 * (s + 1) + 8 * g) * 2);
                              fa_[(s + 1) & 1][t] = *(const LAS bf16x8*)(lds + RL_K + koff(16 * (2 * sb + t) + c16, 4 * (s + 1) + g)); } }
#pragma unroll
                      for (int ti = 0; ti < 2; ++ti)
#pragma unroll
                          for (int tj = 0; tj < 2; ++tj) sc[ti][tj] = __builtin_amdgcn_mfma_f32_16x16x32_bf16(fa_[s & 1][tj], fq_[s & 1][ti], sc[ti][tj], 0, 0, 0); }
#pragma unroll
                  for (int ti = 0; ti < 2; ++ti) { const int i = 16 * (2 * sa + ti) + c16;
#pragma unroll
                      for (int tj = 0; tj < 2; ++tj) { const pg8::f32x4 scv = sc[ti][tj]; const int j0 = 16 * (2 * sb + tj) + 4 * g; float pv[4];
#pragma unroll
                          for (int r = 0; r < 4; ++r) { const int j = j0 + r; const bool keep = dir ? (j >= i) : (j <= i); pv[r] = keep ? scv[r] * pf[ti] : 0.f; }
                          v2u w; w.x = cvt_pk_bf16(pv[0], pv[1]); w.y = cvt_pk_bf16(pv[2], pv[3]);
                          *(LAS v2u*)(lds + RL_P + i * RP_RS + j0 * 2) = w; } } }
                pg8::f32x4 o[2][4];
#pragma unroll
                for (int nb = 0; nb < 2; ++nb)
#pragma unroll
                    for (int ib = 0; ib < 4; ++ib) o[nb][ib] = (pg8::f32x4){0.f, 0.f, 0.f, 0.f};
                { bf16x8 aq[2][4];
#pragma unroll
                  for (int ib = 0; ib < 4; ++ib) aq[0][ib] = *(const LAS bf16x8*)(lds + RL_Q + (16 * ib + c16) * RQ_RS + (8 * g) * 2);
#pragma unroll
                  for (int s = 0; s < 8; ++s) {
                      if (s < 7) {
#pragma unroll
                          for (int ib = 0; ib < 4; ++ib) aq[(s + 1) & 1][ib] = *(const LAS bf16x8*)(lds + RL_Q + (16 * ib + c16) * RQ_RS + (32 * (s + 1) + 8 * g) * 2); }
                      bf16x8 bs[2];
#pragma unroll
                      for (int nb = 0; nb < 2; ++nb) { v4u bw; bw.x = cvt_pk_bf16(S[nb][2 * s][0], S[nb][2 * s][1]); bw.y = cvt_pk_bf16(S[nb][2 * s][2], S[nb][2 * s][3]); bw.z = cvt_pk_bf16(S[nb][2 * s + 1][0], S[nb][2 * s + 1][1]); bw.w = cvt_pk_bf16(S[nb][2 * s + 1][2], S[nb][2 * s + 1][3]);
                          bs[nb] = __builtin_bit_cast(bf16x8, bw); }
#pragma unroll
                      for (int ib = 0; ib < 4; ++ib)
#pragma unroll
                          for (int nb = 0; nb < 2; ++nb) o[nb][ib] = __builtin_amdgcn_mfma_f32_16x16x32_bf16(aq[s & 1][ib], bs[nb], o[nb][ib], 0, 0, 0); } }
#pragma unroll
                for (int ib = 0; ib < 4; ++ib)
#pragma unroll
                    for (int r = 0; r < 4; ++r) { const float qf = fac[64 + 16 * ib + 4 * g + r]; o[0][ib][r] *= qf; o[1][ib][r] *= qf; }
                bf16x8 bv[2][2];
                { const int va = ldsb + RL_V + (8 * g + q4) * RV_RS + (32 * cw + 4 * p4) * 2;
                  const s16x4 l0 = tr_read<0>(va), h0 = tr_read<4 * RV_RS>(va), l1 = tr_read<32 * RV_RS>(va), h1 = tr_read<36 * RV_RS>(va);
                  const s16x4 m0 = tr_read<32>(va), n0 = tr_read<32 + 4 * RV_RS>(va), m1 = tr_read<32 + 32 * RV_RS>(va), n1 = tr_read<32 + 36 * RV_RS>(va);
                  LDS_WAIT(); SBAR();
                  bv[0][0] = cat4(l0, h0); bv[0][1] = cat4(l1, h1); bv[1][0] = cat4(m0, n0); bv[1][1] = cat4(m1, n1); }
                {
#define KTR(T, ks, t) tr_read<(ks) * 8192 + ((T) >> 3) * 16384 + ((T) & 1) * 8>(kb[((T) >> 1) & 3][t])
#define KLOAD(T, L0, H0, L1, H1) do { L0 = KTR(T, 0, 0); H0 = KTR(T, 0, 1); L1 = KTR(T, 1, 0); H1 = KTR(T, 1, 1); } while (0)
#define KMMA(T, L0, H0, L1, H1) do { const bf16x8 A0_ = cat4(L0, H0), A1_ = cat4(L1, H1); \
                      pg8::f32x4 ac0_ = S[0][T] * cdec, ac1_ = S[1][T] * cdec; \
                      ac0_ = __builtin_amdgcn_mfma_f32_16x16x32_bf16(A0_, bv[0][0], ac0_, 0, 0, 0); ac1_ = __builtin_amdgcn_mfma_f32_16x16x32_bf16(A0_, bv[1][0], ac1_, 0, 0, 0); \
                      ac0_ = __builtin_amdgcn_mfma_f32_16x16x32_bf16(A1_, bv[0][1], ac0_, 0, 0, 0); ac1_ = __builtin_amdgcn_mfma_f32_16x16x32_bf16(A1_, bv[1][1], ac1_, 0, 0, 0); \
                      S[0][T] = ac0_; S[1][T] = ac1_; } while (0)
                  s16x4 xa0, xa1, xa2, xa3, ya0, ya1, ya2, ya3;
                  KLOAD(0, xa0, xa1, xa2, xa3);
#define KGROUP(T, LAST) do { KLOAD(T + 1, ya0, ya1, ya2, ya3); \
                      asm volatile("s_waitcnt lgkmcnt(4)" ::: "memory"); SBAR(); \
                      KMMA(T, xa0, xa1, xa2, xa3); \
                      if (!(LAST)) { KLOAD(((T) + 2) & 15, xa0, xa1, xa2, xa3); asm volatile("s_waitcnt lgkmcnt(4)" ::: "memory"); } \
                      else asm volatile("s_waitcnt lgkmcnt(0)" ::: "memory"); \
                      SBAR(); \
                      KMMA(T + 1, ya0, ya1, ya2, ya3); } while (0)
                  KGROUP(0, false); KGROUP(2, false); KGROUP(4, false); KGROUP(6, false); KGROUP(8, false); KGROUP(10, false); KGROUP(12, false); KGROUP(14, true);
#undef KGROUP
#undef KTR
#undef KLOAD
#undef KMMA
                }
                __syncthreads();
#pragma unroll
                for (int ks = 0; ks < 2; ++ks)
#pragma unroll
                    for (int ib = 0; ib < 4; ++ib) { const bf16x8 ap = *(const LAS bf16x8*)(lds + RL_P + (16 * ib + c16) * RP_RS + (32 * ks + 8 * g) * 2);
                        o[0][ib] = __builtin_amdgcn_mfma_f32_16x16x32_bf16(ap, bv[0][ks], o[0][ib], 0, 0, 0); o[1][ib] = __builtin_amdgcn_mfma_f32_16x16x32_bf16(ap, bv[1][ks], o[1][ib], 0, 0, 0); }
#pragma unroll
                for (int nb = 0; nb < 2; ++nb)
#pragma unroll
                    for (int ib = 0; ib < 4; ++ib)
#pragma unroll
                        for (int r = 0; r < 4; ++r) *(LAS unsigned short*)(lds + RL_OT + (16 * ib + 4 * g + r) * ROT_RS + (32 * cw + 16 * nb + c16) * 2) = __builtin_bit_cast(unsigned short, (__bf16)o[nb][ib][r]);
            }
            __builtin_amdgcn_s_setprio(0);
            __syncthreads();
        } else {
            int lt_ = tid - 256; asm volatile("" : "+v"(lt_)); const int lt = lt_; bf16* Og = dir ? OBg : OFg;
            const int qrow = lt >> 5, qch = lt & 31, vrow = lt >> 4, vch = lt & 15;
            v4u sq[8], sk[8], sv[4];
#define RET_LOAD(n) do { const int _rb = RET_ROWBASE(n); \
            _Pragma("unroll") for (int e = 0; e < 8; ++e) { sq[e] = *(const v4u*)(Qg + (size_t)(_rb + qrow + 8 * e) * 2048 + h * 256 + qch * 8); sk[e] = *(const v4u*)(Kg + (size_t)(_rb + qrow + 8 * e) * 2048 + h * 256 + qch * 8); } \
            _Pragma("unroll") for (int e = 0; e < 4; ++e) sv[e] = *(const v4u*)(Vg + (size_t)(_rb + vrow + 16 * e) * 4096 + h * 512 + slice * 128 + vch * 8); } while (0)
#define RET_STAGE() do { \
            _Pragma("unroll") for (int e = 0; e < 8; ++e) { *(LAS v4u*)(lds + RL_Q + (qrow + 8 * e) * RQ_RS + qch * 16) = sq[e]; *(LAS v4u*)(lds + RL_K + koff(qrow + 8 * e, qch)) = sk[e]; } \
            _Pragma("unroll") for (int e = 0; e < 4; ++e) { const float vf = fac[128 + vrow + 16 * e]; v4u w; \
                w.x = cvt_pk_bf16(bflo(sv[e].x) * vf, bfhi(sv[e].x) * vf); w.y = cvt_pk_bf16(bflo(sv[e].y) * vf, bfhi(sv[e].y) * vf); \
                w.z = cvt_pk_bf16(bflo(sv[e].z) * vf, bfhi(sv[e].z) * vf); w.w = cvt_pk_bf16(bflo(sv[e].w) * vf, bfhi(sv[e].w) * vf); \
                *(LAS v4u*)(lds + RL_V + (vrow + 16 * e) * RV_RS + vch * 16) = w; } } while (0)
#define RET_OSTORE(n) do { const int rowprev = RET_ROWBASE(n); \
            _Pragma("unroll") for (int e = 0; e < 2; ++e) { const int orow = (lt >> 3) + 32 * e, ocg = lt & 7; const LAS v4u* op = (const LAS v4u*)(lds + RL_OT + orow * ROT_RS + ocg * 32); const v4u w0 = op[0], w1 = op[1]; \
              float s1 = 0.f, s2 = 0.f; \
              _Pragma("unroll") for (int q = 0; q < 4; ++q) { const float a0 = bflo(w0[q]), a1 = bfhi(w0[q]), b0 = bflo(w1[q]), b1 = bfhi(w1[q]); s1 += (a0 + a1) + (b0 + b1); s2 += (a0 * a0 + a1 * a1) + (b0 * b0 + b1 * b1); } \
              s1 += dpp_ctl<0xB1>(s1); s2 += dpp_ctl<0xB1>(s2); s1 += dpp_ctl<0x4E>(s1); s2 += dpp_ctl<0x4E>(s2); s1 += dpp_ctl<0x141>(s1); s2 += dpp_ctl<0x141>(s2); \
              v4u* gp = (v4u*)(Og + (size_t)(rowprev + orow) * 4096 + h * 512 + slice * 128 + ocg * 16); gp[0] = w0; gp[1] = w1; \
              if (ocg == 0) part[(size_t)(rowprev + orow) * 64 + h * 8 + dir * 4 + slice] = (f32x2){s1, s2}; } } while (0)
            RET_LOAD(0);
            RET_STAGE();
            for (int n = 0; n < 68; ++n) {
                __syncthreads();
                if (n + 1 < 68) RET_LOAD(n + 1);
                if (n > 0) RET_OSTORE(n - 1);
                __syncthreads();
                if (n + 1 < 68) RET_STAGE();
            }
            __syncthreads();
            RET_OSTORE(67);
#undef RET_LOAD
#undef RET_STAGE
#undef RET_OSTORE
        }
#undef RET_ROWBASE
    }
}

namespace att {
constexpr int KVBLK = 64, QBLK = 32;
constexpr int LDQ = 3072, LDKN = 2048, LDKR = 64, LDV = 2048, LDO = 2048;
constexpr float SCALE = MLA_SCALE;
constexpr float THR = 8.f;
constexpr int SHM_V = KVBLK * 128 * 2, SHM_K = KVBLK * 128 * 2, SHM_R = KVBLK * 64 * 2;
constexpr int L_V = 0, L_K = 2 * SHM_V, L_R = L_K + 2 * SHM_K, L_WS = L_R + 2 * SHM_R, L_END = L_WS + NWAVES * 64 * 4;
static_assert(L_END <= RING_BYTES, "attention LDS map");
#define KSWZ(row, colB) ((row) * 256 + ((colB) ^ (((row) & 7) << 4)))
#define RSWZ(row, colB) ((row) * 128 + ((colB) ^ (((row) & 7) << 4)))
__device__ __forceinline__ int crow(int r, int hi) { return (r & 3) + 8 * (r >> 2) + 4 * hi; }
__device__ __forceinline__ void partialSM(f32x16& p0, f32x16& p1, float& m_reg, float& mn, float& alpha) {
  constexpr float C = SCALE * 1.4426950408889634f;
  float pmax = p0[0];
#pragma unroll
  for (int r = 1; r < 16; ++r) pmax = fmaxf(pmax, p0[r]);
#pragma unroll
  for (int r = 0; r < 16; ++r) pmax = fmaxf(pmax, p1[r]);
  { auto rr = __builtin_amdgcn_permlane32_swap(__float_as_uint(pmax), __float_as_uint(pmax), false, false);
    pmax = fmaxf(__uint_as_float(rr[0]), __uint_as_float(rr[1])); }
  if (__builtin_expect(__all(pmax - m_reg <= THR / SCALE), 1)) { mn = m_reg; alpha = 1.f; }
  else { mn = fmaxf(m_reg, pmax); alpha = __builtin_amdgcn_exp2f((m_reg - mn) * C); m_reg = mn; }
  const float mnC = -mn * C;
#pragma unroll
  for (int r = 0; r < 16; ++r) p0[r] = fmaf(p0[r], C, mnC);
#pragma unroll
  for (int r = 0; r < 16; ++r) p1[r] = fmaf(p1[r], C, mnC);
#pragma unroll
  for (int r = 0; r < 16; ++r) p0[r] = __builtin_amdgcn_exp2f(p0[r]);
}
__device__ __forceinline__ void finishSM(f32x16& p0, f32x16& p1, float alpha, float& l_reg, bf16x8& pa0, bf16x8& pa1, bf16x8& pa2, bf16x8& pa3) {
#pragma unroll
  for (int r = 0; r < 16; ++r) p1[r] = __builtin_amdgcn_exp2f(p1[r]);
  float ps = 0;
#pragma unroll
  for (int r = 0; r < 16; ++r) ps += p0[r];
#pragma unroll
  for (int r = 0; r < 16; ++r) ps += p1[r];
  { auto rr = __builtin_amdgcn_permlane32_swap(__float_as_uint(ps), __float_as_uint(ps), false, false);
    ps = __uint_as_float(rr[0]) + __uint_as_float(rr[1]); }
  l_reg = l_reg * alpha + ps;
#define PK4(P, BASE, OUT) do { unsigned a0 = cvt_pk_bf16(P[BASE + 0], P[BASE + 1]), a1 = cvt_pk_bf16(P[BASE + 2], P[BASE + 3]);   \
    unsigned b0 = cvt_pk_bf16(P[BASE + 4], P[BASE + 5]), b1 = cvt_pk_bf16(P[BASE + 6], P[BASE + 7]);                              \
    auto r0 = __builtin_amdgcn_permlane32_swap(a0, b0, false, false); auto r1 = __builtin_amdgcn_permlane32_swap(a1, b1, false, false); \
    v4u w = {r0[0], r1[0], r0[1], r1[1]}; OUT = __builtin_bit_cast(bf16x8, w); } while (0)
  PK4(p0, 0, pa0); PK4(p0, 8, pa1); PK4(p1, 0, pa2); PK4(p1, 8, pa3);
#undef PK4
}
__device__ __forceinline__ void qkt(f32x16& p0, f32x16& p1, const LAS unsigned char* Ks, const LAS unsigned char* Rs, const bf16x8 (&qr)[12], int r32, int hi) {
  p0 = f32x16{}; p1 = f32x16{};
#pragma unroll
  for (int d0 = 0; d0 < 8; ++d0) { const int cb = (d0 * 16 + hi * 8) * 2;
    const bf16x8 b0 = *(const LAS bf16x8*)(Ks + KSWZ(r32, cb));
    const bf16x8 b1 = *(const LAS bf16x8*)(Ks + KSWZ(32 + r32, cb));
    p0 = __builtin_amdgcn_mfma_f32_32x32x16_bf16(b0, qr[d0], p0, 0, 0, 0);
    p1 = __builtin_amdgcn_mfma_f32_32x32x16_bf16(b1, qr[d0], p1, 0, 0, 0); }
#pragma unroll
  for (int d0 = 0; d0 < 4; ++d0) { const int cb = (d0 * 16 + hi * 8) * 2;
    const bf16x8 b0 = *(const LAS bf16x8*)(Rs + RSWZ(r32, cb));
    const bf16x8 b1 = *(const LAS bf16x8*)(Rs + RSWZ(32 + r32, cb));
    p0 = __builtin_amdgcn_mfma_f32_32x32x16_bf16(b0, qr[8 + d0], p0, 0, 0, 0);
    p1 = __builtin_amdgcn_mfma_f32_32x32x16_bf16(b1, qr[8 + d0], p1, 0, 0, 0); }
}
__device__ __forceinline__ int v_st(int k, int c) { const int kk = (k & ~0xC) | ((k & 4) << 1) | ((k & 8) >> 1); return ((kk >> 3) * 4 + (c >> 5)) * 512 + ((kk & 7) * 32 + (c & 31)) * 2; }
__device__ __forceinline__ int v_rd_base(int lane) { return ((lane & 3) << 3) | (((lane >> 2) & 3) << 6) | (((lane >> 4) & 1) << 5) | (((lane >> 5) & 1) << 8); }
constexpr int v_rd_off(int d0, int ks, int half) { return d0 * 512 + ks * 4096 + half * 2048; }
template <int D0> __device__ __forceinline__ void pv_one(f32x16& od, int vb, bf16x8 pa0, bf16x8 pa1, bf16x8 pa2, bf16x8 pa3) {
  const s16x4 l0 = tr_read<v_rd_off(D0, 0, 0)>(vb), h0 = tr_read<v_rd_off(D0, 0, 1)>(vb), l1 = tr_read<v_rd_off(D0, 1, 0)>(vb), h1 = tr_read<v_rd_off(D0, 1, 1)>(vb);
  const s16x4 l2 = tr_read<v_rd_off(D0, 2, 0)>(vb), h2 = tr_read<v_rd_off(D0, 2, 1)>(vb), l3 = tr_read<v_rd_off(D0, 3, 0)>(vb), h3 = tr_read<v_rd_off(D0, 3, 1)>(vb);
  asm volatile("s_waitcnt lgkmcnt(0)" ::: "memory"); SBAR();
  od = __builtin_amdgcn_mfma_f32_32x32x16_bf16(pa0, cat4(l0, h0), od, 0, 0, 0);
  od = __builtin_amdgcn_mfma_f32_32x32x16_bf16(pa1, cat4(l1, h1), od, 0, 0, 0);
  od = __builtin_amdgcn_mfma_f32_32x32x16_bf16(pa2, cat4(l2, h2), od, 0, 0, 0);
  od = __builtin_amdgcn_mfma_f32_32x32x16_bf16(pa3, cat4(l3, h3), od, 0, 0, 0);
}
__device__ __forceinline__ void pv_d0(f32x16* o, int vb, bf16x8 pa0, bf16x8 pa1, bf16x8 pa2, bf16x8 pa3) {
  pv_one<0>(o[0], vb, pa0, pa1, pa2, pa3); pv_one<1>(o[1], vb, pa0, pa1, pa2, pa3); pv_one<2>(o[2], vb, pa0, pa1, pa2, pa3); pv_one<3>(o[3], vb, pa0, pa1, pa2, pa3);
}
__device__ __forceinline__ void attn_body(const bf16* __restrict__ Qb, const bf16* __restrict__ Kn, const bf16* __restrict__ Kr, const bf16* __restrict__ Vh,
                                          bf16* __restrict__ Ob, int seq, LAS unsigned char* lds, int tid_in) {
  int tid_ = tid_in; asm volatile("" : "+v"(tid_));
  const int tid = tid_, wid = tid >> 6, lane = tid & 63, r32 = lane & 31, hi = lane >> 5;
  LAS unsigned char* V_lds = lds + L_V; LAS unsigned char* K_lds = lds + L_K; LAS unsigned char* R_lds = lds + L_R;
  LAS float* wsf = (LAS float*)(lds + L_WS) + wid * 64; LAS float* li_l = wsf; LAS float* al_l = wsf + 32;
  float m_reg = -1e30f, l_reg = 0; f32x16 o[4] = {}; bf16x8 qr[12];
  const bf16* Qw = Qb + (size_t)(wid * QBLK + r32) * LDQ + hi * 8;
#pragma unroll
  for (int d0 = 0; d0 < 12; ++d0) qr[d0] = *(const bf16x8*)(Qw + d0 * 16);
  const int sr = tid >> 4, sc = (tid & 15) * 8, vst0 = v_st(sr, sc), vst1 = v_st(32 + sr, sc);
  const int rr = tid >> 3, rc = (tid & 7) * 8;
  const int vb0 = (int)(uintptr_t)V_lds + v_rd_base(lane);
  bf16x8 vs0, vs1, ks0, ks1, rs0;
#define SLOAD(k0) do { vs0 = *(const bf16x8*)(Vh + (size_t)((k0) + sr) * LDV + sc); vs1 = *(const bf16x8*)(Vh + (size_t)((k0) + 32 + sr) * LDV + sc); \
    ks0 = *(const bf16x8*)(Kn + (size_t)((k0) + sr) * LDKN + sc); ks1 = *(const bf16x8*)(Kn + (size_t)((k0) + 32 + sr) * LDKN + sc); \
    rs0 = *(const bf16x8*)(Kr + (size_t)((k0) + rr) * LDKR + rc); } while (0)
#define SWRITE(b) do { *(LAS bf16x8*)(V_lds + (b) * SHM_V + vst0) = vs0; *(LAS bf16x8*)(V_lds + (b) * SHM_V + vst1) = vs1; const int kc = sc * 2; \
    *(LAS bf16x8*)(K_lds + (b) * SHM_K + KSWZ(sr, kc)) = ks0; *(LAS bf16x8*)(K_lds + (b) * SHM_K + KSWZ(32 + sr, kc)) = ks1; \
    *(LAS bf16x8*)(R_lds + (b) * SHM_R + RSWZ(rr, rc * 2)) = rs0; } while (0)
#define RESC(a) do { if (__any((a) < 1.f)) { if (hi == 0) al_l[r32] = (a); asm volatile("s_waitcnt lgkmcnt(0)" ::: "memory"); \
    _Pragma("unroll") for (int d = 0; d < 4; ++d) _Pragma("unroll") for (int r = 0; r < 16; ++r) o[d][r] *= al_l[crow(r, hi)]; } } while (0)
  f32x16 pA0, pA1, pB0, pB1; float mnA, mnB, alA, alB; bf16x8 pa0, pa1, pa2, pa3; const int NT = seq / KVBLK;
  SLOAD(0); VM_WAIT(); SWRITE(0); __syncthreads();
  qkt(pA0, pA1, K_lds, R_lds, qr, r32, hi); partialSM(pA0, pA1, m_reg, mnA, alA);
  SLOAD(KVBLK);
  VM_WAIT(); SWRITE(1); __syncthreads();
  for (int j = 1; j + 1 < NT; j += 2) {
    SBAR(); qkt(pB0, pB1, K_lds + SHM_K, R_lds + SHM_R, qr, r32, hi);
    finishSM(pA0, pA1, alA, l_reg, pa0, pa1, pa2, pa3); SBAR();
    SLOAD((j + 1) * KVBLK); SBAR();
    pv_d0(o, vb0, pa0, pa1, pa2, pa3); partialSM(pB0, pB1, m_reg, mnB, alB);
    __syncthreads(); VM_WAIT(); SWRITE(0);
    RESC(alB); __syncthreads();
    SBAR(); qkt(pA0, pA1, K_lds, R_lds, qr, r32, hi);
    finishSM(pB0, pB1, alB, l_reg, pa0, pa1, pa2, pa3); SBAR();
    SLOAD((j + 2) * KVBLK); SBAR();
    pv_d0(o, vb0 + SHM_V, pa0, pa1, pa2, pa3); partialSM(pA0, pA1, m_reg, mnA, alA);
    __syncthreads(); VM_WAIT(); SWRITE(1);
    RESC(alA); __syncthreads();
  }
  SBAR(); qkt(pB0, pB1, K_lds + SHM_K, R_lds + SHM_R, qr, r32, hi);
  finishSM(pA0, pA1, alA, l_reg, pa0, pa1, pa2, pa3); SBAR();
  pv_d0(o, vb0, pa0, pa1, pa2, pa3); partialSM(pB0, pB1, m_reg, mnB, alB);
  __syncthreads(); RESC(alB);
  finishSM(pB0, pB1, alB, l_reg, pa0, pa1, pa2, pa3); SBAR();
  pv_d0(o, vb0 + SHM_V, pa0, pa1, pa2, pa3);
  if (hi == 0) li_l[r32] = l_reg; asm volatile("s_waitcnt lgkmcnt(0)" ::: "memory");
  float rli[16];
#pragma unroll
  for (int r = 0; r < 16; ++r) rli[r] = __builtin_amdgcn_rcpf(li_l[crow(r, hi)]);
  bf16* Ow = Ob + (size_t)(wid * QBLK) * LDO;
#pragma unroll
  for (int r = 0; r < 16; ++r) { const int orow = crow(r, hi);
#pragma unroll
    for (int d0 = 0; d0 < 4; ++d0) Ow[(size_t)orow * LDO + d0 * 32 + r32] = (bf16)(cvt_pk_bf16(o[d0][r] * rli[r], 0.f) & 0xffffu); }
  __syncthreads();
#undef SLOAD
#undef SWRITE
#undef RESC
}
}

__device__ __forceinline__ void phase_attn(const Args& a, bool withctx, LAS unsigned char* lds, int tid, int vcu, int G) {
    const bf16* QB = (const bf16*)(a.ws + WS_QB); const bf16* KN = (const bf16*)(a.ws + WS_KN); const bf16* KR = (const bf16*)(a.ws + WS_KR); const bf16* VB = (const bf16*)(a.ws + WS_VB);
    bf16* AO = (bf16*)(a.ws + WS_AO);
    const int nunits = 1024 + (withctx ? 64 : 0);
    for (int u = vcu; u < nunits; u += G) {
        int b, h, qrow0, krow0, seq;
        if (u < 1024) { const int bh = u >> 4, qb = u & 15; b = bh >> 4; h = bh & 15; qrow0 = b * TPB + qb * 256; krow0 = b * TPB; seq = TPB; }
        else { const int v = u - 1024; b = v >> 4; h = v & 15; qrow0 = b * TPB + SEQ; krow0 = b * TPB + SEQ; seq = CTXL; }
        att::attn_body(QB + (size_t)qrow0 * 3072 + h * 192, KN + (size_t)krow0 * 2048 + h * 128, KR + (size_t)krow0 * 64, VB + (size_t)krow0 * 2048 + h * 128,
                       AO + (size_t)qrow0 * 2048 + h * 128, seq, lds, tid);
    }
}

constexpr int PH_PER_LAYER = 10, PH_TOTAL = 2 + DEPTH * PH_PER_LAYER;
#ifndef MK_LAUNCH_PER_PHASE
#define MK_LAUNCH_PER_PHASE 0
#endif

__global__ void __launch_bounds__(NWAVES * 64, 2) fwd(Args a) {
    extern __shared__ __attribute__((aligned(16))) unsigned char lds_raw[];
    LAS unsigned char* lds = (LAS unsigned char*)lds_raw;
    const int tid = threadIdx.x, lane = tid & 63, wave = __builtin_amdgcn_readfirstlane(tid >> 6);
    const int G = gridDim.x; const int bx = blockIdx.x; const int vcu = (G % 8 == 0) ? (bx % 8) * (G / 8) + bx / 8 : bx;
    volatile LAS unsigned* MISC = (volatile LAS unsigned*)(lds + MISC_OFF);
    for (int u = tid; u < (LDS_BYTES - LDSCTL_OFF) / 4; u += NWAVES * 64) ((LAS unsigned*)(lds + LDSCTL_OFF))[u] = 0u;
    __syncthreads();
    const int lo = a.ph_lo, hi = a.ph_hi; const bool use_bar = (hi - lo) > 1;
    XcdBarrier bar; bar.bar = (unsigned*)(a.ws + WS_CTL) + CW_BAR; bar.x = 0; bar.st = MISC + 8;
    if (use_bar) bar = xcd_barrier_post((unsigned*)(a.ws + WS_CTL) + CW_BAR, MISC + 8);
#ifndef DBLMASK
#define DBLMASK 0u
#endif
#define REP(k) (((DBLMASK >> (k)) & 1) ? 2 : 1)
#ifndef PHMASK
#define PHMASK 0xFFFFFFFFu
#endif
#define IN(k) (lo <= (k) && (k) < hi)
#define SEAM(k) do { if ((k) + 1 < hi) xcd_barrier(bar, wave); } while (0)
#define U ((const bf16*)(ws + WS_U))
#define Y ((bf16*)(ws + WS_Y))
#define FRESH_TID() int lane_l; asm volatile("v_mbcnt_lo_u32_b32 %0, -1, 0\n\tv_mbcnt_hi_u32_b32 %0, -1, %0" : "=v"(lane_l));     const int wave_l = wave, tid_l = (wave << 6) | lane_l; (void)tid_l; (void)wave_l; size_t wz_ = 0; asm volatile("" : "+s"(wz_)); Args al = a; al.ws = a.ws + wz_; unsigned char* ws = al.ws; (void)ws;     int bxl = bx, vcul = vcu; asm volatile("" : "+s"(bxl), "+s"(vcul)); (void)bxl; (void)vcul

#define TAIL(cur_, fi_, cnt_) do { if (G == 256 && bxl >= (fi_)) convert_deferred(al, (LAS float*)(lds + wave_l * 16384), lane_l, (cur_) + (bxl - (fi_)) * NWAVES + wave_l, (G - (fi_)) * NWAVES, (cnt_)); } while (0)
    constexpr int TS_QKV = 0, TS_GATE = TS_QKV + 128 * 8 * 8, TS_WIN0 = TS_GATE + 128 * 8 * 8, TS_WOUT0 = TS_WIN0 + 80 * 8 * 12, TS_DQKV = TS_WOUT0 + 128 * 8 * 8, TS_WIN1 = TS_DQKV + 172 * 8 * 12, TS_WOUT1 = TS_WIN1 + 80 * 8 * 12, TS_END = TS_WOUT1 + 128 * 8 * 8;

    if (((PHMASK >> 0) & 1) && IN(0)) { for (int rep = 0; rep < REP(0); ++rep) { FRESH_TID(); phase_pro_a(al, lds, tid_l, lane_l, wave_l, vcul, G); __syncthreads(); } SEAM(0); }
    if (((PHMASK >> 1) & 1) && IN(1)) { FRESH_TID(); phase_pro_b(al, lane_l, wave_l, vcul, G); SEAM(1); }

    for (int layer = 0; layer < DEPTH; ++layer) {
        const int pb = 2 + layer * PH_PER_LAYER; const int j = layer >> 1; const bool last = (layer == DEPTH - 1);
        if ((layer & 1) == 0) {
            if (((PHMASK >> 2) & 1) && IN(pb + 0)) { FRESH_TID();
                pg8::Gemm g{U, (const bf16*)(ws + WS_WQKV) + (size_t)j * 8192 * 2048, M, 8192, 2048}; pg8::TileOrder S; S.init(NTM, 32, G, bxl, 0, 0, 32);
                EpiQKV E{(bf16*)(ws + WS_RQ), (bf16*)(ws + WS_RK), (bf16*)(ws + WS_RV), (const float*)(ws + WS_RCS)};
                for (int rep = 0; rep < REP(2); ++rep) { pg8::gemm_phase<EpiQKV, pg8::TileOrder, true, true>(lds, g, S, E, tid_l); __syncthreads(); } if (layer == 0) TAIL(TS_QKV, 128, 8); SEAM(pb + 0); }
            if (((PHMASK >> 3) & 1) && IN(pb + 1)) { for (int rep = 0; rep < REP(3); ++rep) { FRESH_TID(); phase_ret_scan(al, j, lds, tid_l, lane_l, wave_l, vcul, G); __syncthreads(); } SEAM(pb + 1); }
            if (((PHMASK >> 4) & 1) && IN(pb + 2)) { FRESH_TID();
                pg8::Gemm g{U, (const bf16*)(ws + WS_WG) + (size_t)j * 8192 * 2048, M, 8192, 2048}; pg8::TileOrder S; S.init(NTM, 32, G, bxl, 0, 0, 32);
                EpiGate E{(const bf16*)(ws + WS_OF), (const bf16*)(ws + WS_OB), (const float*)(ws + WS_PART), (bf16*)(ws + WS_YG)};
                for (int rep = 0; rep < REP(4); ++rep) { pg8::gemm_phase<EpiGate, pg8::TileOrder, true, true>(lds, g, S, E, tid_l); __syncthreads(); } if (layer == 0) TAIL(TS_GATE, 128, 8); SEAM(pb + 2); }
            if (((PHMASK >> 5) & 1) && IN(pb + 3)) { FRESH_TID();
                pg8::Gemm g{(const bf16*)(ws + WS_YG), (const bf16*)(ws + WS_WOR) + (size_t)j * 2048 * 4096, M, 2048, 4096}; pg8::TileOrder S; S.init(NTL, 8, G, bxl, 1, KSPLIT, 64);
                EpiBf E{Y, Y, 2048, 0, (float*)(ws + WS_YP)};
                for (int rep = 0; rep < REP(5); ++rep) { pg8::gemm_phase<EpiBf, pg8::TileOrder, true, true>(lds, g, S, E, tid_l); __syncthreads(); } SEAM(pb + 3); }
        } else {
            if (((PHMASK >> 6) & 1) && IN(pb + 0)) { FRESH_TID();
                pg8::Gemm g{U, (const bf16*)(ws + WS_WD) + (size_t)j * 1280 * 2048, M, 1280, 2048}; pg8::TileOrder S; S.init(NTM, 5, G, bxl, 0, 0, 32);
                EpiDQKV E{(bf16*)(ws + WS_CQN), (bf16*)(ws + WS_CKVN), (bf16*)(ws + WS_KR), (float*)(ws + WS_SSQ), (const float*)(ws + WS_ACS)};
                for (int rep = 0; rep < REP(6); ++rep) { pg8::gemm_phase<EpiDQKV, pg8::TileOrder, true, true>(lds, g, S, E, tid_l); __syncthreads(); } if (layer == 1) TAIL(TS_DQKV, 84, 12); SEAM(pb + 0); }
            if (((PHMASK >> 8) & 1) && IN(pb + 2)) { FRESH_TID();
                { pg8::Gemm g{(const bf16*)(ws + WS_CQN), (const bf16*)(ws + WS_WUQ) + (size_t)j * 3072 * 512, M, 3072, 512}; pg8::TileOrder S; S.init(last ? NTL : NTM, 12, G, bxl, last ? 1 : 0, 0, 8);
                  EpiUQ E{(bf16*)(ws + WS_QB), (const float*)(ws + WS_ACS), (const float*)(ws + WS_SSQ)};
                  for (int rep = 0; rep < REP(8); ++rep) { pg8::gemm_phase<EpiUQ, pg8::TileOrder, true, true>(lds, g, S, E, tid_l); __syncthreads(); } }
                __syncthreads();
                { pg8::Gemm g{(const bf16*)(ws + WS_CKVN), (const bf16*)(ws + WS_WUKV) + (size_t)j * 4096 * 512, M, 4096, 512}; pg8::TileOrder S; S.init(NTM, 16, G, bxl, 0, 0, 8);
                  EpiUKV E{(bf16*)(ws + WS_KN), (bf16*)(ws + WS_VB), (const float*)(ws + WS_SSQ)};
                  for (int rep = 0; rep < REP(8); ++rep) { pg8::gemm_phase<EpiUKV, pg8::TileOrder, true, true>(lds, g, S, E, tid_l); __syncthreads(); } }
                SEAM(pb + 2); }
            if (((PHMASK >> 9) & 1) && IN(pb + 3)) { FRESH_TID(); for (int rep = 0; rep < REP(9); ++rep) phase_attn(al, !last, lds, tid_l, vcul, G); SEAM(pb + 3); }
            if (((PHMASK >> 10) & 1) && IN(pb + 4)) { FRESH_TID();
                pg8::Gemm g{(const bf16*)(ws + WS_AO), (const bf16*)(ws + WS_WOM) + (size_t)j * 2048 * 2048, M, 2048, 2048}; pg8::TileOrder S; S.init(NTL, 8, G, bxl, 1, last ? 0 : KSPLIT, 32);
                EpiBf E{Y, Y, 2048, 0, (float*)(ws + WS_YP)};
                for (int rep = 0; rep < REP(10); ++rep) { pg8::gemm_phase<EpiBf, pg8::TileOrder, true, true>(lds, g, S, E, tid_l); __syncthreads(); } SEAM(pb + 4); }
        }
        if (((PHMASK >> 11) & 1) && IN(pb + 5)) { if (REP(11) > 1) { FRESH_TID(); phase_ln(al, layer, 0, lds, tid_l, lane_l, wave_l, vcul, G, true); } FRESH_TID(); phase_ln(al, layer, 0, lds, tid_l, lane_l, wave_l, vcul, G); SEAM(pb + 5); }
        if (((PHMASK >> 12) & 1) && IN(pb + 6)) { FRESH_TID();
            pg8::Gemm g{U, (const bf16*)(ws + WS_WIN) + (size_t)layer * 11264 * 2048, M, 11264, 2048}; pg8::TileOrder S; S.init(last ? NTL : NTM, 44, G, bxl, last ? 1 : 0, 0, 32);
            EpiSwiglu E{(bf16*)(ws + WS_HID)};
#if defined(SPLIT_WIN_PROBE)
            { pg8::TileOrder S1 = S; S1.ilim = 6; pg8::gemm_phase<EpiSwiglu, pg8::TileOrder, true, true>(lds, g, S1, E, tid_l); __syncthreads(); xcd_barrier(bar, wave);
              pg8::TileOrder S2 = S; S2.ioff = 6; pg8::gemm_phase<EpiSwiglu, pg8::TileOrder, true, true>(lds, g, S2, E, tid_l); __syncthreads(); } SEAM(pb + 6); }
#else
            for (int rep = 0; rep < REP(12); ++rep) { pg8::gemm_phase<EpiSwiglu, pg8::TileOrder, true, true>(lds, g, S, E, tid_l); __syncthreads(); } if (layer < 2) TAIL(layer == 0 ? TS_WIN0 : TS_WIN1, 176, 12); SEAM(pb + 6); }
#endif
        if (((PHMASK >> 13) & 1) && IN(pb + 7)) { FRESH_TID();
            pg8::Gemm g{(const bf16*)(ws + WS_HID), (const bf16*)(ws + WS_WOUT) + (size_t)layer * 2048 * 5632, M, 2048, 5632}; pg8::TileOrder S; S.init(NTL, 8, G, bxl, 1, last ? 0 : KSPLIT, 88);
            EpiBf E{Y, Y, 2048, 0, (float*)(ws + WS_YP)};
            for (int rep = 0; rep < REP(13); ++rep) { pg8::gemm_phase<EpiBf, pg8::TileOrder, true, true>(lds, g, S, E, tid_l); __syncthreads(); } if (layer < 2) TAIL(layer == 0 ? TS_WOUT0 : TS_WOUT1, 128, 8); SEAM(pb + 7); }
        if (((PHMASK >> 14) & 1) && IN(pb + 8) && layer == 1) { FRESH_TID();
            const int c0 = (G == 256) ? TS_END : 0; if (c0 < N_DEF_ITEMS) { const int NGW = G * NWAVES; convert_deferred(al, (LAS float*)(lds + wave_l * 16384), lane_l, c0 + vcul * NWAVES + wave_l, NGW, ((N_DEF_ITEMS - c0 + NGW - 1) / NGW + 3) & ~3); } __syncthreads(); }
        if (((PHMASK >> 14) & 1) && IN(pb + 8)) { if (REP(11) > 1) { FRESH_TID(); phase_ln(al, layer, 1, lds, tid_l, lane_l, wave_l, vcul, G, true); } FRESH_TID(); phase_ln(al, layer, 1, lds, tid_l, lane_l, wave_l, vcul, G); SEAM(pb + 8); }
    }
#undef IN
#undef SEAM
#undef U
#undef Y
}

extern "C" void kernel_launch(void* const* d_in, const int* in_sizes, int n_in, void* d_out, int out_size, void* d_ws, size_t ws_size, hipStream_t stream) {
    static int grid = 0;
    if (grid == 0) {
        if (n_in != 21 || ws_size < WS_END) { fprintf(stderr, "kernel_launch: need 21 inputs and %zu bytes of workspace; got %d, %zu\n", (size_t)WS_END, n_in, ws_size); grid = -1; return; }
        int dev = 0, cus = 0, per_cu = 0;
        if (hipGetDevice(&dev) != hipSuccess || hipDeviceGetAttribute(&cus, hipDeviceAttributeMultiprocessorCount, dev) != hipSuccess) { grid = -1; return; }
        if (hipFuncSetAttribute((const void*)fwd, hipFuncAttributeMaxDynamicSharedMemorySize, LDS_BYTES) != hipSuccess) { fprintf(stderr, "kernel_launch: hipFuncSetAttribute failed\n"); grid = -1; return; }
        if (hipOccupancyMaxActiveBlocksPerMultiprocessor(&per_cu, (const void*)fwd, NWAVES * 64, LDS_BYTES) != hipSuccess || per_cu < 1)
            fprintf(stderr, "kernel_launch: occupancy query reports %d workgroups per CU\n", per_cu);
        (void)hipGetLastError();
        grid = cus;
    }
    if (grid < 0) return;
    if (hipMemsetAsync((char*)d_ws + WS_CTL, 0, CTL_ZERO_BYTES, stream) != hipSuccess) return;
    Args a{};
    for (int i = 0; i < 21; ++i) a.in[i] = (const float*)d_in[i];
    a.out = (float*)d_out; a.ws = (unsigned char*)d_ws;
#if MK_LAUNCH_PER_PHASE
    for (int p = 0; p < PH_TOTAL; ++p) {
        const int pl = (p - 2) % PH_PER_LAYER, layer = (p - 2) / PH_PER_LAYER;
        if (p >= 2 && (pl == 9 || (pl == 4 && (layer & 1) == 0))) continue;
        a.ph_lo = p; a.ph_hi = p + 1;
        hipLaunchKernelGGL(fwd, dim3(grid), dim3(NWAVES * 64), LDS_BYTES, stream, a);
    }
#else
    a.ph_lo = 0; a.ph_hi = PH_TOTAL;
    hipLaunchKernelGGL(fwd, dim3(grid), dim3(NWAVES * 64), LDS_BYTES, stream, a);
#endif
    const hipError_t le = hipPeekAtLastError();
    if (le != hipSuccess) fprintf(stderr, "kernel_launch: launch failed: %s\n", hipGetErrorName(le));
}
```

```cpp
#include <hip/hip_runtime.h>
#include <cstdio>
#include <cstdint>
#define MK_LAUNCH_PER_PHASE 0
namespace pg8 {
#define PG8_LAS __attribute__((address_space(3)))
typedef unsigned short bf16_t;
typedef short bf16x8 __attribute__((ext_vector_type(8)));
typedef float f32x4 __attribute__((ext_vector_type(4)));
typedef unsigned u32x4 __attribute__((ext_vector_type(4)));
constexpr int BM = 256, BK = 64, HALF = 128, HTB = HALF * BK * 2  , STAGE_BYTES = 8 * HTB, NXCD = 8, WGM = 8;

__host__ __device__ __forceinline__ int lds_byte(int r, int c) { const int st = (r >> 4) * 2 + (c >> 5), rr = r & 15, cc = c & 31, ob = rr * 64 + cc * 2; return st * 1024 + (ob ^ (((ob >> 9) & 1) << 5)); }
__host__ __device__ __forceinline__ void stage_rc(int b, int& R, int& C) { const int st = b / 1024, sb = b % 1024, swz = sb ^ (((sb >> 9) & 1) << 5); R = (st >> 1) * 16 + swz / 64; C = (st & 1) * 32 + (swz % 64) / 2; }
__host__ __device__ __forceinline__ int perm32(int rho) { const int n = rho >> 4, i = rho & 15; return 8 * (i >> 2) + 4 * n + (i & 3); }

struct Unit { int pm, pn, k0, nt, ks; };
struct Gemm { const bf16_t* A; const bf16_t* Bt; int M, N, K; };

struct StaticOrder {
    int nM, nN, nwg, G, c;
    __host__ __device__ void init(int M, int N, int G_, int c_) { nM = M / BM; nN = N / BM; nwg = nM * nN; G = G_; c = c_; }
    __host__ __device__ bool next(int i, Unit& u) const {
        const long L = (long)i * G + c; if (L >= nwg) return false;
        int wgid = (int)L; { const int q = nwg / NXCD, r = nwg % NXCD, xcd = wgid % NXCD, off = wgid / NXCD; wgid = (xcd < r ? xcd * (q + 1) : r * (q + 1) + (xcd - r) * q) + off; }
        const int nig = WGM * nN, gid = wgid / nig, fm = gid * WGM, gsz = (nM - fm) < WGM ? (nM - fm) : WGM;
        u.pm = fm + ((wgid % nig) % gsz); u.pn = (wgid % nig) / gsz; return true;
    }
    __device__ __forceinline__ void a_ready(const Unit&) const {}
    __device__ __forceinline__ void done(const Unit&) const {}
};

__device__ __forceinline__ unsigned cvt_pk_bf16(float lo, float hi) { unsigned r; asm volatile("v_cvt_pk_bf16_f32 %0, %1, %2" : "=v"(r) : "v"(lo), "v"(hi)); return r; }
struct TileOrder {
    int nM, nN, nmain, nwg, G, c, lat, split, kt, ioff = 0, ilim = 1 << 30;
    __host__ __device__ void init(int nM_, int nN_, int G_, int c_, int lat_, int split_, int kt_) { nM = nM_; nN = nN_; nmain = nM * nN; G = G_; c = c_; lat = lat_; split = split_; kt = kt_; nwg = nmain + 4 * nN * split; }
    __host__ __device__ __forceinline__ bool next(int i, Unit& u) const {
        if (i + ioff >= ilim) return false;
        const long L = (long)(i + ioff) * G + c; if (L >= nwg) return false;
        const bool sp = L >= nmain;
        const int e = (int)L - nmain, sdiv = split > 0 ? split : 1, tile = e / sdiv, sl = e - tile * sdiv, snt = kt / sdiv;
        int wgid = sp ? 0 : (int)L; { const int q = nmain / NXCD, r = nmain % NXCD, xcd = wgid % NXCD, off = wgid / NXCD; wgid = (xcd < r ? xcd * (q + 1) : r * (q + 1) + (xcd - r) * q) + off; }
        const int nig = WGM * nN, gid = wgid / nig, fm = gid * WGM, gsz = (nM - fm) < WGM ? (nM - fm) : WGM;
        int pm = fm + ((wgid % nig) % gsz); const int pn = (wgid % nig) / gsz; if (lat) pm += pm >> 4;
        Unit r; r.pm = sp ? 17 * (tile & 3) + 16 : pm; r.pn = sp ? (tile >> 2) : pn; r.k0 = sp ? sl * snt : 0; r.nt = sp ? snt : kt; r.ks = sp ? sl : -1;
        u = r; return true;
    }
    __device__ __forceinline__ void a_ready(const Unit&) const {}
    __device__ __forceinline__ void done(const Unit&) const {}
};
template <class Epi, class Sched, bool ALIGN_EPI = false, bool SP2 = false>
__device__ __forceinline__ void gemm_phase(PG8_LAS unsigned char* lds, const Gemm g, const Sched& S, const Epi& E, int tid_in) {
    int tid_ = tid_in; asm volatile("" : "+v"(tid_));
    const int tid = tid_, wid = __builtin_amdgcn_readfirstlane(tid >> 6), lane = tid & 63, wr = wid >> 2, wc = wid & 3, fr = lane & 15, fq = lane >> 4;
    const int K = g.K;
    unsigned voffA[2], voffB[2];
#pragma unroll
    for (int i = 0; i < 2; ++i) { int R, C; stage_rc(tid * 16 + i * 8192, R, C); const int Rb = Epi::PERM ? ((R & ~31) + perm32(R & 31)) : R;
        voffA[i] = (unsigned)(R * K + C) * 2u; voffB[i] = (unsigned)(Rb * K + C) * 2u; }
    const size_t kstep = (size_t)(BK * 2);
    const size_t hstep = (size_t)HALF * K * 2;
    const size_t tstep = 2 * hstep;
    const unsigned ldsw = (unsigned)wid * 1024u;
    const int aoff = lds_byte(wr * 64 + fr, fq * 8), boff = lds_byte(wc * 32 + fr, fq * 8);
#define PG8_SA(b, h) (((b) * 2 + (h)) * HTB)
#define PG8_SB(b, h) ((4 + (b) * 2 + (h)) * HTB)
#define PG8_STAGE(bufoff, gbase, voff) do { _Pragma("unroll") for (int _i = 0; _i < 2; ++_i) \
        __builtin_amdgcn_global_load_lds((const unsigned*)((const char*)(gbase) + (voff)[_i]), (PG8_LAS unsigned*)(lds + (bufoff) + ldsw + _i * 8192), 16, 0, 0); } while (0)
#define PG8_LDA(dst, b, h) do { _Pragma("unroll") for (int m = 0; m < 4; ++m) _Pragma("unroll") for (int k = 0; k < 2; ++k) dst[m][k] = *(const PG8_LAS bf16x8*)(lds + PG8_SA(b, h) + aoff + m * 2048 + k * 1024); } while (0)
#define PG8_LDB(dst, b, h) do { _Pragma("unroll") for (int n = 0; n < 2; ++n) _Pragma("unroll") for (int k = 0; k < 2; ++k) dst[n][k] = *(const PG8_LAS bf16x8*)(lds + PG8_SB(b, h) + boff + n * 2048 + k * 1024); } while (0)
#define PG8_MMA(ai, bj, At, Bt) do { __builtin_amdgcn_s_setprio(1); _Pragma("unroll") for (int m = 0; m < 4; ++m) _Pragma("unroll") for (int n = 0; n < 2; ++n) _Pragma("unroll") for (int k = 0; k < 2; ++k) \
        acc[ai][bj][m][n] = __builtin_amdgcn_mfma_f32_16x16x32_bf16(Bt[n][k], At[m][k], acc[ai][bj][m][n], 0, 0, 0); __builtin_amdgcn_s_setprio(0); } while (0)
#define PG8_WAIT_V(n) asm volatile("s_waitcnt vmcnt(" #n ")" ::: "memory")
#define PG8_WAIT_L(n) asm volatile("s_waitcnt lgkmcnt(" #n ")" ::: "memory")
#define PG8_BAR __builtin_amdgcn_s_barrier()
#define PG8_SCHED __builtin_amdgcn_sched_barrier(0)
    Unit cur, nxt; int ui = 0;
    if (!S.next(0, cur)) return;
    f32x4 acc[2][2][4][2];
#pragma unroll
    for (int a = 0; a < 2; ++a)
#pragma unroll
        for (int b = 0; b < 2; ++b)
#pragma unroll
            for (int m = 0; m < 4; ++m)
#pragma unroll
                for (int n = 0; n < 2; ++n) acc[a][b][m][n] = (f32x4){0.f, 0.f, 0.f, 0.f};
    bf16x8 At[4][2], B0[2][2], B1[2][2];
    const char* cA = (const char*)g.A + (size_t)cur.pm * tstep + (size_t)cur.k0 * kstep; const char* cB = (const char*)g.Bt + (size_t)cur.pn * tstep + (size_t)cur.k0 * kstep;
    S.a_ready(cur);
    if constexpr (SP2) {
        PG8_STAGE(PG8_SB(0, 0), cB, voffB); PG8_STAGE(PG8_SB(0, 1), cB + hstep, voffB); PG8_STAGE(PG8_SA(0, 0), cA, voffA); PG8_STAGE(PG8_SA(0, 1), cA + hstep, voffA);
        if (wr == 1) PG8_BAR;
        PG8_WAIT_V(2); PG8_BAR;
        PG8_STAGE(PG8_SB(1, 0), cB + kstep, voffB); PG8_STAGE(PG8_SA(1, 0), cA + kstep, voffA); PG8_STAGE(PG8_SB(1, 1), cB + hstep + kstep, voffB);
        PG8_WAIT_V(6); PG8_BAR;
    } else {
        PG8_STAGE(PG8_SB(0, 0), cB, voffB); PG8_STAGE(PG8_SA(0, 0), cA, voffA); PG8_STAGE(PG8_SB(0, 1), cB + hstep, voffB); PG8_STAGE(PG8_SA(0, 1), cA + hstep, voffA);
        if (wr == 1) PG8_BAR;
        PG8_WAIT_V(4); PG8_BAR;
        PG8_STAGE(PG8_SB(1, 0), cB + kstep, voffB); PG8_STAGE(PG8_SA(1, 0), cA + kstep, voffA); PG8_STAGE(PG8_SB(1, 1), cB + hstep + kstep, voffB);
        PG8_WAIT_V(6); PG8_BAR;
    }
    for (;;) {
        const bool has_next = S.next(ui + 1, nxt);
        const char* nA = has_next ? (const char*)g.A + (size_t)nxt.pm * tstep + (size_t)nxt.k0 * kstep : cA; const char* nB = has_next ? (const char*)g.Bt + (size_t)nxt.pn * tstep + (size_t)nxt.k0 * kstep : cB;
        const int nt = cur.nt;
        for (int t = 0; t < nt; t += 2) {
            const bool last = (t == nt - 2);
            const char* a1 = cA + (size_t)(t + 1) * kstep;
            const char* a2 = last ? nA : cA + (size_t)(t + 2) * kstep; const char* b2 = last ? nB : cB + (size_t)(t + 2) * kstep;
            const char* a3 = a2 + kstep; const char* b3 = b2 + kstep;
            if (last && has_next) S.a_ready(nxt);
            if constexpr (SP2) {
            PG8_LDB(B0, 0, 0); PG8_LDB(B1, 0, 1); PG8_SCHED; PG8_LDA(At, 0, 0); PG8_STAGE(PG8_SA(1, 1), a1 + hstep, voffA);
            PG8_WAIT_V(8); PG8_WAIT_L(0); PG8_BAR; PG8_MMA(0, 0, At, B0); PG8_MMA(0, 1, At, B1); PG8_BAR; PG8_SCHED;
            PG8_LDA(At, 0, 1); PG8_STAGE(PG8_SB(0, 0), b2, voffB); PG8_STAGE(PG8_SB(0, 1), b2 + hstep, voffB); PG8_STAGE(PG8_SA(0, 0), a2, voffA);
            PG8_WAIT_V(8); PG8_WAIT_L(0); PG8_BAR; PG8_MMA(1, 0, At, B0); PG8_MMA(1, 1, At, B1); PG8_BAR; PG8_SCHED;
            PG8_LDB(B0, 1, 0); PG8_LDB(B1, 1, 1); PG8_SCHED; PG8_LDA(At, 1, 0); PG8_STAGE(PG8_SA(0, 1), a2 + hstep, voffA);
            PG8_WAIT_V(8); PG8_WAIT_L(0); PG8_BAR; PG8_MMA(0, 0, At, B0); PG8_MMA(0, 1, At, B1); PG8_BAR; PG8_SCHED;
            PG8_LDA(At, 1, 1); PG8_STAGE(PG8_SB(1, 0), b3, voffB); PG8_STAGE(PG8_SB(1, 1), b3 + hstep, voffB); PG8_STAGE(PG8_SA(1, 0), a3, voffA);
            PG8_WAIT_V(8); PG8_WAIT_L(0); PG8_BAR; PG8_MMA(1, 0, At, B0); PG8_MMA(1, 1, At, B1); PG8_BAR; PG8_SCHED;
            } else {
            PG8_LDB(B0, 0, 0); PG8_SCHED; PG8_LDA(At, 0, 0); PG8_STAGE(PG8_SA(1, 1), a1 + hstep, voffA);
            PG8_WAIT_L(8); PG8_BAR; PG8_WAIT_L(0); PG8_MMA(0, 0, At, B0); PG8_BAR; PG8_SCHED;
            PG8_LDB(B1, 0, 1); PG8_STAGE(PG8_SB(0, 0), b2, voffB);
            PG8_BAR; PG8_WAIT_L(0); PG8_MMA(0, 1, At, B1); PG8_BAR;
            PG8_LDA(At, 0, 1); PG8_STAGE(PG8_SA(0, 0), a2, voffA);
            PG8_BAR; PG8_WAIT_L(0); PG8_MMA(1, 0, At, B0); PG8_BAR; PG8_SCHED;
            PG8_STAGE(PG8_SB(0, 1), b2 + hstep, voffB);
            PG8_WAIT_V(6); PG8_BAR; PG8_MMA(1, 1, At, B1); PG8_BAR;
            PG8_LDB(B0, 1, 0); PG8_SCHED; PG8_LDA(At, 1, 0); PG8_STAGE(PG8_SA(0, 1), a2 + hstep, voffA);
            PG8_WAIT_L(8); PG8_BAR; PG8_WAIT_L(0); PG8_MMA(0, 0, At, B0); PG8_BAR; PG8_SCHED;
            PG8_LDB(B1, 1, 1); PG8_STAGE(PG8_SB(1, 0), b3, voffB);
            PG8_BAR; PG8_WAIT_L(0); PG8_MMA(0, 1, At, B1); PG8_BAR;
            PG8_LDA(At, 1, 1); PG8_STAGE(PG8_SA(1, 0), a3, voffA);
            PG8_BAR; PG8_WAIT_L(0); PG8_MMA(1, 0, At, B0); PG8_BAR; PG8_SCHED;
            PG8_STAGE(PG8_SB(1, 1), b3 + hstep, voffB);
            PG8_WAIT_V(6); PG8_BAR; PG8_MMA(1, 1, At, B1); PG8_BAR;
            }
        }
        if constexpr (ALIGN_EPI) { if (wr == 0) PG8_BAR; }
        asm volatile("s_nop 15\n\ts_nop 15" ::: "memory");
        if constexpr (!Epi::AFTER_DRAIN) { E(acc, cur, wr, wc, fr, fq); S.done(cur); }
        if (!has_next) break;
#pragma unroll
        for (int a = 0; a < 2; ++a)
#pragma unroll
            for (int b = 0; b < 2; ++b)
#pragma unroll
                for (int m = 0; m < 4; ++m)
#pragma unroll
                    for (int n = 0; n < 2; ++n) acc[a][b][m][n] = (f32x4){0.f, 0.f, 0.f, 0.f};
        cur = nxt; cA = nA; cB = nB; ++ui;
        if constexpr (ALIGN_EPI) { if (wr == 1) PG8_BAR; }
    }
    PG8_WAIT_V(0);
    if constexpr (!ALIGN_EPI) { if (wr == 0) PG8_BAR; }
    PG8_BAR;
    if constexpr (Epi::AFTER_DRAIN) { E.fused(acc, cur, wr, wc, fr, fq, lds, wid, lane); S.done(cur); }
#undef PG8_SA
#undef PG8_SB
#undef PG8_STAGE
#undef PG8_LDA
#undef PG8_LDB
#undef PG8_MMA
#undef PG8_WAIT_V
#undef PG8_WAIT_L
#undef PG8_BAR
#undef PG8_SCHED
}
}

constexpr int D = 2048, BATCH = 4, SEQ = 4096, CTXL = 256, DEPTH = 4, FF = 5632;
constexpr int TPB = SEQ + CTXL;
constexpr int M = BATCH * TPB;
constexpr int NTM = M / 256;
constexpr int NTL = BATCH * SEQ / 256;
constexpr float ALPHA = 1.6817928305074290f;
constexpr float LN_EPS = 1e-5f, GN_EPS = 1e-6f, RMS_EPS = 1e-6f;
constexpr float MLA_SCALE = 0.07216878364870322f;
constexpr int NWAVES = 8;

constexpr size_t MiB = 1u << 20;
constexpr size_t WS_CTL = 0, CTL_ZERO_BYTES = 64 * 1024;
constexpr size_t WS_MOD = 1 * MiB;
constexpr size_t WS_RCS = 2 * MiB;
constexpr size_t WS_ACS = 6 * MiB;
constexpr size_t WS_WQKV = 8 * MiB;
constexpr size_t WS_WG = 72 * MiB;
constexpr size_t WS_WOR = 136 * MiB;
constexpr size_t WS_WD = 168 * MiB;
constexpr size_t WS_WUQ = 178 * MiB;
constexpr size_t WS_WUKV = 184 * MiB;
constexpr size_t WS_WOM = 192 * MiB;
constexpr size_t WS_WIN = 208 * MiB;
constexpr size_t WS_WOUT = 384 * MiB;
constexpr size_t WS_H = 472 * MiB;
constexpr size_t WS_U = 608 * MiB;
constexpr size_t WS_Y = 676 * MiB;
constexpr size_t WS_S = 744 * MiB;
constexpr size_t WS_RQ = WS_S, WS_RK = WS_S + 68 * MiB, WS_RV = WS_S + 136 * MiB, WS_OF = WS_S + 272 * MiB, WS_OB = WS_S + 408 * MiB, WS_PART = WS_S + 544 * MiB;
constexpr size_t WS_YG = WS_S;
constexpr size_t WS_SSQ = WS_S  , WS_CQKV = WS_S, WS_CQN = WS_S + 85 * MiB, WS_CKVN = WS_S + 102 * MiB, WS_KR = WS_S + 119 * MiB, WS_QB = WS_S + 122 * MiB,
                 WS_KN = WS_S + 224 * MiB, WS_VB = WS_S + 292 * MiB, WS_AO = WS_S + 360 * MiB;
constexpr size_t WS_HID = WS_S;
constexpr size_t WS_YP = 1297 * MiB;
constexpr size_t WS_END = 1329 * MiB;
constexpr int KSPLIT = 4;

constexpr int CW_BAR = 4096;

constexpr int RING_BYTES = 131072;
constexpr int LDSCTL_OFF = RING_BYTES, MISC_OFF = LDSCTL_OFF + 320;
constexpr int LDS_BYTES = 147456;

#define GAS __attribute__((address_space(1)))
#define LAS __attribute__((address_space(3)))
typedef unsigned short bf16;
typedef unsigned v4u __attribute__((ext_vector_type(4)));
typedef unsigned v2u __attribute__((ext_vector_type(2)));
typedef float f32x4 __attribute__((ext_vector_type(4)));
typedef float f32x2 __attribute__((ext_vector_type(2)));
typedef float f32x16 __attribute__((ext_vector_type(16)));
typedef short bf16x8 __attribute__((ext_vector_type(8)));
typedef short s16x4 __attribute__((ext_vector_type(4)));
typedef _Float16 h16;
typedef _Float16 h16x4 __attribute__((ext_vector_type(4)));
#define LDS_WAIT() asm volatile("s_waitcnt lgkmcnt(0)" ::: "memory")
#define VM_WAIT() asm volatile("s_waitcnt vmcnt(0)" ::: "memory")
#define SBAR() __builtin_amdgcn_sched_barrier(0)
using pg8::cvt_pk_bf16;
__device__ __forceinline__ float bf2f(unsigned short b) { return __uint_as_float(((unsigned)b) << 16); }
__device__ __forceinline__ float bflo(unsigned w) { return __uint_as_float(w << 16); }
__device__ __forceinline__ float bfhi(unsigned w) { return __uint_as_float(w & 0xffff0000u); }
__device__ __forceinline__ float silu_f(float x) { return x * __builtin_amdgcn_rcpf(1.0f + __expf(-x)); }

#define XB_TMO      128
#define XB_XCNT(j)  (256  + 64 * (j))
#define XB_XSUB(j)  (1280 + 64 * (j))
#define XB_XGEN(j)  (2304 + 64 * (j))
#define XB_TOP      3328
#define XB_TOPGEN   3392
#define XCD_BAR_WORDS 3456
#define XB_SPIN_CAP (1u << 20)

__device__ __forceinline__ unsigned xb_ld(unsigned* p)              { return __hip_atomic_load(p, __ATOMIC_RELAXED, __HIP_MEMORY_SCOPE_AGENT); }
__device__ __forceinline__ unsigned xb_add(unsigned* p, unsigned v) { return __hip_atomic_fetch_add(p, v, __ATOMIC_RELAXED, __HIP_MEMORY_SCOPE_AGENT); }
__device__ __forceinline__ unsigned xb_xcc_id() { return (unsigned)__builtin_amdgcn_s_getreg((3 << 11) | 20) & 0xFu; }
#define XB_SPIN(cond, bar) do { unsigned _sp = 0; while (cond) { __builtin_amdgcn_s_sleep(1); \
    if ((++_sp & 255u) == 0u) { if (xb_ld(&(bar)[XB_TMO])) break; if (_sp > XB_SPIN_CAP) { atomicAdd(&(bar)[XB_TMO], 1u); break; } } } } while (0)

struct XcdBarrier { unsigned* bar; unsigned x; volatile LAS unsigned* st; };
__device__ __forceinline__ XcdBarrier xcd_barrier_post(unsigned* bar, volatile LAS unsigned* st) {
    XcdBarrier b; b.bar = bar; b.x = xb_xcc_id(); b.st = st;
    if (threadIdx.x == 0) (void)xb_add(&bar[XB_XCNT(b.x)], 1u);
    return b;
}
__device__ __forceinline__ void xcd_barrier_complete(unsigned* bar, unsigned x, unsigned& nloc, unsigned& nx) {
    const unsigned G = gridDim.x * gridDim.y * gridDim.z;
    unsigned sum, cnt, mine, sp = 0u;
    for (;;) {
        sum = 0u; cnt = 0u; mine = 0u;
#pragma unroll
        for (unsigned j = 0; j < 16; ++j) { const unsigned c = xb_ld(&bar[XB_XCNT(j)]); sum += c; cnt += (c > 0u) ? 1u : 0u; mine = (j == x) ? c : mine; }
        if (sum == G) break;
        __builtin_amdgcn_s_sleep(1);
        if ((++sp & 255u) == 0u) { if (xb_ld(&bar[XB_TMO])) break; if (sp > XB_SPIN_CAP) { atomicAdd(&bar[XB_TMO], 1u); break; } }
    }
    nloc = mine > 0u ? mine : 1u; nx = cnt > 0u ? cnt : 1u;
}
__device__ __forceinline__ void xcd_barrier(const XcdBarrier& b, int wave) {
    asm volatile("s_waitcnt vmcnt(0)" ::: "memory");
    __syncthreads();
    int l_; asm volatile("v_mbcnt_lo_u32_b32 %0, -1, 0\n\tv_mbcnt_hi_u32_b32 %0, -1, %0" : "=v"(l_));
    if (l_ == 0 && wave == 0) {
        unsigned* bar = b.bar;
        __builtin_amdgcn_s_waitcnt(0);
        unsigned nloc = b.st[0], nx = b.st[1];
        if (nloc == 0u) { xcd_barrier_complete(bar, b.x, nloc, nx); b.st[0] = nloc; b.st[1] = nx; }
        const unsigned old = xb_add(&bar[XB_XSUB(b.x)], 1u);
        const unsigned gen = old / nloc;
        if (old + 1u == (gen + 1u) * nloc) {
            __builtin_amdgcn_fence(__ATOMIC_RELEASE, "agent");
            asm volatile("s_waitcnt vmcnt(0)" ::: "memory");
            const unsigned og = xb_add(&bar[XB_TOP], 1u);
            const unsigned tg = og / nx;
            if (og + 1u == (tg + 1u) * nx) xb_add(&bar[XB_TOPGEN], 1u);
            else XB_SPIN(xb_ld(&bar[XB_TOPGEN]) == tg, bar);
            __builtin_amdgcn_fence(__ATOMIC_ACQUIRE, "agent");
            xb_add(&bar[XB_XGEN(b.x)], 1u);
            asm volatile("s_waitcnt vmcnt(0)" ::: "memory");
        } else {
            XB_SPIN(xb_ld(&bar[XB_XGEN(b.x)]) == gen, bar);
            __builtin_amdgcn_fence(__ATOMIC_ACQUIRE, "agent");
            asm volatile("s_waitcnt vmcnt(0)" ::: "memory");
        }
    }
    __syncthreads();
}

__device__ __forceinline__ float shx(float v, int mask, int lane) { return __int_as_float(__builtin_amdgcn_ds_bpermute((lane ^ mask) << 2, __float_as_int(v))); }
__device__ __forceinline__ float wave_sum(float v, int lane) {
#pragma unroll
    for (int o = 1; o < 64; o <<= 1) v += shx(v, o, lane);
    return v;
}

typedef const pg8::f32x4 (&AccRef)[2][2][4][2];

struct EpiQKV {
    static constexpr bool PERM = true, AFTER_DRAIN = false;
    bf16 *Q, *K, *V; const float* cs;
    __device__ __forceinline__ void operator()(AccRef acc, const pg8::Unit& u, int wr, int wc, int fr, int fq) const {
        const int pn = u.pn, row0 = u.pm * 256 + wr * 64 + fr, tj = u.pm % 17; const bool isctx = (tj == 16); const int t0 = tj * 256 + wr * 64 + fr;
        if (pn < 16) {
            bf16* dst = (pn < 8) ? Q : K; const float sc = (pn < 8) ? 1.0f : 0.0625f; const int hc = (pn & 7) * 256 + wc * 32 + 8 * fq;
#pragma unroll
            for (int ai = 0; ai < 2; ++ai)
#pragma unroll
                for (int m = 0; m < 4; ++m) { const int r = row0 + ai * 128 + m * 16, t = t0 + ai * 128 + m * 16;
#pragma unroll
                    for (int bj = 0; bj < 2; ++bj) { f32x4 v0 = acc[ai][bj][m][0], v1 = acc[ai][bj][m][1];
                        if (!isctx) { const f32x4* cp = (const f32x4*)(cs + ((size_t)t * 128 + bj * 64 + wc * 16 + 4 * fq) * 2); const f32x4 c0 = cp[0], c1 = cp[1];
                            v0 = (f32x4){v0[0] * c0[0] - v0[1] * c0[1], v0[0] * c0[1] + v0[1] * c0[0], v0[2] * c0[2] - v0[3] * c0[3], v0[2] * c0[3] + v0[3] * c0[2]};
                            v1 = (f32x4){v1[0] * c1[0] - v1[1] * c1[1], v1[0] * c1[1] + v1[1] * c1[0], v1[2] * c1[2] - v1[3] * c1[3], v1[2] * c1[3] + v1[3] * c1[2]}; }
                        v0 = v0 * sc; v1 = v1 * sc;
                        v4u w; w.x = cvt_pk_bf16(v0[0], v0[1]); w.y = cvt_pk_bf16(v0[2], v0[3]); w.z = cvt_pk_bf16(v1[0], v1[1]); w.w = cvt_pk_bf16(v1[2], v1[3]);
                        *(v4u*)(dst + (size_t)r * 2048 + hc + bj * 128) = w; } }
        } else {
            const int vc = (pn - 16) * 256 + wc * 32 + 8 * fq;
#pragma unroll
            for (int ai = 0; ai < 2; ++ai)
#pragma unroll
                for (int m = 0; m < 4; ++m) { const int r = row0 + ai * 128 + m * 16;
#pragma unroll
                    for (int bj = 0; bj < 2; ++bj) { const f32x4 v0 = acc[ai][bj][m][0], v1 = acc[ai][bj][m][1];
                        v4u w; w.x = cvt_pk_bf16(v0[0], v0[1]); w.y = cvt_pk_bf16(v0[2], v0[3]); w.z = cvt_pk_bf16(v1[0], v1[1]); w.w = cvt_pk_bf16(v1[2], v1[3]);
                        *(v4u*)(V + (size_t)r * 4096 + vc + bj * 128) = w; } }
        }
    }
};
struct EpiGate {
    static constexpr bool PERM = true, AFTER_DRAIN = false;
    const bf16 *OF, *OB; const float* part; bf16* YG;
    __device__ __forceinline__ void operator()(AccRef acc, const pg8::Unit& u, int wr, int wc, int fr, int fq) const {
        const int head = u.pn >> 2, col = u.pn * 128 + wc * 32 + 8 * fq, row0 = u.pm * 256 + wr * 64 + fr;
#pragma unroll
        for (int hb = 0; hb < 4; ++hb) { const int ai = hb >> 1, mb = (hb & 1) * 2;
            f32x4 pa[2][4]; v4u of[2], ob[2];
#pragma unroll
            for (int mm = 0; mm < 2; ++mm) { const int r = row0 + ai * 128 + (mb + mm) * 16; const f32x4* pp = (const f32x4*)(part + ((size_t)r * 8 + head) * 16);
                pa[mm][0] = pp[0]; pa[mm][1] = pp[1]; pa[mm][2] = pp[2]; pa[mm][3] = pp[3];
                of[mm] = *(const v4u*)(OF + (size_t)r * 4096 + col); ob[mm] = *(const v4u*)(OB + (size_t)r * 4096 + col); }
#pragma unroll
            for (int mm = 0; mm < 2; ++mm) { const int m = mb + mm; const int r = row0 + ai * 128 + m * 16;
                const f32x4 a0 = pa[mm][0], a1 = pa[mm][1], b0 = pa[mm][2], b1 = pa[mm][3];
                const float mf = ((a0[0] + a0[2]) + (a1[0] + a1[2])) * (1.0f / 512.0f), qf = ((a0[1] + a0[3]) + (a1[1] + a1[3])) * (1.0f / 512.0f);
                const float mbb = ((b0[0] + b0[2]) + (b1[0] + b1[2])) * (1.0f / 512.0f), qb = ((b0[1] + b0[3]) + (b1[1] + b1[3])) * (1.0f / 512.0f);
                const float rf = rsqrtf(fmaxf(qf - mf * mf, 0.f) + GN_EPS), rb = rsqrtf(fmaxf(qb - mbb * mbb, 0.f) + GN_EPS);
                float y[8];
#pragma unroll
                for (int n = 0; n < 2; ++n) { const f32x4 gf = acc[ai][0][m][n], gb = acc[ai][1][m][n];
#pragma unroll
                    for (int e = 0; e < 4; ++e) { const int idx = n * 4 + e; const unsigned wf = of[mm][idx >> 1], wb = ob[mm][idx >> 1];
                        const float xf = (idx & 1) ? bfhi(wf) : bflo(wf), xb = (idx & 1) ? bfhi(wb) : bflo(wb);
                        y[idx] = silu_f(gf[e]) * ((xf - mf) * rf) + silu_f(gb[e]) * ((xb - mbb) * rb); } }
                v4u w; w.x = cvt_pk_bf16(y[0], y[1]); w.y = cvt_pk_bf16(y[2], y[3]); w.z = cvt_pk_bf16(y[4], y[5]); w.w = cvt_pk_bf16(y[6], y[7]);
                *(v4u*)(YG + (size_t)r * 4096 + col) = w; } }
    }
};
struct EpiSwiglu {
    static constexpr bool PERM = true, AFTER_DRAIN = false;
    bf16* HID;
    __device__ __forceinline__ void operator()(AccRef acc, const pg8::Unit& u, int wr, int wc, int fr, int fq) const {
        const int col = u.pn * 128 + wc * 32 + 8 * fq, row0 = u.pm * 256 + wr * 64 + fr;
#pragma unroll
        for (int ai = 0; ai < 2; ++ai)
#pragma unroll
            for (int m = 0; m < 4; ++m) { const int r = row0 + ai * 128 + m * 16; float y[8];
#pragma unroll
                for (int n = 0; n < 2; ++n) { const f32x4 a = acc[ai][0][m][n], b = acc[ai][1][m][n];
#pragma unroll
                    for (int e = 0; e < 4; ++e) y[n * 4 + e] = silu_f(a[e]) * b[e]; }
                v4u w; w.x = cvt_pk_bf16(y[0], y[1]); w.y = cvt_pk_bf16(y[2], y[3]); w.z = cvt_pk_bf16(y[4], y[5]); w.w = cvt_pk_bf16(y[6], y[7]);
                *(v4u*)(HID + (size_t)r * FF + col) = w; }
    }
};
struct EpiBf {
    static constexpr bool PERM = true, AFTER_DRAIN = false;
    bf16 *O0, *O1; int ldc, split; float* YP;
    __device__ __forceinline__ void operator()(AccRef acc, const pg8::Unit& u, int wr, int wc, int fr, int fq) const {
        const int row0 = u.pm * 256 + wr * 64 + fr, cw = wc * 32 + 8 * fq;
        if (u.ks >= 0) {
            const int crow0 = ((u.pm - 16) / 17) * 256 + wr * 64 + fr;
#pragma unroll
            for (int ai = 0; ai < 2; ++ai)
#pragma unroll
                for (int m = 0; m < 4; ++m) { float* rp = YP + ((size_t)u.ks * 1024 + crow0 + ai * 128 + m * 16) * 2048 + u.pn * 256 + cw;
#pragma unroll
                    for (int bj = 0; bj < 2; ++bj) { *(f32x4*)(rp + bj * 128) = acc[ai][bj][m][0]; *(f32x4*)(rp + bj * 128 + 4) = acc[ai][bj][m][1]; } }
            return; }
#pragma unroll
        for (int ai = 0; ai < 2; ++ai)
#pragma unroll
            for (int m = 0; m < 4; ++m) { const int r = row0 + ai * 128 + m * 16;
#pragma unroll
                for (int bj = 0; bj < 2; ++bj) { const f32x4 v0 = acc[ai][bj][m][0], v1 = acc[ai][bj][m][1];
                    v4u w; w.x = cvt_pk_bf16(v0[0], v0[1]); w.y = cvt_pk_bf16(v0[2], v0[3]); w.z = cvt_pk_bf16(v1[0], v1[1]); w.w = cvt_pk_bf16(v1[2], v1[3]);
                    bf16* dst = split ? ((bj ? O1 : O0) + (size_t)r * ldc + u.pn * 128 + cw) : (O0 + (size_t)r * ldc + u.pn * 256 + bj * 128 + cw);
                    *(v4u*)dst = w; } }
    }
};
struct EpiF32 {
    static constexpr bool PERM = false, AFTER_DRAIN = false;
    float* C; int ldc;
    __device__ __forceinline__ void operator()(AccRef acc, const pg8::Unit& u, int wr, int wc, int fr, int fq) const {
        const int row0 = u.pm * 256 + wr * 64 + fr, col0 = u.pn * 256 + wc * 32 + 4 * fq;
#pragma unroll
        for (int ai = 0; ai < 2; ++ai)
#pragma unroll
            for (int m = 0; m < 4; ++m) { float* rowp = C + (size_t)(row0 + ai * 128 + m * 16) * ldc + col0;
#pragma unroll
                for (int bj = 0; bj < 2; ++bj)
#pragma unroll
                    for (int n = 0; n < 2; ++n) *(f32x4*)(rowp + bj * 128 + n * 16) = acc[ai][bj][m][n]; }
    }
};
struct EpiDQKV {
    static constexpr bool PERM = true, AFTER_DRAIN = false;
    bf16 *CQ, *CKV, *KR; float* ssq; const float* acs;
    __device__ __forceinline__ void operator()(AccRef acc, const pg8::Unit& u, int wr, int wc, int fr, int fq) const {
        const int row0 = u.pm * 256 + wr * 64 + fr, tj = u.pm % 17; const bool isctx = (tj == 16); const int t0 = tj * 256 + wr * 64 + fr;
        if (u.pn < 4) { bf16* dst = (u.pn < 2) ? CQ : CKV; const int colb = (u.pn & 1) * 256 + wc * 32 + 8 * fq;
#pragma unroll
            for (int ai = 0; ai < 2; ++ai)
#pragma unroll
                for (int m = 0; m < 4; ++m) { const int r = row0 + ai * 128 + m * 16; float q = 0.f;
#pragma unroll
                    for (int bj = 0; bj < 2; ++bj) { const f32x4 v0 = acc[ai][bj][m][0], v1 = acc[ai][bj][m][1];
                        q += (v0[0] * v0[0] + v0[1] * v0[1]) + (v0[2] * v0[2] + v0[3] * v0[3]) + (v1[0] * v1[0] + v1[1] * v1[1]) + (v1[2] * v1[2] + v1[3] * v1[3]);
                        v4u w; w.x = cvt_pk_bf16(v0[0], v0[1]); w.y = cvt_pk_bf16(v0[2], v0[3]); w.z = cvt_pk_bf16(v1[0], v1[1]); w.w = cvt_pk_bf16(v1[2], v1[3]);
                        *(v4u*)(dst + (size_t)r * 512 + colb + bj * 128) = w; }
                    { const int ln = fq * 16 + fr;
                      q += shx(q, 16, ln); q += shx(q, 32, ln); }
                    if (fq == 0) ssq[(size_t)r * 16 + u.pn * 4 + wc] = q; }
        } else if (wc < 2) {
#pragma unroll
            for (int ai = 0; ai < 2; ++ai)
#pragma unroll
                for (int m = 0; m < 4; ++m) { const int r = row0 + ai * 128 + m * 16, t = t0 + ai * 128 + m * 16;
                    f32x4 v0 = acc[ai][0][m][0], v1 = acc[ai][0][m][1];
                    if (!isctx) { const f32x4* cp = (const f32x4*)(acs + ((size_t)t * 32 + 16 * wc + 4 * fq) * 2); const f32x4 c0 = cp[0], c1 = cp[1];
                        v0 = (f32x4){v0[0] * c0[0] - v0[1] * c0[1], v0[0] * c0[1] + v0[1] * c0[0], v0[2] * c0[2] - v0[3] * c0[3], v0[2] * c0[3] + v0[3] * c0[2]};
                        v1 = (f32x4){v1[0] * c1[0] - v1[1] * c1[1], v1[0] * c1[1] + v1[1] * c1[0], v1[2] * c1[2] - v1[3] * c1[3], v1[2] * c1[3] + v1[3] * c1[2]}; }
                    v4u w; w.x = cvt_pk_bf16(v0[0], v0[1]); w.y = cvt_pk_bf16(v0[2], v0[3]); w.z = cvt_pk_bf16(v1[0], v1[1]); w.w = cvt_pk_bf16(v1[2], v1[3]);
                    *(v4u*)(KR + (size_t)r * 64 + wc * 32 + 8 * fq) = w; }
        }
    }
};
__device__ __forceinline__ float rms_rstd(const float* p) { const f32x4 a = *(const f32x4*)p, b = *(const f32x4*)(p + 4); return rsqrtf(((a[0] + a[1]) + (a[2] + a[3]) + (b[0] + b[1]) + (b[2] + b[3])) * (1.0f / 512.0f) + RMS_EPS); }
struct EpiUKV {
    static constexpr bool PERM = true, AFTER_DRAIN = false;
    bf16 *KN, *VB; const float* ssq;
    __device__ __forceinline__ void operator()(AccRef acc, const pg8::Unit& u, int wr, int wc, int fr, int fq) const {
        const int row0 = u.pm * 256 + wr * 64 + fr, cw = u.pn * 128 + wc * 32 + 8 * fq;
#pragma unroll
        for (int ai = 0; ai < 2; ++ai)
#pragma unroll
            for (int m = 0; m < 4; ++m) { const int r = row0 + ai * 128 + m * 16; const float rs = rms_rstd(ssq + (size_t)r * 16 + 8);
#pragma unroll
                for (int bj = 0; bj < 2; ++bj) { const f32x4 v0 = acc[ai][bj][m][0] * rs, v1 = acc[ai][bj][m][1] * rs;
                    v4u w; w.x = cvt_pk_bf16(v0[0], v0[1]); w.y = cvt_pk_bf16(v0[2], v0[3]); w.z = cvt_pk_bf16(v1[0], v1[1]); w.w = cvt_pk_bf16(v1[2], v1[3]);
                    *(v4u*)((bj ? VB : KN) + (size_t)r * 2048 + cw) = w; } }
    }
};
struct EpiUQ {
    static constexpr bool PERM = true, AFTER_DRAIN = false;
    bf16* QB; const float* acs; const float* ssq;
    __device__ __forceinline__ void operator()(AccRef acc, const pg8::Unit& u, int wr, int wc, int fr, int fq) const {
        const int row0 = u.pm * 256 + wr * 64 + fr, tj = u.pm % 17; const bool isctx = (tj == 16); const int t0 = tj * 256 + wr * 64 + fr;
#pragma unroll
        for (int bj = 0; bj < 2; ++bj) { const int blk = 4 * u.pn + 2 * bj + (wc >> 1); const bool rope = ((blk % 3) == 2) && !isctx;
            const int col = u.pn * 256 + bj * 128 + wc * 32 + 8 * fq, p0 = 16 * (wc & 1) + 4 * fq;
#pragma unroll
            for (int ai = 0; ai < 2; ++ai)
#pragma unroll
                for (int m = 0; m < 4; ++m) { const int r = row0 + ai * 128 + m * 16, t = t0 + ai * 128 + m * 16; const float rs = rms_rstd(ssq + (size_t)r * 16);
                    f32x4 v0 = acc[ai][bj][m][0] * rs, v1 = acc[ai][bj][m][1] * rs;
                    if (rope) { const f32x4* cp = (const f32x4*)(acs + ((size_t)t * 32 + p0) * 2); const f32x4 c0 = cp[0], c1 = cp[1];
                        v0 = (f32x4){v0[0] * c0[0] - v0[1] * c0[1], v0[0] * c0[1] + v0[1] * c0[0], v0[2] * c0[2] - v0[3] * c0[3], v0[2] * c0[3] + v0[3] * c0[2]};
                        v1 = (f32x4){v1[0] * c1[0] - v1[1] * c1[1], v1[0] * c1[1] + v1[1] * c1[0], v1[2] * c1[2] - v1[3] * c1[3], v1[2] * c1[3] + v1[3] * c1[2]}; }
                    v4u w; w.x = cvt_pk_bf16(v0[0], v0[1]); w.y = cvt_pk_bf16(v0[2], v0[3]); w.z = cvt_pk_bf16(v1[0], v1[1]); w.w = cvt_pk_bf16(v1[2], v1[3]);
                    *(v4u*)(QB + (size_t)r * 3072 + col) = w; } }
    }
};

__device__ __forceinline__ int srccol(int mode, int n, int halfn) {
    if (mode == 1) { if (n >= 4096) return n; const int d = n & 255; return (n & ~255) + ((d & 1) ? 128 + (d >> 1) : (d >> 1)); }
    if (mode == 2) { const int t = n >> 8, r = n & 255; return (r < 128) ? t * 128 + r : halfn + t * 128 + (r - 128); }
    if (mode == 4) { const int h = n / 192, d = n - h * 192; if (d < 128) return n; const int p = d - 128, hf = p >> 5, dd = p & 31; return h * 192 + 128 + hf * 32 + ((dd & 1) ? 16 + (dd >> 1) : (dd >> 1)); }
    if (mode == 5) { const int hf = n >> 5, dd = n & 31; return 512 + hf * 32 + ((dd & 1) ? 16 + (dd >> 1) : (dd >> 1)); }
    return n;
}
struct CvtJob { const float* W; bf16* WT; int ldw, K, Nd, mode, halfn; const float* kscale; };
template <bool KS> __device__ __forceinline__ void transpose_item(const CvtJob& J, LAS float* scr, int item, int lane) {
    const int nblk = J.Nd / 32, kb = item / nblk, nb = item - kb * nblk, k0 = 64 * kb, n0 = 32 * nb;
    const int sc = srccol(J.mode, n0 + (lane & 31), J.halfn);
#pragma unroll
    for (int i = 0; i < 32; ++i) { const int kk = 2 * i + (lane >> 5); float w = J.W[(size_t)(k0 + kk) * J.ldw + sc]; if (KS) w *= J.kscale[k0 + kk]; scr[kk * 33 + (lane & 31)] = w; }
    LDS_WAIT(); asm volatile("" ::: "memory");
    const int c = lane & 7;
#pragma unroll
    for (int j = 0; j < 4; ++j) { const int n = (lane >> 3) + 8 * j; const LAS float* s = scr + (8 * c) * 33 + n;
        v4u o; o.x = cvt_pk_bf16(s[0 * 33], s[1 * 33]); o.y = cvt_pk_bf16(s[2 * 33], s[3 * 33]); o.z = cvt_pk_bf16(s[4 * 33], s[5 * 33]); o.w = cvt_pk_bf16(s[6 * 33], s[7 * 33]);
        *(v4u*)(J.WT + (size_t)(n0 + n) * J.K + k0 + 8 * c) = o; }
    LDS_WAIT(); asm volatile("" ::: "memory");
}

struct Args { const float* in[21]; float* out; unsigned char* ws; int ph_lo, ph_hi; };
enum { I_X = 0, I_C, I_CTX, I_CCTX, I_ADAW, I_ADAB, I_LNG, I_LNB, I_RWQKV, I_RWG, I_RDEC, I_RWO, I_MWDQ, I_MGQ, I_MWUQ, I_MWDKV, I_MGKV, I_MWUKV, I_MWO, I_FWIN, I_FWOUT };

__device__ __forceinline__ CvtJob cvt_job(const Args& a, int j) {
    unsigned char* ws = a.ws; CvtJob J; J.mode = 0; J.halfn = 0; J.kscale = nullptr;
    if (j < 6) { const int l = j / 3, k = j - 3 * l;
        if (k == 0) { J.W = a.in[I_RWQKV] + (size_t)l * 2048 * 8192; J.WT = (bf16*)(ws + WS_WQKV) + (size_t)l * 8192 * 2048; J.ldw = 8192; J.K = 2048; J.Nd = 8192; J.mode = 1; }
        else if (k == 1) { J.W = a.in[I_RWG] + (size_t)l * 2048 * 8192; J.WT = (bf16*)(ws + WS_WG) + (size_t)l * 8192 * 2048; J.ldw = 8192; J.K = 2048; J.Nd = 8192; J.mode = 2; J.halfn = 4096; }
        else { J.W = a.in[I_RWO] + (size_t)l * 4096 * 2048; J.WT = (bf16*)(ws + WS_WOR) + (size_t)l * 2048 * 4096; J.ldw = 2048; J.K = 4096; J.Nd = 2048; }
    } else if (j < 18) { const int jj = j - 6, l = jj / 6, k = jj - 6 * l; bf16* wd = (bf16*)(ws + WS_WD) + (size_t)l * 1280 * 2048;
        if (k == 0) { J.W = a.in[I_MWDQ] + (size_t)l * 2048 * 512; J.WT = wd; J.ldw = 512; J.K = 2048; J.Nd = 512; }
        else if (k == 1) { J.W = a.in[I_MWDKV] + (size_t)l * 2048 * 576; J.WT = wd + (size_t)512 * 2048; J.ldw = 576; J.K = 2048; J.Nd = 512; }
        else if (k == 2) { J.W = a.in[I_MWDKV] + (size_t)l * 2048 * 576; J.WT = wd + (size_t)1024 * 2048; J.ldw = 576; J.K = 2048; J.Nd = 64; J.mode = 5; }
        else if (k == 3) { J.W = a.in[I_MWUQ] + (size_t)l * 512 * 3072; J.WT = (bf16*)(ws + WS_WUQ) + (size_t)l * 3072 * 512; J.ldw = 3072; J.K = 512; J.Nd = 3072; J.mode = 4; J.kscale = a.in[I_MGQ] + (size_t)l * 512; }
        else if (k == 4) { J.W = a.in[I_MWUKV] + (size_t)l * 512 * 4096; J.WT = (bf16*)(ws + WS_WUKV) + (size_t)l * 4096 * 512; J.ldw = 4096; J.K = 512; J.Nd = 4096; J.kscale = a.in[I_MGKV] + (size_t)l * 512; }
        else { J.W = a.in[I_MWO] + (size_t)l * 2048 * 2048; J.WT = (bf16*)(ws + WS_WOM) + (size_t)l * 2048 * 2048; J.ldw = 2048; J.K = 2048; J.Nd = 2048; }
    } else { const int jj = j - 18, l = jj >> 1;
        if ((jj & 1) == 0) { J.W = a.in[I_FWIN] + (size_t)l * 2048 * 11264; J.WT = (bf16*)(ws + WS_WIN) + (size_t)l * 11264 * 2048; J.ldw = 11264; J.K = 2048; J.Nd = 11264; J.mode = 2; J.halfn = 5632; }
        else { J.W = a.in[I_FWOUT] + (size_t)l * 5632 * 2048; J.WT = (bf16*)(ws + WS_WOUT) + (size_t)l * 2048 * 5632; J.ldw = 2048; J.K = 5632; J.Nd = 2048; }
    }
    return J;
}
constexpr int N_CVT_JOBS = 26;
__host__ __device__ constexpr bool cvt_deferred(int j) { return !(j < 3 || j == 18 || j == 19); }
__host__ __device__ constexpr int def_job(int k) { return k < 6 ? 6 + k : k < 8 ? 20 + (k - 6) : k < 11 ? 3 + (k - 8) : k < 13 ? 22 + (k - 11) : k < 19 ? 12 + (k - 13) : 24 + (k - 19); }
constexpr int N_DEF_JOBS = 21, DEF_MLA = 512 + 512 + 64 + 768 + 1024 + 2048, DEF_FFN = 11264 + 5632, DEF_RET = 2 * 8192 + 4096;
constexpr int DEF_DL0 = DEF_MLA + DEF_FFN, DEF_DL1 = DEF_DL0 + DEF_RET + DEF_FFN, DEF_DL2 = DEF_DL1 + DEF_MLA + DEF_FFN;
constexpr int N_DEF_ITEMS = DEF_DL2;

__device__ __forceinline__ bool def_resolve(const Args& a, int idx, int lim, CvtJob& J, int& it) {
    if (idx >= lim) return false;
    int cum = 0;
    for (int k = 0; k < N_DEF_JOBS; ++k) { const CvtJob Jj = cvt_job(a, def_job(k)); const int nit = (Jj.K / 64) * (Jj.Nd / 32);
        if (idx < cum + nit) { J = Jj; it = idx - cum; return true; }
        cum += nit; }
    return false;
}
__device__ __forceinline__ void convert_deferred(const Args& a, LAS float* scr, int lane, int first, int stride, int cnt, int lim = N_DEF_ITEMS) {
    for (int k0 = 0; k0 < cnt; k0 += 4) {
        int q0 = 0;
        while (q0 < 4) {
            CvtJob J; int it0; const int idx0 = first + (k0 + q0) * stride;
            if (!def_resolve(a, idx0, lim, J, it0)) return;
            const int nblk = J.Nd / 32, nit = (J.K / 64) * nblk;
            int m = 1; while (q0 + m < 4 && it0 + m * stride < nit && idx0 + m * stride < lim) ++m;
            float r[4][32];
#pragma unroll
            for (int x = 0; x < 4; ++x) if (x < m) { const int it = it0 + x * stride, kb = it / nblk, nb = it - kb * nblk, kk0 = 64 * kb, n0 = 32 * nb; const int sc = srccol(J.mode, n0 + (lane & 31), J.halfn);
                const float* wp = J.W + (size_t)(kk0 + (lane >> 5)) * J.ldw + sc;
#pragma unroll
                for (int i = 0; i < 32; ++i) r[x][i] = wp[(size_t)(2 * i) * J.ldw]; }
#pragma unroll
            for (int x = 0; x < 4; ++x) if (x < m) { const int it = it0 + x * stride, kb = it / nblk, nb = it - kb * nblk, kk0 = 64 * kb, n0 = 32 * nb;
#pragma unroll
                for (int i = 0; i < 32; ++i) { const int kk = 2 * i + (lane >> 5); float w = r[x][i]; if (J.kscale) w *= J.kscale[kk0 + kk]; scr[kk * 33 + (lane & 31)] = w; }
                LDS_WAIT(); asm volatile("" ::: "memory");
                const int c = lane & 7;
#pragma unroll
                for (int j = 0; j < 4; ++j) { const int n = (lane >> 3) + 8 * j; const LAS float* s = scr + (8 * c) * 33 + n;
                    v4u o; o.x = cvt_pk_bf16(s[0 * 33], s[1 * 33]); o.y = cvt_pk_bf16(s[2 * 33], s[3 * 33]); o.z = cvt_pk_bf16(s[4 * 33], s[5 * 33]); o.w = cvt_pk_bf16(s[6 * 33], s[7 * 33]);
                    *(v4u*)(J.WT + (size_t)(n0 + n) * J.K + kk0 + 8 * c) = o; }
                LDS_WAIT(); asm volatile("" ::: "memory"); }
            q0 += m;
        }
    }
}
__device__ __forceinline__ void phase_pro_a(const Args& a, LAS unsigned char* lds, int tid, int lane, int wave, int vcu, int G) {
    unsigned char* ws = a.ws;
    const int gw = vcu * NWAVES + wave, NGW = G * NWAVES;
#ifndef PROA_REP_CVT
#define PROA_REP_CVT 1
#endif
#ifndef PROA_REP_GEMV
#define PROA_REP_GEMV 1
#endif
    for (int rep_c = 0; rep_c < PROA_REP_CVT; ++rep_c)
    { LAS float* scr = (LAS float*)(lds + wave * 16384);
      int cum = 0;
      for (int j = 0; j < N_CVT_JOBS; ++j) { if (cvt_deferred(j)) continue; const CvtJob J = cvt_job(a, j); const int nit = (J.K / 64) * (J.Nd / 32);
          int start = (gw - cum) % NGW; if (start < 0) start += NGW;
          if (J.kscale) { for (int it = start; it < nit; it += NGW) transpose_item<true>(J, scr, it, lane); }
          else { for (int it = start; it < nit; it += NGW) transpose_item<false>(J, scr, it, lane); }
          cum = (cum + nit) % NGW; }
      const int gt = vcu * 512 + tid, NT = G * 512;
      for (int l = 0; l < 2; ++l) { v4u* z = (v4u*)((bf16*)(ws + WS_WD) + (size_t)l * 1280 * 2048 + (size_t)1088 * 2048);
          for (int i = gt; i < 192 * 2048 / 8; i += NT) z[i] = (v4u){0u, 0u, 0u, 0u}; }
    }
    __syncthreads();
    { const int gt = vcu * 512 + tid, NT = G * 512; f32x2* rcs = (f32x2*)(ws + WS_RCS); f32x2* acs = (f32x2*)(ws + WS_ACS);
      for (int e = gt; e < 4096 * 128; e += NT) { const int t = e >> 7, j = e & 127; const float inv = exp2f(-((float)j * (1.0f / 127.0f)) * 13.287712379549449f);
          const float ang = (float)t * inv; rcs[e] = (f32x2){cosf(ang), sinf(ang)}; }
      for (int e = gt; e < 4096 * 32; e += NT) { const int t = e >> 5, p = e & 31; const int j = p & 15; const float inv = exp2f(-((float)j * (1.0f / 16.0f)) * 13.287712379549449f);
          const float pos = (p < 16) ? (float)(t >> 6) : (float)(t & 63); const float ang = pos * inv; acs[e] = (f32x2){cosf(ang), sinf(ang)}; }
    }
    { LAS float* sc = (LAS float*)lds;
      LAS float* red = (LAS float*)(lds + 5 * 2048 * 4);
      for (int i = tid; i < 5 * 2048; i += 512) { const float v = (i < 4 * 2048) ? a.in[I_C][i] : a.in[I_CCTX][i - 4 * 2048]; sc[i] = silu_f(v); }
      __syncthreads();
      float* mod = (float*)(ws + WS_MOD);
      const int kq = lane >> 4, c4 = lane & 15;
      for (int rep_g = 0; rep_g < PROA_REP_GEMV; ++rep_g)
      for (int it = vcu; it < 4 * 192; it += G) { const int layer = it / 192, col0 = (it - layer * 192) * 64;
          const float* Wl = a.in[I_ADAW] + (size_t)layer * 2048 * 12288 + col0 + 4 * c4;
          float acc[5][4];
#pragma unroll
          for (int r = 0; r < 5; ++r)
#pragma unroll
              for (int e = 0; e < 4; ++e) acc[r][e] = 0.f;
#pragma unroll 8
          for (int j = 0; j < 64; ++j) { const int k = wave * 256 + 4 * j + kq; const f32x4 w = *(const f32x4*)(Wl + (size_t)k * 12288);
#pragma unroll
              for (int r = 0; r < 5; ++r) { const float s = sc[r * 2048 + k]; acc[r][0] += s * w[0]; acc[r][1] += s * w[1]; acc[r][2] += s * w[2]; acc[r][3] += s * w[3]; } }
#pragma unroll
          for (int r = 0; r < 5; ++r)
#pragma unroll
              for (int e = 0; e < 4; ++e) { float v = acc[r][e]; v += shx(v, 16, lane); v += shx(v, 32, lane); acc[r][e] = v; }
          if (lane < 16) {
#pragma unroll
              for (int r = 0; r < 5; ++r)
#pragma unroll
                  for (int e = 0; e < 4; ++e) red[(wave * 5 + r) * 64 + 4 * c4 + e] = acc[r][e]; }
          __syncthreads();
          if (tid < 320) { const int r = tid >> 6, c = tid & 63; float s = 0.f;
#pragma unroll
              for (int w = 0; w < 8; ++w) s += red[(w * 5 + r) * 64 + c];
              mod[((size_t)layer * 5 + r) * 12288 + col0 + c] = s + a.in[I_ADAB][(size_t)layer * 12288 + col0 + c]; }
          __syncthreads(); }
    }
}

__device__ __forceinline__ const float* src_row(const Args& a, int r, int& r5) {
    const int b = r / TPB, t = r - b * TPB;
    if (t < SEQ) { r5 = b; return a.in[I_X] + ((size_t)b * SEQ + t) * D; }
    r5 = 4; return a.in[I_CTX] + ((size_t)b * CTXL + (t - SEQ)) * D;
}
__device__ __forceinline__ void phase_pro_b(const Args& a, int lane, int wave, int vcu, int G) {
    const int gw = vcu * NWAVES + wave, NGW = G * NWAVES; const float* mod = (const float*)(a.ws + WS_MOD);
    bf16* U = (bf16*)(a.ws + WS_U);
    for (int r = gw; r < M; r += NGW) { int r5; const float* src = src_row(a, r, r5); const float* sh = mod + (size_t)r5 * 12288, *scl = sh + 2048;
#pragma unroll
        for (int j = 0; j < 8; ++j) { const int c = 4 * lane + 256 * j; const f32x4 v = *(const f32x4*)(src + c), s = *(const f32x4*)(scl + c), t = *(const f32x4*)(sh + c);
            const f32x4 uu = v * (1.0f + s) + t;
            v2u w; w.x = cvt_pk_bf16(uu[0], uu[1]); w.y = cvt_pk_bf16(uu[2], uu[3]); *(v2u*)(U + (size_t)r * D + c) = w; } }
}
template <bool FIRST> __device__ __forceinline__ void phase_ln_t(const Args& a, int layer, int which, LAS unsigned char* lds, int tid, int lane, int wave, int vcu, int G, bool dry) {
    const float* mod = (const float*)(a.ws + WS_MOD);
    const h16* H = (const h16*)(a.ws + WS_H); h16* Hw = (h16*)(a.ws + (dry ? WS_END : WS_H)); bf16* U = (bf16*)(a.ws + (dry ? WS_END + 136 * MiB : WS_U)); const bf16* Y = (const bf16*)(a.ws + WS_Y);
    const bool latonly = (layer == DEPTH - 1), final = (layer == DEPTH - 1) && which == 1; const bool ysplit = !latonly; const float* YP = (const float*)(a.ws + WS_YP);
    const float* lg = a.in[I_LNG] + ((size_t)layer * 2 + which) * D; const float* lb = a.in[I_LNB] + ((size_t)layer * 2 + which) * D;
    const int gch = which ? 5 : 2; const int nlayer = final ? 0 : (which ? layer + 1 : layer), nsh = which ? 0 : 3;
    const int nrows = latonly ? BATCH * SEQ : M, rpc = nrows / G;
    LAS float* V = (LAS float*)lds;
    if (G != 256) return;
    const int bb = vcu >> 6, c6 = vcu & 63; const int i0 = 0;
    __syncthreads();
    {
        const int i4 = 4 * tid; f32x4 v8[8];
#pragma unroll
        for (int v = 0; v < 2; ++v) { const int r5 = v ? 4 : bb;
            v8[v * 3 + 0] = *(const f32x4*)(mod + ((size_t)layer * 5 + r5) * 12288 + gch * 2048 + i4);
            v8[v * 3 + 1] = *(const f32x4*)(mod + ((size_t)nlayer * 5 + r5) * 12288 + nsh * 2048 + i4);
            v8[v * 3 + 2] = *(const f32x4*)(mod + ((size_t)nlayer * 5 + r5) * 12288 + (nsh + 1) * 2048 + i4); }
        v8[6] = *(const f32x4*)(lg + i4); v8[7] = *(const f32x4*)(lb + i4);
#pragma unroll
        for (int v = 0; v < 8; ++v) *(LAS f32x4*)(V + v * 2048 + i4) = v8[v]; }

    __syncthreads();
    for (int k = wave; k < rpc; k += 2 * NWAVES) {
        f32x4 z[2][8]; int rr[2], tt[2]; bool ok[2];
#pragma unroll
        for (int q = 0; q < 2; ++q) { const int kk = k + q * NWAVES; ok[q] = kk < rpc; const int ii = ok[q] ? kk : 0;
            const int t = (ii < 64) ? c6 * 64 + ii : SEQ + c6 * 4 + (ii - 64); const int r = bb * TPB + t; rr[q] = r; tt[q] = t;
            const LAS float* gate = V + (t < SEQ ? 0 : 3) * 2048;
            const float* xrow = (t < SEQ) ? a.in[I_X] + ((size_t)bb * SEQ + t) * D : a.in[I_CTX] + ((size_t)bb * CTXL + (t - SEQ)) * D; const h16* hrow = H + (size_t)r * D;
            f32x4 hv[8], yv[8];
            if (FIRST) {
#pragma unroll
                for (int j = 0; j < 8; ++j) hv[j] = *(const f32x4*)(xrow + 4 * lane + 256 * j);
            } else {
#pragma unroll
                for (int j = 0; j < 8; ++j) hv[j] = __builtin_convertvector(*(const h16x4*)(hrow + 4 * lane + 256 * j), f32x4);
            }
            if (ysplit && t >= SEQ) { const float* yp = YP + ((size_t)bb * CTXL + (t - SEQ)) * D + 4 * lane;
#pragma unroll
                for (int jh = 0; jh < 2; ++jh) { f32x4 p[4][4];
#pragma unroll
                    for (int jj = 0; jj < 4; ++jj)
#pragma unroll
                        for (int s4 = 0; s4 < 4; ++s4) p[jj][s4] = *(const f32x4*)(yp + 256 * (4 * jh + jj) + (size_t)s4 * 1024 * D);
#pragma unroll
                    for (int jj = 0; jj < 4; ++jj) yv[4 * jh + jj] = (p[jj][0] + p[jj][1]) + (p[jj][2] + p[jj][3]); }
            } else {
#pragma unroll
                for (int j = 0; j < 8; ++j) { const v2u yw = *(const v2u*)(Y + (size_t)r * D + 4 * lane + 256 * j); yv[j] = (f32x4){bflo(yw.x), bfhi(yw.x), bflo(yw.y), bfhi(yw.y)}; }
            }
#pragma unroll
            for (int j = 0; j < 8; ++j) { const int c = 4 * lane + 256 * j; const f32x4 g = *(const LAS f32x4*)(gate + c);
                z[q][j] = hv[j] * ALPHA + g * yv[j]; } }
        float s0 = 0.f, s1 = 0.f;
#pragma unroll
        for (int j = 0; j < 8; ++j) { s0 += (z[0][j][0] + z[0][j][1]) + (z[0][j][2] + z[0][j][3]); s1 += (z[1][j][0] + z[1][j][1]) + (z[1][j][2] + z[1][j][3]); }
#pragma unroll
        for (int o = 1; o < 64; o <<= 1) { s0 += shx(s0, o, lane); s1 += shx(s1, o, lane); }
        const float m0 = s0 * (1.0f / D), m1 = s1 * (1.0f / D); float q0 = 0.f, q1 = 0.f;
#pragma unroll
        for (int j = 0; j < 8; ++j) { z[0][j] = z[0][j] - m0; z[1][j] = z[1][j] - m1;
            q0 += (z[0][j][0] * z[0][j][0] + z[0][j][1] * z[0][j][1]) + (z[0][j][2] * z[0][j][2] + z[0][j][3] * z[0][j][3]);
            q1 += (z[1][j][0] * z[1][j][0] + z[1][j][1] * z[1][j][1]) + (z[1][j][2] * z[1][j][2] + z[1][j][3] * z[1][j][3]); }
#pragma unroll
        for (int o = 1; o < 64; o <<= 1) { q0 += shx(q0, o, lane); q1 += shx(q1, o, lane); }
        const float rs[2] = {rsqrtf(q0 * (1.0f / D) + LN_EPS), rsqrtf(q1 * (1.0f / D) + LN_EPS)};
#pragma unroll
        for (int q = 0; q < 2; ++q) { if (!ok[q]) continue; const int r = rr[q], t = tt[q]; const LAS float* nm = V + ((t < SEQ ? 0 : 3) + 1) * 2048;
#pragma unroll
            for (int j = 0; j < 8; ++j) { const int c = 4 * lane + 256 * j; const f32x4 gg = *(const LAS f32x4*)(V + 6 * 2048 + c), bv = *(const LAS f32x4*)(V + 7 * 2048 + c);
                const f32x4 hn = z[q][j] * rs[q] * gg + bv;
                if (final) { if (!dry) *(f32x4*)(a.out + ((size_t)bb * SEQ + t) * D + c) = hn; else *(h16x4*)(Hw + (size_t)r * D + c) = __builtin_convertvector(hn, h16x4); }
                else { *(h16x4*)(Hw + (size_t)r * D + c) = __builtin_convertvector(hn, h16x4); const f32x4 sh = *(const LAS f32x4*)(nm + c), sc = *(const LAS f32x4*)(nm + 2048 + c); const f32x4 uu = hn * (1.0f + sc) + sh;
                    v2u w; w.x = cvt_pk_bf16(uu[0], uu[1]); w.y = cvt_pk_bf16(uu[2], uu[3]); *(v2u*)(U + (size_t)r * D + c) = w; } } }
    }
    __syncthreads();
}
__device__ __forceinline__ void phase_ln(const Args& a, int layer, int which, LAS unsigned char* lds, int tid, int lane, int wave, int vcu, int G, bool dry = false) {
    if (layer == 0 && which == 0) phase_ln_t<true>(a, layer, which, lds, tid, lane, wave, vcu, G, dry); else phase_ln_t<false>(a, layer, which, lds, tid, lane, wave, vcu, G, dry);
}
__device__ __forceinline__ void phase_mla_norm(const Args& a, int ml, int lane, int wave, int vcu, int G) {
    const int gw = vcu * NWAVES + wave, NGW = G * NWAVES;
    const float* C = (const float*)(a.ws + WS_CQKV); bf16* CQN = (bf16*)(a.ws + WS_CQN); bf16* CKVN = (bf16*)(a.ws + WS_CKVN); bf16* KR = (bf16*)(a.ws + WS_KR);
    const float* gq = a.in[I_MGQ] + (size_t)ml * 512; const float* gkv = a.in[I_MGKV] + (size_t)ml * 512; const f32x2* acs = (const f32x2*)(a.ws + WS_ACS);
    for (int r = gw; r < M; r += NGW) { const float* row = C + (size_t)r * 1280; const int b = r / TPB, t = r - b * TPB;
        f32x4 q0 = *(const f32x4*)(row + 4 * lane), q1 = *(const f32x4*)(row + 256 + 4 * lane), k0 = *(const f32x4*)(row + 512 + 4 * lane), k1 = *(const f32x4*)(row + 768 + 4 * lane);
        float sq = (q0[0] * q0[0] + q0[1] * q0[1]) + (q0[2] * q0[2] + q0[3] * q0[3]) + (q1[0] * q1[0] + q1[1] * q1[1]) + (q1[2] * q1[2] + q1[3] * q1[3]);
        float sk = (k0[0] * k0[0] + k0[1] * k0[1]) + (k0[2] * k0[2] + k0[3] * k0[3]) + (k1[0] * k1[0] + k1[1] * k1[1]) + (k1[2] * k1[2] + k1[3] * k1[3]);
        const float rq = rsqrtf(wave_sum(sq, lane) * (1.0f / 512.0f) + RMS_EPS), rk = rsqrtf(wave_sum(sk, lane) * (1.0f / 512.0f) + RMS_EPS);
        const f32x4 g0 = *(const f32x4*)(gq + 4 * lane), g1 = *(const f32x4*)(gq + 256 + 4 * lane), h0 = *(const f32x4*)(gkv + 4 * lane), h1 = *(const f32x4*)(gkv + 256 + 4 * lane);
        q0 = q0 * rq * g0; q1 = q1 * rq * g1; k0 = k0 * rk * h0; k1 = k1 * rk * h1;
        v2u w; w.x = cvt_pk_bf16(q0[0], q0[1]); w.y = cvt_pk_bf16(q0[2], q0[3]); *(v2u*)(CQN + (size_t)r * 512 + 4 * lane) = w;
        w.x = cvt_pk_bf16(q1[0], q1[1]); w.y = cvt_pk_bf16(q1[2], q1[3]); *(v2u*)(CQN + (size_t)r * 512 + 256 + 4 * lane) = w;
        w.x = cvt_pk_bf16(k0[0], k0[1]); w.y = cvt_pk_bf16(k0[2], k0[3]); *(v2u*)(CKVN + (size_t)r * 512 + 4 * lane) = w;
        w.x = cvt_pk_bf16(k1[0], k1[1]); w.y = cvt_pk_bf16(k1[2], k1[3]); *(v2u*)(CKVN + (size_t)r * 512 + 256 + 4 * lane) = w;
        if (lane < 32) { f32x2 kr = *(const f32x2*)(row + 1024 + 2 * lane);
            if (t < SEQ) { const f32x2 cs = acs[(size_t)t * 32 + lane]; kr = (f32x2){kr[0] * cs[0] - kr[1] * cs[1], kr[0] * cs[1] + kr[1] * cs[0]}; }
            *(unsigned*)(KR + (size_t)r * 64 + 2 * lane) = cvt_pk_bf16(kr[0], kr[1]); } }
}

constexpr int RQ_RS = 528, RV_RS = 288, RP_RS = 144;
__device__ __forceinline__ int koff(int row, int ch32) { const int f = ((row & 3) << 2) | ((row >> 2) & 3); return (ch32 >> 4) * 16384 + row * 256 + (((ch32 & 15) ^ f) << 4); }
constexpr int RL_Q = 0, RL_K = RL_Q + 64 * RQ_RS, RL_V = RL_K + 32768, RL_P = RL_V + 64 * RV_RS, RL_OT = RL_P + 64 * RP_RS, RL_FAC = RL_OT + 64 * 272, RL_END = RL_FAC + 4 * 64 * 4;
constexpr int ROT_RS = 272;
static_assert(RL_END <= RING_BYTES, "retention LDS map");
template <int OFF> __device__ __forceinline__ s16x4 tr_read(int addr) {
    s16x4 r; asm volatile("ds_read_b64_tr_b16 %0, %1 offset:%2" : "=&v"(r) : "v"(addr), "i"(OFF) : "memory"); return r;
}
template <int CTL> __device__ __forceinline__ float dpp_ctl(float v) { return __int_as_float(__builtin_amdgcn_update_dpp(0, __float_as_int(v), CTL, 0xf, 0xf, false)); }
template <int N> __device__ __forceinline__ float dpp_ror(float v) { return __int_as_float(__builtin_amdgcn_update_dpp(0, __float_as_int(v), 0x120 + N, 0xf, 0xf, false)); }
__device__ __forceinline__ bf16x8 cat4(s16x4 l, s16x4 h) { return (bf16x8){l[0], l[1], l[2], l[3], h[0], h[1], h[2], h[3]}; }

__device__ __forceinline__ void phase_ret_scan(const Args& a, int rl, LAS unsigned char* lds, int tid, int lane, int wave, int vcu, int G) {
    const bf16* Qg = (const bf16*)(a.ws + WS_RQ); const bf16* Kg = (const bf16*)(a.ws + WS_RK); const bf16* Vg = (const bf16*)(a.ws + WS_RV);
    bf16* OFg = (bf16*)(a.ws + WS_OF); bf16* OBg = (bf16*)(a.ws + WS_OB); f32x2* part = (f32x2*)(a.ws + WS_PART);
    LAS float* fac = (LAS float*)(lds + RL_FAC);
    const int ldsb = (int)(uintptr_t)lds;
    for (int item = vcu; item < 256; item += G) {
        const int slice = item & 3, dir = (item >> 2) & 1, h = (item >> 3) & 7, b = item >> 6;
        __syncthreads();
        if (tid < 64) { const float x = a.in[I_RDEC][(size_t)rl * 16 + dir * 8 + h]; const float lg = -log1pf(expf(-x));
            const int i = tid;
            fac[i] = dir ? expf(-lg * (float)i) : expf(lg * (float)(i - 63));
            fac[64 + i] = dir ? expf(lg * (float)(64 - i)) : expf(lg * (float)(i + 1));
            fac[128 + i] = dir ? expf(lg * (float)i) : expf(lg * (float)(63 - i));
            if (i == 0) fac[192] = expf(lg * 64.0f); }
        __syncthreads();
#define RET_ROWBASE(n) ({ int _cc, _rb; if ((n) < 4) { _cc = dir ? 3 - (n) : (n); _rb = b * TPB + SEQ + 64 * _cc; } else { _cc = dir ? 63 - ((n) - 4) : (n) - 4; _rb = b * TPB + 64 * _cc; } _rb; })
        if (wave < 4) {
            __builtin_amdgcn_s_setprio(2);
            int lane_c = lane; asm volatile("" : "+v"(lane_c));
            const int g = lane_c >> 4, c16 = lane_c & 15, q4 = c16 >> 2, p4 = lane_c & 3;
            const int cw = wave, sa = cw >> 1, sb = cw & 1;
            const float cdec = fac[192];
            const float pf[2] = {fac[16 * (2 * sa) + c16], fac[16 * (2 * sa + 1) + c16]};
            int kb[4][2];
#pragma unroll
            for (int u = 0; u < 4; ++u)
#pragma unroll
                for (int t = 0; t < 2; ++t) { const int row = 8 * g + 4 * t + q4, f = ((row & 3) << 2) | ((row >> 2) & 3); kb[u][t] = ldsb + RL_K + row * 256 + (((4 * u + p4) ^ f) << 4); }
            pg8::f32x4 S[2][16];
#pragma unroll
            for (int nb = 0; nb < 2; ++nb)
#pragma unroll
                for (int T = 0; T < 16; ++T) S[nb][T] = (pg8::f32x4){0.f, 0.f, 0.f, 0.f};
            for (int n = 0; n < 68; ++n) {
                __syncthreads();
                { pg8::f32x4 sc[2][2];
#pragma unroll
                  for (int ti = 0; ti < 2; ++ti)
#pragma unroll
                      for (int tj = 0; tj < 2; ++tj) sc[ti][tj] = (pg8::f32x4){0.f, 0.f, 0.f, 0.f};
                  bf16x8 fq_[2][2], fa_[2][2];
#pragma unroll
                  for (int t = 0; t < 2; ++t) { fq_[0][t] = *(const LAS bf16x8*)(lds + RL_Q + (16 * (2 * sa + t) + c16) * RQ_RS + (8 * g) * 2); fa_[0][t] = *(const LAS bf16x8*)(lds + RL_K + koff(16 * (2 * sb + t) + c16, g)); }
#pragma unroll
                  for (int s = 0; s < 8; ++s) {
                      if (s < 7) {
#pragma unroll
                          for (int t = 0; t < 2; ++t) { fq_[(s + 1) & 1][t] = *(const LAS bf16x8*)(lds + RL_Q + (16 * (2 * sa + t) + c16) * RQ_RS + (32 * (s + 1) + 8 * g) * 2);
                              fa_[(s + 1) & 1][t] = *(const LAS bf16x8*)(lds + RL_K + koff(16 * (2 * sb + t) + c16, 4 * (s + 1) + g)); } }
#pragma unroll
                      for (int ti = 0; ti < 2; ++ti)
#pragma unroll
                          for (int tj = 0; tj < 2; ++tj) sc[ti][tj] = __builtin_amdgcn_mfma_f32_16x16x32_bf16(fa_[s & 1][tj], fq_[s & 1][ti], sc[ti][tj], 0, 0, 0); }
#pragma unroll
                  for (int ti = 0; ti < 2; ++ti) { const int i = 16 * (2 * sa + ti) + c16;
#pragma unroll
                      for (int tj = 0; tj < 2; ++tj) { const pg8::f32x4 scv = sc[ti][tj]; const int j0 = 16 * (2 * sb + tj) + 4 * g; float pv[4];
#pragma unroll
                          for (int r = 0; r < 4; ++r) { const int j = j0 + r; const bool keep = dir ? (j >= i) : (j <= i); pv[r] = keep ? scv[r] * pf[ti] : 0.f; }
                          v2u w; w.x = cvt_pk_bf16(pv[0], pv[1]); w.y = cvt_pk_bf16(pv[2], pv[3]);
                          *(LAS v2u*)(lds + RL_P + i * RP_RS + j0 * 2) = w; } } }
                pg8::f32x4 o[2][4];
#pragma unroll
                for (int nb = 0; nb < 2; ++nb)
#pragma unroll
                    for (int ib = 0; ib < 4; ++ib) o[nb][ib] = (pg8::f32x4){0.f, 0.f, 0.f, 0.f};
                { bf16x8 aq[2][4];
#pragma unroll
                  for (int ib = 0; ib < 4; ++ib) aq[0][ib] = *(const LAS bf16x8*)(lds + RL_Q + (16 * ib + c16) * RQ_RS + (8 * g) * 2);
#pragma unroll
                  for (int s = 0; s < 8; ++s) {
                      if (s < 7) {
#pragma unroll
                          for (int ib = 0; ib < 4; ++ib) aq[(s + 1) & 1][ib] = *(const LAS bf16x8*)(lds + RL_Q + (16 * ib + c16) * RQ_RS + (32 * (s + 1) + 8 * g) * 2); }
                      bf16x8 bs[2];
#pragma unroll
                      for (int nb = 0; nb < 2; ++nb) { v4u bw; bw.x = cvt_pk_bf16(S[nb][2 * s][0], S[nb][2 * s][1]); bw.y = cvt_pk_bf16(S[nb][2 * s][2], S[nb][2 * s][3]); bw.z = cvt_pk_bf16(S[nb][2 * s + 1][0], S[nb][2 * s + 1][1]); bw.w = cvt_pk_bf16(S[nb][2 * s + 1][2], S[nb][2 * s + 1][3]);
                          bs[nb] = __builtin_bit_cast(bf16x8, bw); }
#pragma unroll
                      for (int ib = 0; ib < 4; ++ib)
#pragma unroll
                          for (int nb = 0; nb < 2; ++nb) o[nb][ib] = __builtin_amdgcn_mfma_f32_16x16x32_bf16(aq[s & 1][ib], bs[nb], o[nb][ib], 0, 0, 0); } }
#pragma unroll
                for (int ib = 0; ib < 4; ++ib)
#pragma unroll
                    for (int r = 0; r < 4; ++r) { const float qf = fac[64 + 16 * ib + 4 * g + r]; o[0][ib][r] *= qf; o[1][ib][r] *= qf; }
                bf16x8 bv[2][2];
                { const int va = ldsb + RL_V + (8 * g + q4) * RV_RS + (32 * cw + 4 * p4) * 2;
                  const s16x4 l0 = tr_read<0>(va), h0 = tr_read<4 * RV_RS>(va), l1 = tr_read<32 * RV_RS>(va), h1 = tr_read<36 * RV_RS>(va);
                  const s16x4 m0 = tr_read<32>(va), n0 = tr_read<32 + 4 * RV_RS>(va), m1 = tr_read<32 + 32 * RV_RS>(va), n1 = tr_read<32 + 36 * RV_RS>(va);
                  LDS_WAIT(); SBAR();
                  bv[0][0] = cat4(l0, h0); bv[0][1] = cat4(l1, h1); bv[1][0] = cat4(m0, n0); bv[1][1] = cat4(m1, n1); }
                {
#define KTR(T, ks, t) tr_read<(ks) * 8192 + ((T) >> 3) * 16384 + ((T) & 1) * 8>(kb[((T) >> 1) & 3][t])
#define KLOAD(T, L0, H0, L1, H1) do { L0 = KTR(T, 0, 0); H0 = KTR(T, 0, 1); L1 = KTR(T, 1, 0); H1 = KTR(T, 1, 1); } while (0)
#define KMMA(T, L0, H0, L1, H1) do { const bf16x8 A0_ = cat4(L0, H0), A1_ = cat4(L1, H1); \
                      pg8::f32x4 ac0_ = S[0][T] * cdec, ac1_ = S[1][T] * cdec; \
                      ac0_ = __builtin_amdgcn_mfma_f32_16x16x32_bf16(A0_, bv[0][0], ac0_, 0, 0, 0); ac1_ = __builtin_amdgcn_mfma_f32_16x16x32_bf16(A0_, bv[1][0], ac1_, 0, 0, 0); \
                      ac0_ = __builtin_amdgcn_mfma_f32_16x16x32_bf16(A1_, bv[0][1], ac0_, 0, 0, 0); ac1_ = __builtin_amdgcn_mfma_f32_16x16x32_bf16(A1_, bv[1][1], ac1_, 0, 0, 0); \
                      S[0][T] = ac0_; S[1][T] = ac1_; } while (0)
                  s16x4 xa0, xa1, xa2, xa3, ya0, ya1, ya2, ya3;
                  KLOAD(0, xa0, xa1, xa2, xa3);
#define KGROUP(T, LAST) do { KLOAD(T + 1, ya0, ya1, ya2, ya3); \
                      asm volatile("s_waitcnt lgkmcnt(4)" ::: "memory"); SBAR(); \
                      KMMA(T, xa0, xa1, xa2, xa3); \
                      if (!(LAST)) { KLOAD(((T) + 2) & 15, xa0, xa1, xa2, xa3); asm volatile("s_waitcnt lgkmcnt(4)" ::: "memory"); } \
                      else asm volatile("s_waitcnt lgkmcnt(0)" ::: "memory"); \
                      SBAR(); \
                      KMMA(T + 1, ya0, ya1, ya2, ya3); } while (0)
                  KGROUP(0, false); KGROUP(2, false); KGROUP(4, false); KGROUP(6, false); KGROUP(8, false); KGROUP(10, false); KGROUP(12, false); KGROUP(14, true);
#undef KGROUP
#undef KTR
#undef KLOAD
#undef KMMA
                }
                __syncthreads();
#pragma unroll
                for (int ks = 0; ks < 2; ++ks)
#pragma unroll
                    for (int ib = 0; ib < 4; ++ib) { const bf16x8 ap = *(const LAS bf16x8*)(lds + RL_P + (16 * ib + c16) * RP_RS + (32 * ks + 8 * g) * 2);
                        o[0][ib] = __builtin_amdgcn_mfma_f32_16x16x32_bf16(ap, bv[0][ks], o[0][ib], 0, 0, 0); o[1][ib] = __builtin_amdgcn_mfma_f32_16x16x32_bf16(ap, bv[1][ks], o[1][ib], 0, 0, 0); }
#pragma unroll
                for (int nb = 0; nb < 2; ++nb)
#pragma unroll
                    for (int ib = 0; ib < 4; ++ib)
#pragma unroll
                        for (int r = 0; r < 4; ++r) *(LAS unsigned short*)(lds + RL_OT + (16 * ib + 4 * g + r) * ROT_RS + (32 * cw + 16 * nb + c16) * 2) = __builtin_bit_cast(unsigned short, (__bf16)o[nb][ib][r]);
            }
            __builtin_amdgcn_s_setprio(0);
            __syncthreads();
        } else {
            int lt_ = tid - 256; asm volatile("" : "+v"(lt_)); const int lt = lt_; bf16* Og = dir ? OBg : OFg;
            const int qrow = lt >> 5, qch = lt & 31, vrow = lt >> 4, vch = lt & 15;
            v4u sq[8], sk[8], sv[4];
#define RET_LOAD(n) do { const int _rb = RET_ROWBASE(n); \
            _Pragma("unroll") for (int e = 0; e < 8; ++e) { sq[e] = *(const v4u*)(Qg + (size_t)(_rb + qrow + 8 * e) * 2048 + h * 256 + qch * 8); sk[e] = *(const v4u*)(Kg + (size_t)(_rb + qrow + 8 * e) * 2048 + h * 256 + qch * 8); } \
            _Pragma("unroll") for (int e = 0; e < 4; ++e) sv[e] = *(const v4u*)(Vg + (size_t)(_rb + vrow + 16 * e) * 4096 + h * 512 + slice * 128 + vch * 8); } while (0)
#define RET_STAGE() do { \
            _Pragma("unroll") for (int e = 0; e < 8; ++e) { *(LAS v4u*)(lds + RL_Q + (qrow + 8 * e) * RQ_RS + qch * 16) = sq[e]; *(LAS v4u*)(lds + RL_K + koff(qrow + 8 * e, qch)) = sk[e]; } \
            _Pragma("unroll") for (int e = 0; e < 4; ++e) { const float vf = fac[128 + vrow + 16 * e]; v4u w; \
                w.x = cvt_pk_bf16(bflo(sv[e].x) * vf, bfhi(sv[e].x) * vf); w.y = cvt_pk_bf16(bflo(sv[e].y) * vf, bfhi(sv[e].y) * vf); \
                w.z = cvt_pk_bf16(bflo(sv[e].z) * vf, bfhi(sv[e].z) * vf); w.w = cvt_pk_bf16(bflo(sv[e].w) * vf, bfhi(sv[e].w) * vf); \
                *(LAS v4u*)(lds + RL_V + (vrow + 16 * e) * RV_RS + vch * 16) = w; } } while (0)
#define RET_OSTORE(n) do { const int rowprev = RET_ROWBASE(n); \
            _Pragma("unroll") for (int e = 0; e < 2; ++e) { const int orow = (lt >> 3) + 32 * e, ocg = lt & 7; const LAS v4u* op = (const LAS v4u*)(lds + RL_OT + orow * ROT_RS + ocg * 32); const v4u w0 = op[0], w1 = op[1]; \
              float s1 = 0.f, s2 = 0.f; \
              _Pragma("unroll") for (int q = 0; q < 4; ++q) { const float a0 = bflo(w0[q]), a1 = bfhi(w0[q]), b0 = bflo(w1[q]), b1 = bfhi(w1[q]); s1 += (a0 + a1) + (b0 + b1); s2 += (a0 * a0 + a1 * a1) + (b0 * b0 + b1 * b1); } \
              s1 += dpp_ctl<0xB1>(s1); s2 += dpp_ctl<0xB1>(s2); s1 += dpp_ctl<0x4E>(s1); s2 += dpp_ctl<0x4E>(s2); s1 += dpp_ctl<0x141>(s1); s2 += dpp_ctl<0x141>(s2); \
              v4u* gp = (v4u*)(Og + (size_t)(rowprev + orow) * 4096 + h * 512 + slice * 128 + ocg * 16); gp[0] = w0; gp[1] = w1; \
              if (ocg == 0) part[(size_t)(rowprev + orow) * 64 + h * 8 + dir * 4 + slice] = (f32x2){s1, s2}; } } while (0)
            RET_LOAD(0);
            RET_STAGE();
            for (int n = 0; n < 68; ++n) {
                __syncthreads();
                if (n + 1 < 68) RET_LOAD(n + 1);
                if (n > 0) RET_OSTORE(n - 1);
                __syncthreads();
                if (n + 1 < 68) RET_STAGE();
            }
            __syncthreads();
            RET_OSTORE(67);
#undef RET_LOAD
#undef RET_STAGE
#undef RET_OSTORE
        }
#undef RET_ROWBASE
    }
}

namespace att {
constexpr int KVBLK = 64, QBLK = 32;
constexpr int LDQ = 3072, LDKN = 2048, LDKR = 64, LDV = 2048, LDO = 2048;
constexpr float SCALE = MLA_SCALE;
constexpr float THR = 8.f;
constexpr int SHM_V = KVBLK * 128 * 2, SHM_K = KVBLK * 128 * 2, SHM_R = KVBLK * 64 * 2;
constexpr int L_V = 0, L_K = 2 * SHM_V, L_R = L_K + 2 * SHM_K, L_WS = L_R + 2 * SHM_R, L_END = L_WS + NWAVES * 64 * 4;
static_assert(L_END <= RING_BYTES, "attention LDS map");
#define KSWZ(row, colB) ((row) * 256 + ((colB) ^ (((row) & 7) << 4)))
#define RSWZ(row, colB) ((row) * 128 + ((colB) ^ (((row) & 7) << 4)))
__device__ __forceinline__ int crow(int r, int hi) { return (r & 3) + 8 * (r >> 2) + 4 * hi; }
__device__ __forceinline__ void partialSM(f32x16& p0, f32x16& p1, float& m_reg, float& mn, float& alpha) {
  constexpr float C = SCALE * 1.4426950408889634f;
  float pmax = p0[0];
#pragma unroll
  for (int r = 1; r < 16; ++r) pmax = fmaxf(pmax, p0[r]);
#pragma unroll
  for (int r = 0; r < 16; ++r) pmax = fmaxf(pmax, p1[r]);
  { auto rr = __builtin_amdgcn_permlane32_swap(__float_as_uint(pmax), __float_as_uint(pmax), false, false);
    pmax = fmaxf(__uint_as_float(rr[0]), __uint_as_float(rr[1])); }
  if (__builtin_expect(__all(pmax - m_reg <= THR / SCALE), 1)) { mn = m_reg; alpha = 1.f; }
  else { mn = fmaxf(m_reg, pmax); alpha = __builtin_amdgcn_exp2f((m_reg - mn) * C); m_reg = mn; }
  const float mnC = -mn * C;
#pragma unroll
  for (int r = 0; r < 16; ++r) p0[r] = fmaf(p0[r], C, mnC);
#pragma unroll
  for (int r = 0; r < 16; ++r) p1[r] = fmaf(p1[r], C, mnC);
#pragma unroll
  for (int r = 0; r < 16; ++r) p0[r] = __builtin_amdgcn_exp2f(p0[r]);
}
__device__ __forceinline__ void finishSM(f32x16& p0, f32x16& p1, float alpha, float& l_reg, bf16x8& pa0, bf16x8& pa1, bf16x8& pa2, bf16x8& pa3) {
#pragma unroll
  for (int r = 0; r < 16; ++r) p1[r] = __builtin_amdgcn_exp2f(p1[r]);
  float ps = 0;
#pragma unroll
  for (int r = 0; r < 16; ++r) ps += p0[r];
#pragma unroll
  for (int r = 0; r < 16; ++r) ps += p1[r];
  { auto rr = __builtin_amdgcn_permlane32_swap(__float_as_uint(ps), __float_as_uint(ps), false, false);
    ps = __uint_as_float(rr[0]) + __uint_as_float(rr[1]); }
  l_reg = l_reg * alpha + ps;
#define PK4(P, BASE, OUT) do { unsigned a0 = cvt_pk_bf16(P[BASE + 0], P[BASE + 1]), a1 = cvt_pk_bf16(P[BASE + 2], P[BASE + 3]);   \
    unsigned b0 = cvt_pk_bf16(P[BASE + 4], P[BASE + 5]), b1 = cvt_pk_bf16(P[BASE + 6], P[BASE + 7]);                              \
    auto r0 = __builtin_amdgcn_permlane32_swap(a0, b0, false, false); auto r1 = __builtin_amdgcn_permlane32_swap(a1, b1, false, false); \
    v4u w = {r0[0], r1[0], r0[1], r1[1]}; OUT = __builtin_bit_cast(bf16x8, w); } while (0)
  PK4(p0, 0, pa0); PK4(p0, 8, pa1); PK4(p1, 0, pa2); PK4(p1, 8, pa3);
#undef PK4
}
__device__ __forceinline__ void qkt(f32x16& p0, f32x16& p1, const LAS unsigned char* Ks, const LAS unsigned char* Rs, const bf16x8 (&qr)[12], int r32, int hi) {
  p0 = f32x16{}; p1 = f32x16{};
#pragma unroll
  for (int d0 = 0; d0 < 8; ++d0) { const int cb = (d0 * 16 + hi * 8) * 2;
    const bf16x8 b0 = *(const LAS bf16x8*)(Ks + KSWZ(r32, cb));
    const bf16x8 b1 = *(const LAS bf16x8*)(Ks + KSWZ(32 + r32, cb));
    p0 = __builtin_amdgcn_mfma_f32_32x32x16_bf16(b0, qr[d0], p0, 0, 0, 0);
    p1 = __builtin_amdgcn_mfma_f32_32x32x16_bf16(b1, qr[d0], p1, 0, 0, 0); }
#pragma unroll
  for (int d0 = 0; d0 < 4; ++d0) { const int cb = (d0 * 16 + hi * 8) * 2;
    const bf16x8 b0 = *(const LAS bf16x8*)(Rs + RSWZ(r32, cb));
    const bf16x8 b1 = *(const LAS bf16x8*)(Rs + RSWZ(32 + r32, cb));
    p0 = __builtin_amdgcn_mfma_f32_32x32x16_bf16(b0, qr[8 + d0], p0, 0, 0, 0);
    p1 = __builtin_amdgcn_mfma_f32_32x32x16_bf16(b1, qr[8 + d0], p1, 0, 0, 0); }
}
__device__ __forceinline__ int v_st(int k, int c) { const int kk = (k & ~0xC) | ((k & 4) << 1) | ((k & 8) >> 1); return ((kk >> 3) * 4 + (c >> 5)) * 512 + ((kk & 7) * 32 + (c & 31)) * 2; }
__device__ __forceinline__ int v_rd_base(int lane) { return ((lane & 3) << 3) | (((lane >> 2) & 3) << 6) | (((lane >> 4) & 1) << 5) | (((lane >> 5) & 1) << 8); }
constexpr int v_rd_off(int d0, int ks, int half) { return d0 * 512 + ks * 4096 + half * 2048; }
template <int D0> __device__ __forceinline__ void pv_one(f32x16& od, int vb, bf16x8 pa0, bf16x8 pa1, bf16x8 pa2, bf16x8 pa3) {
  const s16x4 l0 = tr_read<v_rd_off(D0, 0, 0)>(vb), h0 = tr_read<v_rd_off(D0, 0, 1)>(vb), l1 = tr_read<v_rd_off(D0, 1, 0)>(vb), h1 = tr_read<v_rd_off(D0, 1, 1)>(vb);
  const s16x4 l2 = tr_read<v_rd_off(D0, 2, 0)>(vb), h2 = tr_read<v_rd_off(D0, 2, 1)>(vb), l3 = tr_read<v_rd_off(D0, 3, 0)>(vb), h3 = tr_read<v_rd_off(D0, 3, 1)>(vb);
  asm volatile("s_waitcnt lgkmcnt(0)" ::: "memory"); SBAR();
  od = __builtin_amdgcn_mfma_f32_32x32x16_bf16(pa0, cat4(l0, h0), od, 0, 0, 0);
  od = __builtin_amdgcn_mfma_f32_32x32x16_bf16(pa1, cat4(l1, h1), od, 0, 0, 0);
  od = __builtin_amdgcn_mfma_f32_32x32x16_bf16(pa2, cat4(l2, h2), od, 0, 0, 0);
  od = __builtin_amdgcn_mfma_f32_32x32x16_bf16(pa3, cat4(l3, h3), od, 0, 0, 0);
}
__device__ __forceinline__ void pv_d0(f32x16* o, int vb, bf16x8 pa0, bf16x8 pa1, bf16x8 pa2, bf16x8 pa3) {
  pv_one<0>(o[0], vb, pa0, pa1, pa2, pa3); pv_one<1>(o[1], vb, pa0, pa1, pa2, pa3); pv_one<2>(o[2], vb, pa0, pa1, pa2, pa3); pv_one<3>(o[3], vb, pa0, pa1, pa2, pa3);
}
__device__ __forceinline__ void attn_body(const bf16* __restrict__ Qb, const bf16* __restrict__ Kn, const bf16* __restrict__ Kr, const bf16* __restrict__ Vh,
                                          bf16* __restrict__ Ob, int seq, LAS unsigned char* lds, int tid_in) {
  int tid_ = tid_in; asm volatile("" : "+v"(tid_));
  const int tid = tid_, wid = tid >> 6, lane = tid & 63, r32 = lane & 31, hi = lane >> 5;
  LAS unsigned char* V_lds = lds + L_V; LAS unsigned char* K_lds = lds + L_K; LAS unsigned char* R_lds = lds + L_R;
  LAS float* wsf = (LAS float*)(lds + L_WS) + wid * 64; LAS float* li_l = wsf; LAS float* al_l = wsf + 32;
  float m_reg = -1e30f, l_reg = 0; f32x16 o[4] = {}; bf16x8 qr[12];
  const bf16* Qw = Qb + (size_t)(wid * QBLK + r32) * LDQ + hi * 8;
#pragma unroll
  for (int d0 = 0; d0 < 12; ++d0) qr[d0] = *(const bf16x8*)(Qw + d0 * 16);
  const int sr = tid >> 4, sc = (tid & 15) * 8, vst0 = v_st(sr, sc), vst1 = v_st(32 + sr, sc);
  const int rr = tid >> 3, rc = (tid & 7) * 8;
  const int vb0 = (int)(uintptr_t)V_lds + v_rd_base(lane);
  bf16x8 vs0, vs1, ks0, ks1, rs0;
#define SLOAD(k0) do { vs0 = *(const bf16x8*)(Vh + (size_t)((k0) + sr) * LDV + sc); vs1 = *(const bf16x8*)(Vh + (size_t)((k0) + 32 + sr) * LDV + sc); \
    ks0 = *(const bf16x8*)(Kn + (size_t)((k0) + sr) * LDKN + sc); ks1 = *(const bf16x8*)(Kn + (size_t)((k0) + 32 + sr) * LDKN + sc); \
    rs0 = *(const bf16x8*)(Kr + (size_t)((k0) + rr) * LDKR + rc); } while (0)
#define SWRITE(b) do { *(LAS bf16x8*)(V_lds + (b) * SHM_V + vst0) = vs0; *(LAS bf16x8*)(V_lds + (b) * SHM_V + vst1) = vs1; const int kc = sc * 2; \
    *(LAS bf16x8*)(K_lds + (b) * SHM_K + KSWZ(sr, kc)) = ks0; *(LAS bf16x8*)(K_lds + (b) * SHM_K + KSWZ(32 + sr, kc)) = ks1; \
    *(LAS bf16x8*)(R_lds + (b) * SHM_R + RSWZ(rr, rc * 2)) = rs0; } while (0)
#define RESC(a) do { if (__any((a) < 1.f)) { if (hi == 0) al_l[r32] = (a); asm volatile("s_waitcnt lgkmcnt(0)" ::: "memory"); \
    _Pragma("unroll") for (int d = 0; d < 4; ++d) _Pragma("unroll") for (int r = 0; r < 16; ++r) o[d][r] *= al_l[crow(r, hi)]; } } while (0)
  f32x16 pA0, pA1, pB0, pB1; float mnA, mnB, alA, alB; bf16x8 pa0, pa1, pa2, pa3; const int NT = seq / KVBLK;
  SLOAD(0); VM_WAIT(); SWRITE(0); __syncthreads();
  qkt(pA0, pA1, K_lds, R_lds, qr, r32, hi); partialSM(pA0, pA1, m_reg, mnA, alA);
  SLOAD(KVBLK);
  VM_WAIT(); SWRITE(1); __syncthreads();
  for (int j = 1; j + 1 < NT; j += 2) {
    SBAR(); qkt(pB0, pB1, K_lds + SHM_K, R_lds + SHM_R, qr, r32, hi);
    finishSM(pA0, pA1, alA, l_reg, pa0, pa1, pa2, pa3); SBAR();
    SLOAD((j + 1) * KVBLK); SBAR();
    pv_d0(o, vb0, pa0, pa1, pa2, pa3); partialSM(pB0, pB1, m_reg, mnB, alB);
    __syncthreads(); VM_WAIT(); SWRITE(0);
    RESC(alB); __syncthreads();
    SBAR(); qkt(pA0, pA1, K_lds, R_lds, qr, r32, hi);
    finishSM(pB0, pB1, alB, l_reg, pa0, pa1, pa2, pa3); SBAR();
    SLOAD((j + 2) * KVBLK); SBAR();
    pv_d0(o, vb0 + SHM_V, pa0, pa1, pa2, pa3); partialSM(pA0, pA1, m_reg, mnA, alA);
    __syncthreads(); VM_WAIT(); SWRITE(1);
    RESC(alA); __syncthreads();
  }
  SBAR(); qkt(pB0, pB1, K_lds + SHM_K, R_lds + SHM_R, qr, r32, hi);
  finishSM(pA0, pA1, alA, l_reg, pa0, pa1, pa2, pa3); SBAR();
  pv_d0(o, vb0, pa0, pa1, pa2, pa3); partialSM(pB0, pB1, m_reg, mnB, alB);
  __syncthreads(); RESC(alB);
  finishSM(pB0, pB1, alB, l_reg, pa0, pa1, pa2, pa3); SBAR();
  pv_d0(o, vb0 + SHM_V, pa0, pa1, pa2, pa3);
  if (hi == 0) li_l[r32] = l_reg; asm volatile("s_waitcnt lgkmcnt(0)" ::: "memory");
  float rli[16];
#pragma unroll
  for (int r = 0; r < 16; ++r) rli[r] = __builtin_amdgcn_rcpf(li_l[crow(r, hi)]);
  bf16* Ow = Ob + (size_t)(wid * QBLK) * LDO;
#pragma unroll
  for (int r = 0; r < 16; ++r) { const int orow = crow(r, hi);
#pragma unroll
    for (int d0 = 0; d0 < 4; ++d0) Ow[(size_t)orow * LDO + d0 * 32 + r32] = (bf16)(cvt_pk_bf16(o[d0][r] * rli[r], 0.f) & 0xffffu); }
  __syncthreads();
#undef SLOAD
#undef SWRITE
#undef RESC
}
}

__device__ __forceinline__ void phase_attn(const Args& a, bool withctx, LAS unsigned char* lds, int tid, int vcu, int G) {
    const bf16* QB = (const bf16*)(a.ws + WS_QB); const bf16* KN = (const bf16*)(a.ws + WS_KN); const bf16* KR = (const bf16*)(a.ws + WS_KR); const bf16* VB = (const bf16*)(a.ws + WS_VB);
    bf16* AO = (bf16*)(a.ws + WS_AO);
    const int nunits = 1024 + (withctx ? 64 : 0);
    for (int u = vcu; u < nunits; u += G) {
        int b, h, qrow0, krow0, seq;
        if (u < 1024) { const int bh = u >> 4, qb = u & 15; b = bh >> 4; h = bh & 15; qrow0 = b * TPB + qb * 256; krow0 = b * TPB; seq = TPB; }
        else { const int v = u - 1024; b = v >> 4; h = v & 15; qrow0 = b * TPB + SEQ; krow0 = b * TPB + SEQ; seq = CTXL; }
        att::attn_body(QB + (size_t)qrow0 * 3072 + h * 192, KN + (size_t)krow0 * 2048 + h * 128, KR + (size_t)krow0 * 64, VB + (size_t)krow0 * 2048 + h * 128,
                       AO + (size_t)qrow0 * 2048 + h * 128, seq, lds, tid);
    }
}

constexpr int PH_PER_LAYER = 10, PH_TOTAL = 2 + DEPTH * PH_PER_LAYER;
#ifndef MK_LAUNCH_PER_PHASE
#define MK_LAUNCH_PER_PHASE 0
#endif

__global__ void __launch_bounds__(NWAVES * 64, 2) fwd(Args a) {
    extern __shared__ __attribute__((aligned(16))) unsigned char lds_raw[];
    LAS unsigned char* lds = (LAS unsigned char*)lds_raw;
    const int tid = threadIdx.x, lane = tid & 63, wave = __builtin_amdgcn_readfirstlane(tid >> 6);
    const int G = gridDim.x; const int bx = blockIdx.x; const int vcu = (G % 8 == 0) ? (bx % 8) * (G / 8) + bx / 8 : bx;
    volatile LAS unsigned* MISC = (volatile LAS unsigned*)(lds + MISC_OFF);
    for (int u = tid; u < (LDS_BYTES - LDSCTL_OFF) / 4; u += NWAVES * 64) ((LAS unsigned*)(lds + LDSCTL_OFF))[u] = 0u;
    __syncthreads();
    const int lo = a.ph_lo, hi = a.ph_hi; const bool use_bar = (hi - lo) > 1;
    XcdBarrier bar; bar.bar = (unsigned*)(a.ws + WS_CTL) + CW_BAR; bar.x = 0; bar.st = MISC + 8;
    if (use_bar) bar = xcd_barrier_post((unsigned*)(a.ws + WS_CTL) + CW_BAR, MISC + 8);
#ifndef DBLMASK
#define DBLMASK 0u
#endif
#define REP(k) (((DBLMASK >> (k)) & 1) ? 2 : 1)
#ifndef PHMASK
#define PHMASK 0xFFFFFFFFu
#endif
#define IN(k) (lo <= (k) && (k) < hi)
#define SEAM(k) do { if ((k) + 1 < hi) xcd_barrier(bar, wave); } while (0)
#define U ((const bf16*)(ws + WS_U))
#define Y ((bf16*)(ws + WS_Y))
#define FRESH_TID() int lane_l; asm volatile("v_mbcnt_lo_u32_b32 %0, -1, 0\n\tv_mbcnt_hi_u32_b32 %0, -1, %0" : "=v"(lane_l));     const int wave_l = wave, tid_l = (wave << 6) | lane_l; (void)tid_l; (void)wave_l; size_t wz_ = 0; asm volatile("" : "+s"(wz_)); Args al = a; al.ws = a.ws + wz_; unsigned char* ws = al.ws; (void)ws;     int bxl = bx, vcul = vcu; asm volatile("" : "+s"(bxl), "+s"(vcul)); (void)bxl; (void)vcul

#define TAIL(cur_, fi_, cnt_) do { if (G == 256 && bxl >= (fi_)) convert_deferred(al, (LAS float*)(lds + wave_l * 16384), lane_l, (cur_) + (bxl - (fi_)) * NWAVES + wave_l, (G - (fi_)) * NWAVES, (cnt_)); } while (0)
    constexpr int TC_A = 8, TC_WIN = 12, TC_WOUT = 8, TC_DQKV = 12;
    constexpr int SZ_A = 128 * 8 * TC_A, SZ_WIN = 80 * 8 * TC_WIN, SZ_WOUT = 128 * 8 * TC_WOUT, SZ_DQKV = 172 * 8 * TC_DQKV;
    constexpr int TS_QKV0 = 0, TS_GATE0 = TS_QKV0 + SZ_A, TS_WIN0 = TS_GATE0 + SZ_A, TS_WOUT0 = TS_WIN0 + SZ_WIN, TS_DQKV = TS_WOUT0 + SZ_WOUT, TS_WIN1 = TS_DQKV + SZ_DQKV, TS_WOUT1 = TS_WIN1 + SZ_WIN,
                  TS_QKV2 = TS_WOUT1 + SZ_WOUT, TS_GATE2 = TS_QKV2 + SZ_A, TS_WIN2 = TS_GATE2 + SZ_A, TS_WOUT2 = TS_WIN2 + SZ_WIN, TS_END = TS_WOUT2 + SZ_WOUT;
    static_assert(TS_DQKV >= DEF_DL0 && TS_QKV2 >= DEF_DL1 && TS_END >= DEF_DL2, "the tail slots of layers 0 / 0-1 / 0-2 must cover what layers 1 / 2 / 3 need");

    if (((PHMASK >> 0) & 1) && IN(0)) { for (int rep = 0; rep < REP(0); ++rep) { FRESH_TID(); phase_pro_a(al, lds, tid_l, lane_l, wave_l, vcul, G); __syncthreads(); } SEAM(0); }
    if (((PHMASK >> 1) & 1) && IN(1)) { FRESH_TID(); phase_pro_b(al, lane_l, wave_l, vcul, G); SEAM(1); }

    for (int layer = 0; layer < DEPTH; ++layer) {
        const int pb = 2 + layer * PH_PER_LAYER; const int j = layer >> 1; const bool last = (layer == DEPTH - 1);
        if ((layer & 1) == 0) {
            if (((PHMASK >> 2) & 1) && IN(pb + 0)) { FRESH_TID();
                pg8::Gemm g{U, (const bf16*)(ws + WS_WQKV) + (size_t)j * 8192 * 2048, M, 8192, 2048}; pg8::TileOrder S; S.init(NTM, 32, G, bxl, 0, 0, 32);
                EpiQKV E{(bf16*)(ws + WS_RQ), (bf16*)(ws + WS_RK), (bf16*)(ws + WS_RV), (const float*)(ws + WS_RCS)};
                for (int rep = 0; rep < REP(2); ++rep) { pg8::gemm_phase<EpiQKV, pg8::TileOrder, true, true>(lds, g, S, E, tid_l); __syncthreads(); } if (layer == 0) TAIL(TS_QKV0, 128, TC_A); else TAIL(TS_QKV2, 128, TC_A); SEAM(pb + 0); }
            if (((PHMASK >> 3) & 1) && IN(pb + 1)) { for (int rep = 0; rep < REP(3); ++rep) { FRESH_TID(); phase_ret_scan(al, j, lds, tid_l, lane_l, wave_l, vcul, G); __syncthreads(); } SEAM(pb + 1); }
            if (((PHMASK >> 4) & 1) && IN(pb + 2)) { FRESH_TID();
                pg8::Gemm g{U, (const bf16*)(ws + WS_WG) + (size_t)j * 8192 * 2048, M, 8192, 2048}; pg8::TileOrder S; S.init(NTM, 32, G, bxl, 0, 0, 32);
                EpiGate E{(const bf16*)(ws + WS_OF), (const bf16*)(ws + WS_OB), (const float*)(ws + WS_PART), (bf16*)(ws + WS_YG)};
                for (int rep = 0; rep < REP(4); ++rep) { pg8::gemm_phase<EpiGate, pg8::TileOrder, true, true>(lds, g, S, E, tid_l); __syncthreads(); } if (layer == 0) TAIL(TS_GATE0, 128, TC_A); else TAIL(TS_GATE2, 128, TC_A); SEAM(pb + 2); }
            if (((PHMASK >> 5) & 1) && IN(pb + 3)) { FRESH_TID();
                pg8::Gemm g{(const bf16*)(ws + WS_YG), (const bf16*)(ws + WS_WOR) + (size_t)j * 2048 * 4096, M, 2048, 4096}; pg8::TileOrder S; S.init(NTL, 8, G, bxl, 1, KSPLIT, 64);
                EpiBf E{Y, Y, 2048, 0, (float*)(ws + WS_YP)};
                for (int rep = 0; rep < REP(5); ++rep) { pg8::gemm_phase<EpiBf, pg8::TileOrder, true, true>(lds, g, S, E, tid_l); __syncthreads(); } SEAM(pb + 3); }
        } else {
            if (((PHMASK >> 6) & 1) && IN(pb + 0)) { FRESH_TID();
                pg8::Gemm g{U, (const bf16*)(ws + WS_WD) + (size_t)j * 1280 * 2048, M, 1280, 2048}; pg8::TileOrder S; S.init(NTM, 5, G, bxl, 0, 0, 32);
                EpiDQKV E{(bf16*)(ws + WS_CQN), (bf16*)(ws + WS_CKVN), (bf16*)(ws + WS_KR), (float*)(ws + WS_SSQ), (const float*)(ws + WS_ACS)};
                for (int rep = 0; rep < REP(6); ++rep) { pg8::gemm_phase<EpiDQKV, pg8::TileOrder, true, true>(lds, g, S, E, tid_l); __syncthreads(); } if (layer == 1) TAIL(TS_DQKV, 84, TC_DQKV); SEAM(pb + 0); }
            if (((PHMASK >> 8) & 1) && IN(pb + 2)) { FRESH_TID();
                { pg8::Gemm g{(const bf16*)(ws + WS_CQN), (const bf16*)(ws + WS_WUQ) + (size_t)j * 3072 * 512, M, 3072, 512}; pg8::TileOrder S; S.init(last ? NTL : NTM, 12, G, bxl, last ? 1 : 0, 0, 8);
                  EpiUQ E{(bf16*)(ws + WS_QB), (const float*)(ws + WS_ACS), (const float*)(ws + WS_SSQ)};
                  for (int rep = 0; rep < REP(8); ++rep) { pg8::gemm_phase<EpiUQ, pg8::TileOrder, true, true>(lds, g, S, E, tid_l); __syncthreads(); } }
                __syncthreads();
                { pg8::Gemm g{(const bf16*)(ws + WS_CKVN), (const bf16*)(ws + WS_WUKV) + (size_t)j * 4096 * 512, M, 4096, 512}; pg8::TileOrder S; S.init(NTM, 16, G, bxl, 0, 0, 8);
                  EpiUKV E{(bf16*)(ws + WS_KN), (bf16*)(ws + WS_VB), (const float*)(ws + WS_SSQ)};
                  for (int rep = 0; rep < REP(8); ++rep) { pg8::gemm_phase<EpiUKV, pg8::TileOrder, true, true>(lds, g, S, E, tid_l); __syncthreads(); } }
                SEAM(pb + 2); }
            if (((PHMASK >> 9) & 1) && IN(pb + 3)) { FRESH_TID(); for (int rep = 0; rep < REP(9); ++rep) phase_attn(al, !last, lds, tid_l, vcul, G); SEAM(pb + 3); }
            if (((PHMASK >> 10) & 1) && IN(pb + 4)) { FRESH_TID();
                pg8::Gemm g{(const bf16*)(ws + WS_AO), (const bf16*)(ws + WS_WOM) + (size_t)j * 2048 * 2048, M, 2048, 2048}; pg8::TileOrder S; S.init(NTL, 8, G, bxl, 1, last ? 0 : KSPLIT, 32);
                EpiBf E{Y, Y, 2048, 0, (float*)(ws + WS_YP)};
                for (int rep = 0; rep < REP(10); ++rep) { pg8::gemm_phase<EpiBf, pg8::TileOrder, true, true>(lds, g, S, E, tid_l); __syncthreads(); } SEAM(pb + 4); }
        }
        if (((PHMASK >> 11) & 1) && IN(pb + 5)) { if (REP(11) > 1) { FRESH_TID(); phase_ln(al, layer, 0, lds, tid_l, lane_l, wave_l, vcul, G, true); } FRESH_TID(); phase_ln(al, layer, 0, lds, tid_l, lane_l, wave_l, vcul, G); SEAM(pb + 5); }
        if (((PHMASK >> 12) & 1) && IN(pb + 6)) { FRESH_TID();
            pg8::Gemm g{U, (const bf16*)(ws + WS_WIN) + (size_t)layer * 11264 * 2048, M, 11264, 2048}; pg8::TileOrder S; S.init(last ? NTL : NTM, 44, G, bxl, last ? 1 : 0, 0, 32);
            EpiSwiglu E{(bf16*)(ws + WS_HID)};
#if defined(SPLIT_WIN_PROBE)
            { pg8::TileOrder S1 = S; S1.ilim = 6; pg8::gemm_phase<EpiSwiglu, pg8::TileOrder, true, true>(lds, g, S1, E, tid_l); __syncthreads(); xcd_barrier(bar, wave);
              pg8::TileOrder S2 = S; S2.ioff = 6; pg8::gemm_phase<EpiSwiglu, pg8::TileOrder, true, true>(lds, g, S2, E, tid_l); __syncthreads(); } SEAM(pb + 6); }
#else
            for (int rep = 0; rep < REP(12); ++rep) { pg8::gemm_phase<EpiSwiglu, pg8::TileOrder, true, true>(lds, g, S, E, tid_l); __syncthreads(); } if (layer < 3) TAIL(layer == 0 ? TS_WIN0 : layer == 1 ? TS_WIN1 : TS_WIN2, 176, TC_WIN); SEAM(pb + 6); }
#endif
        if (((PHMASK >> 13) & 1) && IN(pb + 7)) { FRESH_TID();
            pg8::Gemm g{(const bf16*)(ws + WS_HID), (const bf16*)(ws + WS_WOUT) + (size_t)layer * 2048 * 5632, M, 2048, 5632}; pg8::TileOrder S; S.init(NTL, 8, G, bxl, 1, last ? 0 : KSPLIT, 88);
            EpiBf E{Y, Y, 2048, 0, (float*)(ws + WS_YP)};
            for (int rep = 0; rep < REP(13); ++rep) { pg8::gemm_phase<EpiBf, pg8::TileOrder, true, true>(lds, g, S, E, tid_l); __syncthreads(); } if (layer < 3) TAIL(layer == 0 ? TS_WOUT0 : layer == 1 ? TS_WOUT1 : TS_WOUT2, 128, TC_WOUT); SEAM(pb + 7); }
        if (((PHMASK >> 14) & 1) && IN(pb + 8) && layer < 3 && G != 256) { FRESH_TID();
            const int c0 = layer == 0 ? 0 : layer == 1 ? DEF_DL0 : DEF_DL1, c1 = layer == 0 ? DEF_DL0 : layer == 1 ? DEF_DL1 : DEF_DL2; const int NGW = G * NWAVES;
            convert_deferred(al, (LAS float*)(lds + wave_l * 16384), lane_l, c0 + vcul * NWAVES + wave_l, NGW, ((c1 - c0 + NGW - 1) / NGW + 3) & ~3, c1); __syncthreads(); }
        if (((PHMASK >> 14) & 1) && IN(pb + 8)) { if (REP(11) > 1) { FRESH_TID(); phase_ln(al, layer, 1, lds, tid_l, lane_l, wave_l, vcul, G, true); } FRESH_TID(); phase_ln(al, layer, 1, lds, tid_l, lane_l, wave_l, vcul, G); SEAM(pb + 8); }
    }
#undef IN
#undef SEAM
#undef U
#undef Y
}

extern "C" void kernel_launch(void* const* d_in, const int* in_sizes, int n_in, void* d_out, int out_size, void* d_ws, size_t ws_size, hipStream_t stream) {
    static int grid = 0;
    if (grid == 0) {
        if (n_in != 21 || ws_size < WS_END) { fprintf(stderr, "kernel_launch: need 21 inputs and %zu bytes of workspace; got %d, %zu\n", (size_t)WS_END, n_in, ws_size); grid = -1; return; }
        int dev = 0, cus = 0, per_cu = 0;
        if (hipGetDevice(&dev) != hipSuccess || hipDeviceGetAttribute(&cus, hipDeviceAttributeMultiprocessorCount, dev) != hipSuccess) { grid = -1; return; }
        if (hipFuncSetAttribute((const void*)fwd, hipFuncAttributeMaxDynamicSharedMemorySize, LDS_BYTES) != hipSuccess) { fprintf(stderr, "kernel_launch: hipFuncSetAttribute failed\n"); grid = -1; return; }
        if (hipOccupancyMaxActiveBlocksPerMultiprocessor(&per_cu, (const void*)fwd, NWAVES * 64, LDS_BYTES) != hipSuccess || per_cu < 1)
            fprintf(stderr, "kernel_launch: occupancy query reports %d workgroups per CU\n", per_cu);
        (void)hipGetLastError();
        grid = cus;
    }
    if (grid < 0) return;
    if (hipMemsetAsync((char*)d_ws + WS_CTL, 0, CTL_ZERO_BYTES, stream) != hipSuccess) return;
    Args a{};
    for (int i = 0; i < 21; ++i) a.in[i] = (const float*)d_in[i];
    a.out = (float*)d_out; a.ws = (unsigned char*)d_ws;
#if MK_LAUNCH_PER_PHASE
    for (int p = 0; p < PH_TOTAL; ++p) {
        const int pl = (p - 2) % PH_PER_LAYER, layer = (p - 2) / PH_PER_LAYER;
        if (p >= 2 && (pl == 9 || (pl == 4 && (layer & 1) == 0))) continue;
        a.ph_lo = p; a.ph_hi = p + 1;
        hipLaunchKernelGGL(fwd, dim3(grid), dim3(NWAVES * 64), LDS_BYTES, stream, a);
    }
#else
    a.ph_lo = 0; a.ph_hi = PH_TOTAL;
    hipLaunchKernelGGL(fwd, dim3(grid), dim3(NWAVES * 64), LDS_BYTES, stream, a);
#endif
    const hipError_t le = hipPeekAtLastError();
    if (le != hipSuccess) fprintf(stderr, "kernel_launch: launch failed: %s\n", hipGetErrorName(le));
}
```

```cpp
#include <hip/hip_runtime.h>
#include <cstdio>
#include <cstdint>
#define MK_LAUNCH_PER_PHASE 0
namespace pg8 {
#define PG8_LAS __attribute__((address_space(3)))
typedef unsigned short bf16_t;
typedef short bf16x8 __attribute__((ext_vector_type(8)));
typedef float f32x4 __attribute__((ext_vector_type(4)));
typedef unsigned u32x4 __attribute__((ext_vector_type(4)));
constexpr int BM = 256, BK = 64, HALF = 128, HTB = HALF * BK * 2  , STAGE_BYTES = 8 * HTB, NXCD = 8, WGM = 8;

__host__ __device__ __forceinline__ int lds_byte(int r, int c) { const int st = (r >> 4) * 2 + (c >> 5), rr = r & 15, cc = c & 31, ob = rr * 64 + cc * 2; return st * 1024 + (ob ^ (((ob >> 9) & 1) << 5)); }
__host__ __device__ __forceinline__ void stage_rc(int b, int& R, int& C) { const int st = b / 1024, sb = b % 1024, swz = sb ^ (((sb >> 9) & 1) << 5); R = (st >> 1) * 16 + swz / 64; C = (st & 1) * 32 + (swz % 64) / 2; }
__host__ __device__ __forceinline__ int perm32(int rho) { const int n = rho >> 4, i = rho & 15; return 8 * (i >> 2) + 4 * n + (i & 3); }

struct Unit { int pm, pn, k0, nt, ks; };
struct Gemm { const bf16_t* A; const bf16_t* Bt; int M, N, K; };

struct StaticOrder {
    int nM, nN, nwg, G, c;
    __host__ __device__ void init(int M, int N, int G_, int c_) { nM = M / BM; nN = N / BM; nwg = nM * nN; G = G_; c = c_; }
    __host__ __device__ bool next(int i, Unit& u) const {
        const long L = (long)i * G + c; if (L >= nwg) return false;
        int wgid = (int)L; { const int q = nwg / NXCD, r = nwg % NXCD, xcd = wgid % NXCD, off = wgid / NXCD; wgid = (xcd < r ? xcd * (q + 1) : r * (q + 1) + (xcd - r) * q) + off; }
        const int nig = WGM * nN, gid = wgid / nig, fm = gid * WGM, gsz = (nM - fm) < WGM ? (nM - fm) : WGM;
        u.pm = fm + ((wgid % nig) % gsz); u.pn = (wgid % nig) / gsz; return true;
    }
    __device__ __forceinline__ void a_ready(const Unit&) const {}
    __device__ __forceinline__ void done(const Unit&) const {}
};

__device__ __forceinline__ unsigned cvt_pk_bf16(float lo, float hi) { unsigned r; asm volatile("v_cvt_pk_bf16_f32 %0, %1, %2" : "=v"(r) : "v"(lo), "v"(hi)); return r; }
struct TileOrder {
    int nM, nN, nmain, nwg, G, c, lat, split, kt, ioff = 0, ilim = 1 << 30;
    __host__ __device__ void init(int nM_, int nN_, int G_, int c_, int lat_, int split_, int kt_) { nM = nM_; nN = nN_; nmain = nM * nN; G = G_; c = c_; lat = lat_; split = split_; kt = kt_; nwg = nmain + 4 * nN * split; }
    __host__ __device__ __forceinline__ bool next(int i, Unit& u) const {
        if (i + ioff >= ilim) return false;
        const long L = (long)(i + ioff) * G + c; if (L >= nwg) return false;
        const bool sp = L >= nmain;
        const int e = (int)L - nmain, sdiv = split > 0 ? split : 1, tile = e / sdiv, sl = e - tile * sdiv, snt = kt / sdiv;
        int wgid = sp ? 0 : (int)L; { const int q = nmain / NXCD, r = nmain % NXCD, xcd = wgid % NXCD, off = wgid / NXCD; wgid = (xcd < r ? xcd * (q + 1) : r * (q + 1) + (xcd - r) * q) + off; }
        const int nig = WGM * nN, gid = wgid / nig, fm = gid * WGM, gsz = (nM - fm) < WGM ? (nM - fm) : WGM;
        int pm = fm + ((wgid % nig) % gsz); const int pn = (wgid % nig) / gsz; if (lat) pm += pm >> 4;
        Unit r; r.pm = sp ? 17 * (tile & 3) + 16 : pm; r.pn = sp ? (tile >> 2) : pn; r.k0 = sp ? sl * snt : 0; r.nt = sp ? snt : kt; r.ks = sp ? sl : -1;
        u = r; return true;
    }
    __device__ __forceinline__ void a_ready(const Unit&) const {}
    __device__ __forceinline__ void done(const Unit&) const {}
};
template <class Epi, class Sched, bool ALIGN_EPI = false, bool SP2 = false>
__device__ __forceinline__ void gemm_phase(PG8_LAS unsigned char* lds, const Gemm g, const Sched& S, const Epi& E, int tid_in) {
    int tid_ = tid_in; asm volatile("" : "+v"(tid_));
    const int tid = tid_, wid = __builtin_amdgcn_readfirstlane(tid >> 6), lane = tid & 63, wr = wid >> 2, wc = wid & 3, fr = lane & 15, fq = lane >> 4;
    const int K = g.K;
    unsigned voffA[2], voffB[2];
#pragma unroll
    for (int i = 0; i < 2; ++i) { int R, C; stage_rc(tid * 16 + i * 8192, R, C); const int Rb = Epi::PERM ? ((R & ~31) + perm32(R & 31)) : R;
        voffA[i] = (unsigned)(R * K + C) * 2u; voffB[i] = (unsigned)(Rb * K + C) * 2u; }
    const size_t kstep = (size_t)(BK * 2);
    const size_t hstep = (size_t)HALF * K * 2;
    const size_t tstep = 2 * hstep;
    const unsigned ldsw = (unsigned)wid * 1024u;
    const int aoff = lds_byte(wr * 64 + fr, fq * 8), boff = lds_byte(wc * 32 + fr, fq * 8);
#define PG8_SA(b, h) (((b) * 2 + (h)) * HTB)
#define PG8_SB(b, h) ((4 + (b) * 2 + (h)) * HTB)
#define PG8_STAGE(bufoff, gbase, voff) do { _Pragma("unroll") for (int _i = 0; _i < 2; ++_i) \
        __builtin_amdgcn_global_load_lds((const unsigned*)((const char*)(gbase) + (voff)[_i]), (PG8_LAS unsigned*)(lds + (bufoff) + ldsw + _i * 8192), 16, 0, 0); } while (0)
#define PG8_LDA(dst, b, h) do { _Pragma("unroll") for (int m = 0; m < 4; ++m) _Pragma("unroll") for (int k = 0; k < 2; ++k) dst[m][k] = *(const PG8_LAS bf16x8*)(lds + PG8_SA(b, h) + aoff + m * 2048 + k * 1024); } while (0)
#define PG8_LDB(dst, b, h) do { _Pragma("unroll") for (int n = 0; n < 2; ++n) _Pragma("unroll") for (int k = 0; k < 2; ++k) dst[n][k] = *(const PG8_LAS bf16x8*)(lds + PG8_SB(b, h) + boff + n * 2048 + k * 1024); } while (0)
#define PG8_MMA(ai, bj, At, Bt) do { __builtin_amdgcn_s_setprio(1); _Pragma("unroll") for (int m = 0; m < 4; ++m) _Pragma("unroll") for (int n = 0; n < 2; ++n) _Pragma("unroll") for (int k = 0; k < 2; ++k) \
        acc[ai][bj][m][n] = __builtin_amdgcn_mfma_f32_16x16x32_bf16(Bt[n][k], At[m][k], acc[ai][bj][m][n], 0, 0, 0); __builtin_amdgcn_s_setprio(0); } while (0)
#define PG8_WAIT_V(n) asm volatile("s_waitcnt vmcnt(" #n ")" ::: "memory")
#define PG8_WAIT_L(n) asm volatile("s_waitcnt lgkmcnt(" #n ")" ::: "memory")
#define PG8_BAR __builtin_amdgcn_s_barrier()
#define PG8_SCHED __builtin_amdgcn_sched_barrier(0)
    Unit cur, nxt; int ui = 0;
    if (!S.next(0, cur)) return;
    f32x4 acc[2][2][4][2];
#pragma unroll
    for (int a = 0; a < 2; ++a)
#pragma unroll
        for (int b = 0; b < 2; ++b)
#pragma unroll
            for (int m = 0; m < 4; ++m)
#pragma unroll
                for (int n = 0; n < 2; ++n) acc[a][b][m][n] = (f32x4){0.f, 0.f, 0.f, 0.f};
    bf16x8 At[4][2], B0[2][2], B1[2][2];
    const char* cA = (const char*)g.A + (size_t)cur.pm * tstep + (size_t)cur.k0 * kstep; const char* cB = (const char*)g.Bt + (size_t)cur.pn * tstep + (size_t)cur.k0 * kstep;
    S.a_ready(cur);
    if constexpr (SP2) {
        PG8_STAGE(PG8_SB(0, 0), cB, voffB); PG8_STAGE(PG8_SB(0, 1), cB + hstep, voffB); PG8_STAGE(PG8_SA(0, 0), cA, voffA); PG8_STAGE(PG8_SA(0, 1), cA + hstep, voffA);
        if (wr == 1) PG8_BAR;
        PG8_WAIT_V(2); PG8_BAR;
        PG8_STAGE(PG8_SB(1, 0), cB + kstep, voffB); PG8_STAGE(PG8_SA(1, 0), cA + kstep, voffA); PG8_STAGE(PG8_SB(1, 1), cB + hstep + kstep, voffB);
        PG8_WAIT_V(6); PG8_BAR;
    } else {
        PG8_STAGE(PG8_SB(0, 0), cB, voffB); PG8_STAGE(PG8_SA(0, 0), cA, voffA); PG8_STAGE(PG8_SB(0, 1), cB + hstep, voffB); PG8_STAGE(PG8_SA(0, 1), cA + hstep, voffA);
        if (wr == 1) PG8_BAR;
        PG8_WAIT_V(4); PG8_BAR;
        PG8_STAGE(PG8_SB(1, 0), cB + kstep, voffB); PG8_STAGE(PG8_SA(1, 0), cA + kstep, voffA); PG8_STAGE(PG8_SB(1, 1), cB + hstep + kstep, voffB);
        PG8_WAIT_V(6); PG8_BAR;
    }
    for (;;) {
        const bool has_next = S.next(ui + 1, nxt);
        const char* nA = has_next ? (const char*)g.A + (size_t)nxt.pm * tstep + (size_t)nxt.k0 * kstep : cA; const char* nB = has_next ? (const char*)g.Bt + (size_t)nxt.pn * tstep + (size_t)nxt.k0 * kstep : cB;
        const int nt = cur.nt;
        for (int t = 0; t < nt; t += 2) {
            const bool last = (t == nt - 2);
            const char* a1 = cA + (size_t)(t + 1) * kstep;
            const char* a2 = last ? nA : cA + (size_t)(t + 2) * kstep; const char* b2 = last ? nB : cB + (size_t)(t + 2) * kstep;
            const char* a3 = a2 + kstep; const char* b3 = b2 + kstep;
            if (last && has_next) S.a_ready(nxt);
            if constexpr (SP2) {
            PG8_LDB(B0, 0, 0); PG8_LDB(B1, 0, 1); PG8_SCHED; PG8_LDA(At, 0, 0); PG8_STAGE(PG8_SA(1, 1), a1 + hstep, voffA);
            PG8_WAIT_V(8); PG8_WAIT_L(0); PG8_BAR; PG8_MMA(0, 0, At, B0); PG8_MMA(0, 1, At, B1); PG8_BAR; PG8_SCHED;
            PG8_LDA(At, 0, 1); PG8_STAGE(PG8_SB(0, 0), b2, voffB); PG8_STAGE(PG8_SB(0, 1), b2 + hstep, voffB); PG8_STAGE(PG8_SA(0, 0), a2, voffA);
            PG8_WAIT_V(8); PG8_WAIT_L(0); PG8_BAR; PG8_MMA(1, 0, At, B0); PG8_MMA(1, 1, At, B1); PG8_BAR; PG8_SCHED;
            PG8_LDB(B0, 1, 0); PG8_LDB(B1, 1, 1); PG8_SCHED; PG8_LDA(At, 1, 0); PG8_STAGE(PG8_SA(0, 1), a2 + hstep, voffA);
            PG8_WAIT_V(8); PG8_WAIT_L(0); PG8_BAR; PG8_MMA(0, 0, At, B0); PG8_MMA(0, 1, At, B1); PG8_BAR; PG8_SCHED;
            PG8_LDA(At, 1, 1); PG8_STAGE(PG8_SB(1, 0), b3, voffB); PG8_STAGE(PG8_SB(1, 1), b3 + hstep, voffB); PG8_STAGE(PG8_SA(1, 0), a3, voffA);
            PG8_WAIT_V(8); PG8_WAIT_L(0); PG8_BAR; PG8_MMA(1, 0, At, B0); PG8_MMA(1, 1, At, B1); PG8_BAR; PG8_SCHED;
            } else {
            PG8_LDB(B0, 0, 0); PG8_SCHED; PG8_LDA(At, 0, 0); PG8_STAGE(PG8_SA(1, 1), a1 + hstep, voffA);
            PG8_WAIT_L(8); PG8_BAR; PG8_WAIT_L(0); PG8_MMA(0, 0, At, B0); PG8_BAR; PG8_SCHED;
            PG8_LDB(B1, 0, 1); PG8_STAGE(PG8_SB(0, 0), b2, voffB);
            PG8_BAR; PG8_WAIT_L(0); PG8_MMA(0, 1, At, B1); PG8_BAR;
            PG8_LDA(At, 0, 1); PG8_STAGE(PG8_SA(0, 0), a2, voffA);
            PG8_BAR; PG8_WAIT_L(0); PG8_MMA(1, 0, At, B0); PG8_BAR; PG8_SCHED;
            PG8_STAGE(PG8_SB(0, 1), b2 + hstep, voffB);
            PG8_WAIT_V(6); PG8_BAR; PG8_MMA(1, 1, At, B1); PG8_BAR;
            PG8_LDB(B0, 1, 0); PG8_SCHED; PG8_LDA(At, 1, 0); PG8_STAGE(PG8_SA(0, 1), a2 + hstep, voffA);
            PG8_WAIT_L(8); PG8_BAR; PG8_WAIT_L(0); PG8_MMA(0, 0, At, B0); PG8_BAR; PG8_SCHED;
            PG8_LDB(B1, 1, 1); PG8_STAGE(PG8_SB(1, 0), b3, voffB);
            PG8_BAR; PG8_WAIT_L(0); PG8_MMA(0, 1, At, B1); PG8_BAR;
            PG8_LDA(At, 1, 1); PG8_STAGE(PG8_SA(1, 0), a3, voffA);
            PG8_BAR; PG8_WAIT_L(0); PG8_MMA(1, 0, At, B0); PG8_BAR; PG8_SCHED;
            PG8_STAGE(PG8_SB(1, 1), b3 + hstep, voffB);
            PG8_WAIT_V(6); PG8_BAR; PG8_MMA(1, 1, At, B1); PG8_BAR;
            }
        }
        if constexpr (ALIGN_EPI) { if (wr == 0) PG8_BAR; }
        asm volatile("s_nop 15\n\ts_nop 15" ::: "memory");
        if constexpr (!Epi::AFTER_DRAIN) { E(acc, cur, wr, wc, fr, fq); S.done(cur); }
        if (!has_next) break;
#pragma unroll
        for (int a = 0; a < 2; ++a)
#pragma unroll
            for (int b = 0; b < 2; ++b)
#pragma unroll
                for (int m = 0; m < 4; ++m)
#pragma unroll
                    for (int n = 0; n < 2; ++n) acc[a][b][m][n] = (f32x4){0.f, 0.f, 0.f, 0.f};
        cur = nxt; cA = nA; cB = nB; ++ui;
        if constexpr (ALIGN_EPI) { if (wr == 1) PG8_BAR; }
    }
    PG8_WAIT_V(0);
    if constexpr (!ALIGN_EPI) { if (wr == 0) PG8_BAR; }
    PG8_BAR;
    if constexpr (Epi::AFTER_DRAIN) { E.fused(acc, cur, wr, wc, fr, fq, lds, wid, lane); S.done(cur); }
#undef PG8_SA
#undef PG8_SB
#undef PG8_STAGE
#undef PG8_LDA
#undef PG8_LDB
#undef PG8_MMA
#undef PG8_WAIT_V
#undef PG8_WAIT_L
#undef PG8_BAR
#undef PG8_SCHED
}
}

constexpr int D = 2048, BATCH = 4, SEQ = 4096, CTXL = 256, DEPTH = 4, FF = 5632;
constexpr int TPB = SEQ + CTXL;
constexpr int M = BATCH * TPB;
constexpr int NTM = M / 256;
constexpr int NTL = BATCH * SEQ / 256;
constexpr float ALPHA = 1.6817928305074290f;
constexpr float LN_EPS = 1e-5f, GN_EPS = 1e-6f, RMS_EPS = 1e-6f;
constexpr float MLA_SCALE = 0.07216878364870322f;
constexpr int NWAVES = 8;

constexpr size_t MiB = 1u << 20;
constexpr size_t WS_CTL = 0, CTL_ZERO_BYTES = 64 * 1024;
constexpr size_t WS_MOD = 1 * MiB;
constexpr size_t WS_RCS = 2 * MiB;
constexpr size_t WS_ACS = 6 * MiB;
constexpr size_t WS_WQKV = 8 * MiB;
constexpr size_t WS_WG = 72 * MiB;
constexpr size_t WS_WOR = 136 * MiB;
constexpr size_t WS_WD = 168 * MiB;
constexpr size_t WS_WUQ = 178 * MiB;
constexpr size_t WS_WUKV = 184 * MiB;
constexpr size_t WS_WOM = 192 * MiB;
constexpr size_t WS_WIN = 208 * MiB;
constexpr size_t WS_WOUT = 384 * MiB;
constexpr size_t WS_H = 472 * MiB;
constexpr size_t WS_U = 608 * MiB;
constexpr size_t WS_Y = 676 * MiB;
constexpr size_t WS_S = 744 * MiB;
constexpr size_t WS_RQ = WS_S, WS_RK = WS_S + 68 * MiB, WS_RV = WS_S + 136 * MiB, WS_OF = WS_S + 272 * MiB, WS_OB = WS_S + 408 * MiB, WS_PART = WS_S + 544 * MiB;
constexpr size_t WS_YG = WS_S;
constexpr size_t WS_SSQ = WS_S  , WS_CQKV = WS_S, WS_CQN = WS_S + 85 * MiB, WS_CKVN = WS_S + 102 * MiB, WS_KR = WS_S + 119 * MiB, WS_QB = WS_S + 122 * MiB,
                 WS_KN = WS_S + 224 * MiB, WS_VB = WS_S + 292 * MiB, WS_AO = WS_S + 360 * MiB;
constexpr size_t WS_HID = WS_S;
constexpr size_t WS_YP = 1297 * MiB;
constexpr size_t WS_END = 1329 * MiB;
constexpr int KSPLIT = 4;

constexpr int CW_BAR = 4096;

constexpr int RING_BYTES = 131072;
constexpr int LDSCTL_OFF = RING_BYTES, MISC_OFF = LDSCTL_OFF + 320;
constexpr int LDS_BYTES = 147456;

#define GAS __attribute__((address_space(1)))
#define LAS __attribute__((address_space(3)))
typedef unsigned short bf16;
typedef unsigned v4u __attribute__((ext_vector_type(4)));
typedef unsigned v2u __attribute__((ext_vector_type(2)));
typedef float f32x4 __attribute__((ext_vector_type(4)));
typedef float f32x2 __attribute__((ext_vector_type(2)));
typedef float f32x16 __attribute__((ext_vector_type(16)));
typedef short bf16x8 __attribute__((ext_vector_type(8)));
typedef short s16x4 __attribute__((ext_vector_type(4)));
typedef _Float16 h16;
typedef _Float16 h16x4 __attribute__((ext_vector_type(4)));
#define LDS_WAIT() asm volatile("s_waitcnt lgkmcnt(0)" ::: "memory")
#define VM_WAIT() asm volatile("s_waitcnt vmcnt(0)" ::: "memory")
#define SBAR() __builtin_amdgcn_sched_barrier(0)
using pg8::cvt_pk_bf16;
__device__ __forceinline__ float bf2f(unsigned short b) { return __uint_as_float(((unsigned)b) << 16); }
__device__ __forceinline__ float bflo(unsigned w) { return __uint_as_float(w << 16); }
__device__ __forceinline__ float bfhi(unsigned w) { return __uint_as_float(w & 0xffff0000u); }
__device__ __forceinline__ float silu_f(float x) { return x * __builtin_amdgcn_rcpf(1.0f + __expf(-x)); }

#define XB_TMO      128
#define XB_XCNT(j)  (256  + 64 * (j))
#define XB_XSUB(j)  (1280 + 64 * (j))
#define XB_XGEN(j)  (2304 + 64 * (j))
#define XB_TOP      3328
#define XB_TOPGEN   3392
#define XCD_BAR_WORDS 3456
#define XB_SPIN_CAP (1u << 20)

__device__ __forceinline__ unsigned xb_ld(unsigned* p)              { return __hip_atomic_load(p, __ATOMIC_RELAXED, __HIP_MEMORY_SCOPE_AGENT); }
__device__ __forceinline__ unsigned xb_add(unsigned* p, unsigned v) { return __hip_atomic_fetch_add(p, v, __ATOMIC_RELAXED, __HIP_MEMORY_SCOPE_AGENT); }
__device__ __forceinline__ unsigned xb_xcc_id() { return (unsigned)__builtin_amdgcn_s_getreg((3 << 11) | 20) & 0xFu; }
#define XB_SPIN(cond, bar) do { unsigned _sp = 0; while (cond) { __builtin_amdgcn_s_sleep(1); \
    if ((++_sp & 255u) == 0u) { if (xb_ld(&(bar)[XB_TMO])) break; if (_sp > XB_SPIN_CAP) { atomicAdd(&(bar)[XB_TMO], 1u); break; } } } } while (0)

struct XcdBarrier { unsigned* bar; unsigned x; volatile LAS unsigned* st; };
__device__ __forceinline__ XcdBarrier xcd_barrier_post(unsigned* bar, volatile LAS unsigned* st) {
    XcdBarrier b; b.bar = bar; b.x = xb_xcc_id(); b.st = st;
    if (threadIdx.x == 0) (void)xb_add(&bar[XB_XCNT(b.x)], 1u);
    return b;
}
__device__ __forceinline__ void xcd_barrier_complete(unsigned* bar, unsigned x, unsigned& nloc, unsigned& nx) {
    const unsigned G = gridDim.x * gridDim.y * gridDim.z;
    unsigned sum, cnt, mine, sp = 0u;
    for (;;) {
        sum = 0u; cnt = 0u; mine = 0u;
#pragma unroll
        for (unsigned j = 0; j < 16; ++j) { const unsigned c = xb_ld(&bar[XB_XCNT(j)]); sum += c; cnt += (c > 0u) ? 1u : 0u; mine = (j == x) ? c : mine; }
        if (sum == G) break;
        __builtin_amdgcn_s_sleep(1);
        if ((++sp & 255u) == 0u) { if (xb_ld(&bar[XB_TMO])) break; if (sp > XB_SPIN_CAP) { atomicAdd(&bar[XB_TMO], 1u); break; } }
    }
    nloc = mine > 0u ? mine : 1u; nx = cnt > 0u ? cnt : 1u;
}
__device__ __forceinline__ void xcd_barrier(const XcdBarrier& b, int wave) {
    asm volatile("s_waitcnt vmcnt(0)" ::: "memory");
    __syncthreads();
    int l_; asm volatile("v_mbcnt_lo_u32_b32 %0, -1, 0\n\tv_mbcnt_hi_u32_b32 %0, -1, %0" : "=v"(l_));
    if (l_ == 0 && wave == 0) {
        unsigned* bar = b.bar;
        __builtin_amdgcn_s_waitcnt(0);
        unsigned nloc = b.st[0], nx = b.st[1];
        if (nloc == 0u) { xcd_barrier_complete(bar, b.x, nloc, nx); b.st[0] = nloc; b.st[1] = nx; }
        const unsigned old = xb_add(&bar[XB_XSUB(b.x)], 1u);
        const unsigned gen = old / nloc;
        if (old + 1u == (gen + 1u) * nloc) {
            __builtin_amdgcn_fence(__ATOMIC_RELEASE, "agent");
            asm volatile("s_waitcnt vmcnt(0)" ::: "memory");
            const unsigned og = xb_add(&bar[XB_TOP], 1u);
            const unsigned tg = og / nx;
            if (og + 1u == (tg + 1u) * nx) xb_add(&bar[XB_TOPGEN], 1u);
            else XB_SPIN(xb_ld(&bar[XB_TOPGEN]) == tg, bar);
            __builtin_amdgcn_fence(__ATOMIC_ACQUIRE, "agent");
            xb_add(&bar[XB_XGEN(b.x)], 1u);
            asm volatile("s_waitcnt vmcnt(0)" ::: "memory");
        } else {
            XB_SPIN(xb_ld(&bar[XB_XGEN(b.x)]) == gen, bar);
            __builtin_amdgcn_fence(__ATOMIC_ACQUIRE, "agent");
            asm volatile("s_waitcnt vmcnt(0)" ::: "memory");
        }
    }
    __syncthreads();
}

__device__ __forceinline__ float shx(float v, int mask, int lane) { return __int_as_float(__builtin_amdgcn_ds_bpermute((lane ^ mask) << 2, __float_as_int(v))); }
__device__ __forceinline__ float wave_sum(float v, int lane) {
#pragma unroll
    for (int o = 1; o < 64; o <<= 1) v += shx(v, o, lane);
    return v;
}

typedef const pg8::f32x4 (&AccRef)[2][2][4][2];

struct EpiQKV {
    static constexpr bool PERM = true, AFTER_DRAIN = false;
    bf16 *Q, *K, *V; const float* cs;
    __device__ __forceinline__ void operator()(AccRef acc, const pg8::Unit& u, int wr, int wc, int fr, int fq) const {
        const int pn = u.pn, row0 = u.pm * 256 + wr * 64 + fr, tj = u.pm % 17; const bool isctx = (tj == 16); const int t0 = tj * 256 + wr * 64 + fr;
        if (pn < 16) {
            bf16* dst = (pn < 8) ? Q : K; const float sc = (pn < 8) ? 1.0f : 0.0625f; const int hc = (pn & 7) * 256 + wc * 32 + 8 * fq;
#pragma unroll
            for (int ai = 0; ai < 2; ++ai)
#pragma unroll
                for (int m = 0; m < 4; ++m) { const int r = row0 + ai * 128 + m * 16, t = t0 + ai * 128 + m * 16;
#pragma unroll
                    for (int bj = 0; bj < 2; ++bj) { f32x4 v0 = acc[ai][bj][m][0], v1 = acc[ai][bj][m][1];
                        if (!isctx) { const f32x4* cp = (const f32x4*)(cs + ((size_t)t * 128 + bj * 64 + wc * 16 + 4 * fq) * 2); const f32x4 c0 = cp[0], c1 = cp[1];
                            v0 = (f32x4){v0[0] * c0[0] - v0[1] * c0[1], v0[0] * c0[1] + v0[1] * c0[0], v0[2] * c0[2] - v0[3] * c0[3], v0[2] * c0[3] + v0[3] * c0[2]};
                            v1 = (f32x4){v1[0] * c1[0] - v1[1] * c1[1], v1[0] * c1[1] + v1[1] * c1[0], v1[2] * c1[2] - v1[3] * c1[3], v1[2] * c1[3] + v1[3] * c1[2]}; }
                        v0 = v0 * sc; v1 = v1 * sc;
                        v4u w; w.x = cvt_pk_bf16(v0[0], v0[1]); w.y = cvt_pk_bf16(v0[2], v0[3]); w.z = cvt_pk_bf16(v1[0], v1[1]); w.w = cvt_pk_bf16(v1[2], v1[3]);
                        *(v4u*)(dst + (size_t)r * 2048 + hc + bj * 128) = w; } }
        } else {
            const int vc = (pn - 16) * 256 + wc * 32 + 8 * fq;
#pragma unroll
            for (int ai = 0; ai < 2; ++ai)
#pragma unroll
                for (int m = 0; m < 4; ++m) { const int r = row0 + ai * 128 + m * 16;
#pragma unroll
                    for (int bj = 0; bj < 2; ++bj) { const f32x4 v0 = acc[ai][bj][m][0], v1 = acc[ai][bj][m][1];
                        v4u w; w.x = cvt_pk_bf16(v0[0], v0[1]); w.y = cvt_pk_bf16(v0[2], v0[3]); w.z = cvt_pk_bf16(v1[0], v1[1]); w.w = cvt_pk_bf16(v1[2], v1[3]);
                        *(v4u*)(V + (size_t)r * 4096 + vc + bj * 128) = w; } }
        }
    }
};
struct EpiGate {
    static constexpr bool PERM = true, AFTER_DRAIN = false;
    const bf16 *OF, *OB; const float* part; bf16* YG;
    __device__ __forceinline__ void operator()(AccRef acc, const pg8::Unit& u, int wr, int wc, int fr, int fq) const {
        const int head = u.pn >> 2, col = u.pn * 128 + wc * 32 + 8 * fq, row0 = u.pm * 256 + wr * 64 + fr;
#pragma unroll
        for (int hb = 0; hb < 4; ++hb) { const int ai = hb >> 1, mb = (hb & 1) * 2;
            f32x4 pa[2][4]; v4u of[2], ob[2];
#pragma unroll
            for (int mm = 0; mm < 2; ++mm) { const int r = row0 + ai * 128 + (mb + mm) * 16; const f32x4* pp = (const f32x4*)(part + ((size_t)r * 8 + head) * 16);
                pa[mm][0] = pp[0]; pa[mm][1] = pp[1]; pa[mm][2] = pp[2]; pa[mm][3] = pp[3];
                of[mm] = *(const v4u*)(OF + (size_t)r * 4096 + col); ob[mm] = *(const v4u*)(OB + (size_t)r * 4096 + col); }
#pragma unroll
            for (int mm = 0; mm < 2; ++mm) { const int m = mb + mm; const int r = row0 + ai * 128 + m * 16;
                const f32x4 a0 = pa[mm][0], a1 = pa[mm][1], b0 = pa[mm][2], b1 = pa[mm][3];
                const float mf = ((a0[0] + a0[2]) + (a1[0] + a1[2])) * (1.0f / 512.0f), qf = ((a0[1] + a0[3]) + (a1[1] + a1[3])) * (1.0f / 512.0f);
                const float mbb = ((b0[0] + b0[2]) + (b1[0] + b1[2])) * (1.0f / 512.0f), qb = ((b0[1] + b0[3]) + (b1[1] + b1[3])) * (1.0f / 512.0f);
                const float rf = rsqrtf(fmaxf(qf - mf * mf, 0.f) + GN_EPS), rb = rsqrtf(fmaxf(qb - mbb * mbb, 0.f) + GN_EPS);
                float y[8];
#pragma unroll
                for (int n = 0; n < 2; ++n) { const f32x4 gf = acc[ai][0][m][n], gb = acc[ai][1][m][n];
#pragma unroll
                    for (int e = 0; e < 4; ++e) { const int idx = n * 4 + e; const unsigned wf = of[mm][idx >> 1], wb = ob[mm][idx >> 1];
                        const float xf = (idx & 1) ? bfhi(wf) : bflo(wf), xb = (idx & 1) ? bfhi(wb) : bflo(wb);
                        y[idx] = silu_f(gf[e]) * ((xf - mf) * rf) + silu_f(gb[e]) * ((xb - mbb) * rb); } }
                v4u w; w.x = cvt_pk_bf16(y[0], y[1]); w.y = cvt_pk_bf16(y[2], y[3]); w.z = cvt_pk_bf16(y[4], y[5]); w.w = cvt_pk_bf16(y[6], y[7]);
                *(v4u*)(YG + (size_t)r * 4096 + col) = w; } }
    }
};
struct EpiSwiglu {
    static constexpr bool PERM = true, AFTER_DRAIN = false;
    bf16* HID;
    __device__ __forceinline__ void operator()(AccRef acc, const pg8::Unit& u, int wr, int wc, int fr, int fq) const {
        const int col = u.pn * 128 + wc * 32 + 8 * fq, row0 = u.pm * 256 + wr * 64 + fr;
#pragma unroll
        for (int ai = 0; ai < 2; ++ai)
#pragma unroll
            for (int m = 0; m < 4; ++m) { const int r = row0 + ai * 128 + m * 16; float y[8];
#pragma unroll
                for (int n = 0; n < 2; ++n) { const f32x4 a = acc[ai][0][m][n], b = acc[ai][1][m][n];
#pragma unroll
                    for (int e = 0; e < 4; ++e) y[n * 4 + e] = silu_f(a[e]) * b[e]; }
                v4u w; w.x = cvt_pk_bf16(y[0], y[1]); w.y = cvt_pk_bf16(y[2], y[3]); w.z = cvt_pk_bf16(y[4], y[5]); w.w = cvt_pk_bf16(y[6], y[7]);
                *(v4u*)(HID + (size_t)r * FF + col) = w; }
    }
};
struct EpiBf {
    static constexpr bool PERM = true, AFTER_DRAIN = false;
    bf16 *O0, *O1; int ldc, split; float* YP;
    __device__ __forceinline__ void operator()(AccRef acc, const pg8::Unit& u, int wr, int wc, int fr, int fq) const {
        const int row0 = u.pm * 256 + wr * 64 + fr, cw = wc * 32 + 8 * fq;
        if (u.ks >= 0) {
            const int crow0 = ((u.pm - 16) / 17) * 256 + wr * 64 + fr;
#pragma unroll
            for (int ai = 0; ai < 2; ++ai)
#pragma unroll
                for (int m = 0; m < 4; ++m) { float* rp = YP + ((size_t)u.ks * 1024 + crow0 + ai * 128 + m * 16) * 2048 + u.pn * 256 + cw;
#pragma unroll
                    for (int bj = 0; bj < 2; ++bj) { *(f32x4*)(rp + bj * 128) = acc[ai][bj][m][0]; *(f32x4*)(rp + bj * 128 + 4) = acc[ai][bj][m][1]; } }
            return; }
#pragma unroll
        for (int ai = 0; ai < 2; ++ai)
#pragma unroll
            for (int m = 0; m < 4; ++m) { const int r = row0 + ai * 128 + m * 16;
#pragma unroll
                for (int bj = 0; bj < 2; ++bj) { const f32x4 v0 = acc[ai][bj][m][0], v1 = acc[ai][bj][m][1];
                    v4u w; w.x = cvt_pk_bf16(v0[0], v0[1]); w.y = cvt_pk_bf16(v0[2], v0[3]); w.z = cvt_pk_bf16(v1[0], v1[1]); w.w = cvt_pk_bf16(v1[2], v1[3]);
                    bf16* dst = split ? ((bj ? O1 : O0) + (size_t)r * ldc + u.pn * 128 + cw) : (O0 + (size_t)r * ldc + u.pn * 256 + bj * 128 + cw);
                    *(v4u*)dst = w; } }
    }
};
struct EpiF32 {
    static constexpr bool PERM = false, AFTER_DRAIN = false;
    float* C; int ldc;
    __device__ __forceinline__ void operator()(AccRef acc, const pg8::Unit& u, int wr, int wc, int fr, int fq) const {
        const int row0 = u.pm * 256 + wr * 64 + fr, col0 = u.pn * 256 + wc * 32 + 4 * fq;
#pragma unroll
        for (int ai = 0; ai < 2; ++ai)
#pragma unroll
            for (int m = 0; m < 4; ++m) { float* rowp = C + (size_t)(row0 + ai * 128 + m * 16) * ldc + col0;
#pragma unroll
                for (int bj = 0; bj < 2; ++bj)
#pragma unroll
                    for (int n = 0; n < 2; ++n) *(f32x4*)(rowp + bj * 128 + n * 16) = acc[ai][bj][m][n]; }
    }
};
struct EpiDQKV {
    static constexpr bool PERM = true, AFTER_DRAIN = false;
    bf16 *CQ, *CKV, *KR; float* ssq; const float* acs;
    __device__ __forceinline__ void operator()(AccRef acc, const pg8::Unit& u, int wr, int wc, int fr, int fq) const {
        const int row0 = u.pm * 256 + wr * 64 + fr, tj = u.pm % 17; const bool isctx = (tj == 16); const int t0 = tj * 256 + wr * 64 + fr;
        if (u.pn < 4) { bf16* dst = (u.pn < 2) ? CQ : CKV; const int colb = (u.pn & 1) * 256 + wc * 32 + 8 * fq;
#pragma unroll
            for (int ai = 0; ai < 2; ++ai)
#pragma unroll
                for (int m = 0; m < 4; ++m) { const int r = row0 + ai * 128 + m * 16; float q = 0.f;
#pragma unroll
                    for (int bj = 0; bj < 2; ++bj) { const f32x4 v0 = acc[ai][bj][m][0], v1 = acc[ai][bj][m][1];
                        q += (v0[0] * v0[0] + v0[1] * v0[1]) + (v0[2] * v0[2] + v0[3] * v0[3]) + (v1[0] * v1[0] + v1[1] * v1[1]) + (v1[2] * v1[2] + v1[3] * v1[3]);
                        v4u w; w.x = cvt_pk_bf16(v0[0], v0[1]); w.y = cvt_pk_bf16(v0[2], v0[3]); w.z = cvt_pk_bf16(v1[0], v1[1]); w.w = cvt_pk_bf16(v1[2], v1[3]);
                        *(v4u*)(dst + (size_t)r * 512 + colb + bj * 128) = w; }
                    { const int ln = fq * 16 + fr;
                      q += shx(q, 16, ln); q += shx(q, 32, ln); }
                    if (fq == 0) ssq[(size_t)r * 16 + u.pn * 4 + wc] = q; }
        } else if (wc < 2) {
#pragma unroll
            for (int ai = 0; ai < 2; ++ai)
#pragma unroll
                for (int m = 0; m < 4; ++m) { const int r = row0 + ai * 128 + m * 16, t = t0 + ai * 128 + m * 16;
                    f32x4 v0 = acc[ai][0][m][0], v1 = acc[ai][0][m][1];
                    if (!isctx) { const f32x4* cp = (const f32x4*)(acs + ((size_t)t * 32 + 16 * wc + 4 * fq) * 2); const f32x4 c0 = cp[0], c1 = cp[1];
                        v0 = (f32x4){v0[0] * c0[0] - v0[1] * c0[1], v0[0] * c0[1] + v0[1] * c0[0], v0[2] * c0[2] - v0[3] * c0[3], v0[2] * c0[3] + v0[3] * c0[2]};
                        v1 = (f32x4){v1[0] * c1[0] - v1[1] * c1[1], v1[0] * c1[1] + v1[1] * c1[0], v1[2] * c1[2] - v1[3] * c1[3], v1[2] * c1[3] + v1[3] * c1[2]}; }
                    v4u w; w.x = cvt_pk_bf16(v0[0], v0[1]); w.y = cvt_pk_bf16(v0[2], v0[3]); w.z = cvt_pk_bf16(v1[0], v1[1]); w.w = cvt_pk_bf16(v1[2], v1[3]);
                    *(v4u*)(KR + (size_t)r * 64 + wc * 32 + 8 * fq) = w; }
        }
    }
};
__device__ __forceinline__ float rms_rstd(const float* p) { const f32x4 a = *(const f32x4*)p, b = *(const f32x4*)(p + 4); return rsqrtf(((a[0] + a[1]) + (a[2] + a[3]) + (b[0] + b[1]) + (b[2] + b[3])) * (1.0f / 512.0f) + RMS_EPS); }
struct EpiUKV {
    static constexpr bool PERM = true, AFTER_DRAIN = false;
    bf16 *KN, *VB; const float* ssq;
    __device__ __forceinline__ void operator()(AccRef acc, const pg8::Unit& u, int wr, int wc, int fr, int fq) const {
        const int row0 = u.pm * 256 + wr * 64 + fr, cw = u.pn * 128 + wc * 32 + 8 * fq;
#pragma unroll
        for (int ai = 0; ai < 2; ++ai)
#pragma unroll
            for (int m = 0; m < 4; ++m) { const int r = row0 + ai * 128 + m * 16; const float rs = rms_rstd(ssq + (size_t)r * 16 + 8);
#pragma unroll
                for (int bj = 0; bj < 2; ++bj) { const f32x4 v0 = acc[ai][bj][m][0] * rs, v1 = acc[ai][bj][m][1] * rs;
                    v4u w; w.x = cvt_pk_bf16(v0[0], v0[1]); w.y = cvt_pk_bf16(v0[2], v0[3]); w.z = cvt_pk_bf16(v1[0], v1[1]); w.w = cvt_pk_bf16(v1[2], v1[3]);
                    *(v4u*)((bj ? VB : KN) + (size_t)r * 2048 + cw) = w; } }
    }
};
struct EpiUQ {
    static constexpr bool PERM = true, AFTER_DRAIN = false;
    bf16* QB; const float* acs; const float* ssq;
    __device__ __forceinline__ void operator()(AccRef acc, const pg8::Unit& u, int wr, int wc, int fr, int fq) const {
        const int row0 = u.pm * 256 + wr * 64 + fr, tj = u.pm % 17; const bool isctx = (tj == 16); const int t0 = tj * 256 + wr * 64 + fr;
#pragma unroll
        for (int bj = 0; bj < 2; ++bj) { const int blk = 4 * u.pn + 2 * bj + (wc >> 1); const bool rope = ((blk % 3) == 2) && !isctx;
            const int col = u.pn * 256 + bj * 128 + wc * 32 + 8 * fq, p0 = 16 * (wc & 1) + 4 * fq;
#pragma unroll
            for (int ai = 0; ai < 2; ++ai)
#pragma unroll
                for (int m = 0; m < 4; ++m) { const int r = row0 + ai * 128 + m * 16, t = t0 + ai * 128 + m * 16; const float rs = rms_rstd(ssq + (size_t)r * 16);
                    f32x4 v0 = acc[ai][bj][m][0] * rs, v1 = acc[ai][bj][m][1] * rs;
                    if (rope) { const f32x4* cp = (const f32x4*)(acs + ((size_t)t * 32 + p0) * 2); const f32x4 c0 = cp[0], c1 = cp[1];
                        v0 = (f32x4){v0[0] * c0[0] - v0[1] * c0[1], v0[0] * c0[1] + v0[1] * c0[0], v0[2] * c0[2] - v0[3] * c0[3], v0[2] * c0[3] + v0[3] * c0[2]};
                        v1 = (f32x4){v1[0] * c1[0] - v1[1] * c1[1], v1[0] * c1[1] + v1[1] * c1[0], v1[2] * c1[2] - v1[3] * c1[3], v1[2] * c1[3] + v1[3] * c1[2]}; }
                    v4u w; w.x = cvt_pk_bf16(v0[0], v0[1]); w.y = cvt_pk_bf16(v0[2], v0[3]); w.z = cvt_pk_bf16(v1[0], v1[1]); w.w = cvt_pk_bf16(v1[2], v1[3]);
                    *(v4u*)(QB + (size_t)r * 3072 + col) = w; } }
    }
};

__device__ __forceinline__ int srccol(int mode, int n, int halfn) {
    if (mode == 1) { if (n >= 4096) return n; const int d = n & 255; return (n & ~255) + ((d & 1) ? 128 + (d >> 1) : (d >> 1)); }
    if (mode == 2) { const int t = n >> 8, r = n & 255; return (r < 128) ? t * 128 + r : halfn + t * 128 + (r - 128); }
    if (mode == 4) { const int h = n / 192, d = n - h * 192; if (d < 128) return n; const int p = d - 128, hf = p >> 5, dd = p & 31; return h * 192 + 128 + hf * 32 + ((dd & 1) ? 16 + (dd >> 1) : (dd >> 1)); }
    if (mode == 5) { const int hf = n >> 5, dd = n & 31; return 512 + hf * 32 + ((dd & 1) ? 16 + (dd >> 1) : (dd >> 1)); }
    return n;
}
struct CvtJob { const float* W; bf16* WT; int ldw, K, Nd, mode, halfn; const float* kscale; };
template <bool KS> __device__ __forceinline__ void transpose_item(const CvtJob& J, LAS float* scr, int item, int lane) {
    const int nblk = J.Nd / 32, kb = item / nblk, nb = item - kb * nblk, k0 = 64 * kb, n0 = 32 * nb;
    const int sc = srccol(J.mode, n0 + (lane & 31), J.halfn);
#pragma unroll
    for (int i = 0; i < 32; ++i) { const int kk = 2 * i + (lane >> 5); float w = J.W[(size_t)(k0 + kk) * J.ldw + sc]; if (KS) w *= J.kscale[k0 + kk]; scr[kk * 33 + (lane & 31)] = w; }
    LDS_WAIT(); asm volatile("" ::: "memory");
    const int c = lane & 7;
#pragma unroll
    for (int j = 0; j < 4; ++j) { const int n = (lane >> 3) + 8 * j; const LAS float* s = scr + (8 * c) * 33 + n;
        v4u o; o.x = cvt_pk_bf16(s[0 * 33], s[1 * 33]); o.y = cvt_pk_bf16(s[2 * 33], s[3 * 33]); o.z = cvt_pk_bf16(s[4 * 33], s[5 * 33]); o.w = cvt_pk_bf16(s[6 * 33], s[7 * 33]);
        *(v4u*)(J.WT + (size_t)(n0 + n) * J.K + k0 + 8 * c) = o; }
    LDS_WAIT(); asm volatile("" ::: "memory");
}

struct Args { const float* in[21]; float* out; unsigned char* ws; int ph_lo, ph_hi; };
enum { I_X = 0, I_C, I_CTX, I_CCTX, I_ADAW, I_ADAB, I_LNG, I_LNB, I_RWQKV, I_RWG, I_RDEC, I_RWO, I_MWDQ, I_MGQ, I_MWUQ, I_MWDKV, I_MGKV, I_MWUKV, I_MWO, I_FWIN, I_FWOUT };

__device__ __forceinline__ CvtJob cvt_job(const Args& a, int j) {
    unsigned char* ws = a.ws; CvtJob J; J.mode = 0; J.halfn = 0; J.kscale = nullptr;
    if (j < 6) { const int l = j / 3, k = j - 3 * l;
        if (k == 0) { J.W = a.in[I_RWQKV] + (size_t)l * 2048 * 8192; J.WT = (bf16*)(ws + WS_WQKV) + (size_t)l * 8192 * 2048; J.ldw = 8192; J.K = 2048; J.Nd = 8192; J.mode = 1; }
        else if (k == 1) { J.W = a.in[I_RWG] + (size_t)l * 2048 * 8192; J.WT = (bf16*)(ws + WS_WG) + (size_t)l * 8192 * 2048; J.ldw = 8192; J.K = 2048; J.Nd = 8192; J.mode = 2; J.halfn = 4096; }
        else { J.W = a.in[I_RWO] + (size_t)l * 4096 * 2048; J.WT = (bf16*)(ws + WS_WOR) + (size_t)l * 2048 * 4096; J.ldw = 2048; J.K = 4096; J.Nd = 2048; }
    } else if (j < 18) { const int jj = j - 6, l = jj / 6, k = jj - 6 * l; bf16* wd = (bf16*)(ws + WS_WD) + (size_t)l * 1280 * 2048;
        if (k == 0) { J.W = a.in[I_MWDQ] + (size_t)l * 2048 * 512; J.WT = wd; J.ldw = 512; J.K = 2048; J.Nd = 512; }
        else if (k == 1) { J.W = a.in[I_MWDKV] + (size_t)l * 2048 * 576; J.WT = wd + (size_t)512 * 2048; J.ldw = 576; J.K = 2048; J.Nd = 512; }
        else if (k == 2) { J.W = a.in[I_MWDKV] + (size_t)l * 2048 * 576; J.WT = wd + (size_t)1024 * 2048; J.ldw = 576; J.K = 2048; J.Nd = 64; J.mode = 5; }
        else if (k == 3) { J.W = a.in[I_MWUQ] + (size_t)l * 512 * 3072; J.WT = (bf16*)(ws + WS_WUQ) + (size_t)l * 3072 * 512; J.ldw = 3072; J.K = 512; J.Nd = 3072; J.mode = 4; J.kscale = a.in[I_MGQ] + (size_t)l * 512; }
        else if (k == 4) { J.W = a.in[I_MWUKV] + (size_t)l * 512 * 4096; J.WT = (bf16*)(ws + WS_WUKV) + (size_t)l * 4096 * 512; J.ldw = 4096; J.K = 512; J.Nd = 4096; J.kscale = a.in[I_MGKV] + (size_t)l * 512; }
        else { J.W = a.in[I_MWO] + (size_t)l * 2048 * 2048; J.WT = (bf16*)(ws + WS_WOM) + (size_t)l * 2048 * 2048; J.ldw = 2048; J.K = 2048; J.Nd = 2048; }
    } else { const int jj = j - 18, l = jj >> 1;
        if ((jj & 1) == 0) { J.W = a.in[I_FWIN] + (size_t)l * 2048 * 11264; J.WT = (bf16*)(ws + WS_WIN) + (size_t)l * 11264 * 2048; J.ldw = 11264; J.K = 2048; J.Nd = 11264; J.mode = 2; J.halfn = 5632; }
        else { J.W = a.in[I_FWOUT] + (size_t)l * 5632 * 2048; J.WT = (bf16*)(ws + WS_WOUT) + (size_t)l * 2048 * 5632; J.ldw = 2048; J.K = 5632; J.Nd = 2048; }
    }
    return J;
}
constexpr int N_CVT_JOBS = 26;
__host__ __device__ constexpr bool cvt_deferred(int j) { return (j >= 3 && j < 6) || (j >= 12 && j < 18) || (j >= 22); }
constexpr int N_DEF_ITEMS = 2 * 8192 + 4096 + (512 + 512 + 64 + 768 + 1024 + 2048) + 2 * (11264 + 5632);

__device__ __forceinline__ bool def_resolve(const Args& a, int idx, int lim, CvtJob& J, int& it) {
    if (idx >= lim) return false;
    int cum = 0;
    for (int j = 0; j < N_CVT_JOBS; ++j) { if (!cvt_deferred(j)) continue; const CvtJob Jj = cvt_job(a, j); const int nit = (Jj.K / 64) * (Jj.Nd / 32);
        if (idx < cum + nit) { J = Jj; it = idx - cum; return true; }
        cum += nit; }
    return false;
}
__device__ __forceinline__ void convert_deferred(const Args& a, LAS float* scr, int lane, int first, int stride, int cnt, int lim = N_DEF_ITEMS) {
    for (int k0 = 0; k0 < cnt; k0 += 4) {
        int q0 = 0;
        while (q0 < 4) {
            CvtJob J; int it0; const int idx0 = first + (k0 + q0) * stride;
            if (!def_resolve(a, idx0, lim, J, it0)) return;
            const int nblk = J.Nd / 32, nit = (J.K / 64) * nblk;
            int m = 1; while (q0 + m < 4 && it0 + m * stride < nit && idx0 + m * stride < lim) ++m;
            float r[4][32];
#pragma unroll
            for (int x = 0; x < 4; ++x) if (x < m) { const int it = it0 + x * stride, kb = it / nblk, nb = it - kb * nblk, kk0 = 64 * kb, n0 = 32 * nb; const int sc = srccol(J.mode, n0 + (lane & 31), J.halfn);
                const float* wp = J.W + (size_t)(kk0 + (lane >> 5)) * J.ldw + sc;
#pragma unroll
                for (int i = 0; i < 32; ++i) r[x][i] = wp[(size_t)(2 * i) * J.ldw]; }
#pragma unroll
            for (int x = 0; x < 4; ++x) if (x < m) { const int it = it0 + x * stride, kb = it / nblk, nb = it - kb * nblk, kk0 = 64 * kb, n0 = 32 * nb;
#pragma unroll
                for (int i = 0; i < 32; ++i) { const int kk = 2 * i + (lane >> 5); float w = r[x][i]; if (J.kscale) w *= J.kscale[kk0 + kk]; scr[kk * 33 + (lane & 31)] = w; }
                LDS_WAIT(); asm volatile("" ::: "memory");
                const int c = lane & 7;
#pragma unroll
                for (int j = 0; j < 4; ++j) { const int n = (lane >> 3) + 8 * j; const LAS float* s = scr + (8 * c) * 33 + n;
                    v4u o; o.x = cvt_pk_bf16(s[0 * 33], s[1 * 33]); o.y = cvt_pk_bf16(s[2 * 33], s[3 * 33]); o.z = cvt_pk_bf16(s[4 * 33], s[5 * 33]); o.w = cvt_pk_bf16(s[6 * 33], s[7 * 33]);
                    *(v4u*)(J.WT + (size_t)(n0 + n) * J.K + kk0 + 8 * c) = o; }
                LDS_WAIT(); asm volatile("" ::: "memory"); }
            q0 += m;
        }
    }
}
__device__ __forceinline__ void phase_pro_a(const Args& a, LAS unsigned char* lds, int tid, int lane, int wave, int vcu, int G) {
    unsigned char* ws = a.ws;
    const int gw = vcu * NWAVES + wave, NGW = G * NWAVES;
#ifndef PROA_REP_CVT
#define PROA_REP_CVT 1
#endif
#ifndef PROA_REP_GEMV
#define PROA_REP_GEMV 1
#endif
    for (int rep_c = 0; rep_c < PROA_REP_CVT; ++rep_c)
    { LAS float* scr = (LAS float*)(lds + wave * 16384);
      int cum = 0;
      for (int j = 0; j < N_CVT_JOBS; ++j) { if (cvt_deferred(j)) continue; const CvtJob J = cvt_job(a, j); const int nit = (J.K / 64) * (J.Nd / 32);
          int start = (gw - cum) % NGW; if (start < 0) start += NGW;
          if (J.kscale) { for (int it = start; it < nit; it += NGW) transpose_item<true>(J, scr, it, lane); }
          else { for (int it = start; it < nit; it += NGW) transpose_item<false>(J, scr, it, lane); }
          cum = (cum + nit) % NGW; }
      const int gt = vcu * 512 + tid, NT = G * 512;
      for (int l = 0; l < 2; ++l) { v4u* z = (v4u*)((bf16*)(ws + WS_WD) + (size_t)l * 1280 * 2048 + (size_t)1088 * 2048);
          for (int i = gt; i < 192 * 2048 / 8; i += NT) z[i] = (v4u){0u, 0u, 0u, 0u}; }
    }
    __syncthreads();
    { const int gt = vcu * 512 + tid, NT = G * 512; f32x2* rcs = (f32x2*)(ws + WS_RCS); f32x2* acs = (f32x2*)(ws + WS_ACS);
      for (int e = gt; e < 4096 * 128; e += NT) { const int t = e >> 7, j = e & 127; const float inv = exp2f(-((float)j * (1.0f / 127.0f)) * 13.287712379549449f);
          const float ang = (float)t * inv; rcs[e] = (f32x2){cosf(ang), sinf(ang)}; }
      for (int e = gt; e < 4096 * 32; e += NT) { const int t = e >> 5, p = e & 31; const int j = p & 15; const float inv = exp2f(-((float)j * (1.0f / 16.0f)) * 13.287712379549449f);
          const float pos = (p < 16) ? (float)(t >> 6) : (float)(t & 63); const float ang = pos * inv; acs[e] = (f32x2){cosf(ang), sinf(ang)}; }
    }
    { LAS float* sc = (LAS float*)lds;
      LAS float* red = (LAS float*)(lds + 5 * 2048 * 4);
      for (int i = tid; i < 5 * 2048; i += 512) { const float v = (i < 4 * 2048) ? a.in[I_C][i] : a.in[I_CCTX][i - 4 * 2048]; sc[i] = silu_f(v); }
      __syncthreads();
      float* mod = (float*)(ws + WS_MOD);
      const int kq = lane >> 4, c4 = lane & 15;
      for (int rep_g = 0; rep_g < PROA_REP_GEMV; ++rep_g)
      for (int it = vcu; it < 4 * 192; it += G) { const int layer = it / 192, col0 = (it - layer * 192) * 64;
          const float* Wl = a.in[I_ADAW] + (size_t)layer * 2048 * 12288 + col0 + 4 * c4;
          float acc[5][4];
#pragma unroll
          for (int r = 0; r < 5; ++r)
#pragma unroll
              for (int e = 0; e < 4; ++e) acc[r][e] = 0.f;
#pragma unroll 8
          for (int j = 0; j < 64; ++j) { const int k = wave * 256 + 4 * j + kq; const f32x4 w = *(const f32x4*)(Wl + (size_t)k * 12288);
#pragma unroll
              for (int r = 0; r < 5; ++r) { const float s = sc[r * 2048 + k]; acc[r][0] += s * w[0]; acc[r][1] += s * w[1]; acc[r][2] += s * w[2]; acc[r][3] += s * w[3]; } }
#pragma unroll
          for (int r = 0; r < 5; ++r)
#pragma unroll
              for (int e = 0; e < 4; ++e) { float v = acc[r][e]; v += shx(v, 16, lane); v += shx(v, 32, lane); acc[r][e] = v; }
          if (lane < 16) {
#pragma unroll
              for (int r = 0; r < 5; ++r)
#pragma unroll
                  for (int e = 0; e < 4; ++e) red[(wave * 5 + r) * 64 + 4 * c4 + e] = acc[r][e]; }
          __syncthreads();
          if (tid < 320) { const int r = tid >> 6, c = tid & 63; float s = 0.f;
#pragma unroll
              for (int w = 0; w < 8; ++w) s += red[(w * 5 + r) * 64 + c];
              mod[((size_t)layer * 5 + r) * 12288 + col0 + c] = s + a.in[I_ADAB][(size_t)layer * 12288 + col0 + c]; }
          __syncthreads(); }
    }
}

__device__ __forceinline__ const float* src_row(const Args& a, int r, int& r5) {
    const int b = r / TPB, t = r - b * TPB;
    if (t < SEQ) { r5 = b; return a.in[I_X] + ((size_t)b * SEQ + t) * D; }
    r5 = 4; return a.in[I_CTX] + ((size_t)b * CTXL + (t - SEQ)) * D;
}
__device__ __forceinline__ void phase_pro_b(const Args& a, int lane, int wave, int vcu, int G) {
    const int gw = vcu * NWAVES + wave, NGW = G * NWAVES; const float* mod = (const float*)(a.ws + WS_MOD);
    bf16* U = (bf16*)(a.ws + WS_U);
    for (int r = gw; r < M; r += NGW) { int r5; const float* src = src_row(a, r, r5); const float* sh = mod + (size_t)r5 * 12288, *scl = sh + 2048;
#pragma unroll
        for (int j = 0; j < 8; ++j) { const int c = 4 * lane + 256 * j; const f32x4 v = *(const f32x4*)(src + c), s = *(const f32x4*)(scl + c), t = *(const f32x4*)(sh + c);
            const f32x4 uu = v * (1.0f + s) + t;
            v2u w; w.x = cvt_pk_bf16(uu[0], uu[1]); w.y = cvt_pk_bf16(uu[2], uu[3]); *(v2u*)(U + (size_t)r * D + c) = w; } }
}
template <bool FIRST> __device__ __forceinline__ void phase_ln_t(const Args& a, int layer, int which, LAS unsigned char* lds, int tid, int lane, int wave, int vcu, int G, bool dry) {
    const float* mod = (const float*)(a.ws + WS_MOD);
    const h16* H = (const h16*)(a.ws + WS_H); h16* Hw = (h16*)(a.ws + (dry ? WS_END : WS_H)); bf16* U = (bf16*)(a.ws + (dry ? WS_END + 136 * MiB : WS_U)); const bf16* Y = (const bf16*)(a.ws + WS_Y);
    const bool latonly = (layer == DEPTH - 1), final = (layer == DEPTH - 1) && which == 1; const bool ysplit = !latonly; const float* YP = (const float*)(a.ws + WS_YP);
    const float* lg = a.in[I_LNG] + ((size_t)layer * 2 + which) * D; const float* lb = a.in[I_LNB] + ((size_t)layer * 2 + which) * D;
    const int gch = which ? 5 : 2; const int nlayer = final ? 0 : (which ? layer + 1 : layer), nsh = which ? 0 : 3;
    const int nrows = latonly ? BATCH * SEQ : M, rpc = nrows / G;
    LAS float* V = (LAS float*)lds;
    if (G != 256) return;
    const int bb = vcu >> 6, c6 = vcu & 63; const int i0 = 0;
    __syncthreads();
    {
        const int i4 = 4 * tid; f32x4 v8[8];
#pragma unroll
        for (int v = 0; v < 2; ++v) { const int r5 = v ? 4 : bb;
            v8[v * 3 + 0] = *(const f32x4*)(mod + ((size_t)layer * 5 + r5) * 12288 + gch * 2048 + i4);
            v8[v * 3 + 1] = *(const f32x4*)(mod + ((size_t)nlayer * 5 + r5) * 12288 + nsh * 2048 + i4);
            v8[v * 3 + 2] = *(const f32x4*)(mod + ((size_t)nlayer * 5 + r5) * 12288 + (nsh + 1) * 2048 + i4); }
        v8[6] = *(const f32x4*)(lg + i4); v8[7] = *(const f32x4*)(lb + i4);
#pragma unroll
        for (int v = 0; v < 8; ++v) *(LAS f32x4*)(V + v * 2048 + i4) = v8[v]; }

    __syncthreads();
    for (int k = wave; k < rpc; k += 2 * NWAVES) {
        f32x4 z[2][8]; int rr[2], tt[2]; bool ok[2];
#pragma unroll
        for (int q = 0; q < 2; ++q) { const int kk = k + q * NWAVES; ok[q] = kk < rpc; const int ii = ok[q] ? kk : 0;
            const int t = (ii < 64) ? c6 * 64 + ii : SEQ + c6 * 4 + (ii - 64); const int r = bb * TPB + t; rr[q] = r; tt[q] = t;
            const LAS float* gate = V + (t < SEQ ? 0 : 3) * 2048;
            const float* xrow = (t < SEQ) ? a.in[I_X] + ((size_t)bb * SEQ + t) * D : a.in[I_CTX] + ((size_t)bb * CTXL + (t - SEQ)) * D; const h16* hrow = H + (size_t)r * D;
            f32x4 hv[8], yv[8];
            if (FIRST) {
#pragma unroll
                for (int j = 0; j < 8; ++j) hv[j] = *(const f32x4*)(xrow + 4 * lane + 256 * j);
            } else {
#pragma unroll
                for (int j = 0; j < 8; ++j) hv[j] = __builtin_convertvector(*(const h16x4*)(hrow + 4 * lane + 256 * j), f32x4);
            }
            if (ysplit && t >= SEQ) { const float* yp = YP + ((size_t)bb * CTXL + (t - SEQ)) * D + 4 * lane;
#pragma unroll
                for (int jh = 0; jh < 2; ++jh) { f32x4 p[4][4];
#pragma unroll
                    for (int jj = 0; jj < 4; ++jj)
#pragma unroll
                        for (int s4 = 0; s4 < 4; ++s4) p[jj][s4] = *(const f32x4*)(yp + 256 * (4 * jh + jj) + (size_t)s4 * 1024 * D);
#pragma unroll
                    for (int jj = 0; jj < 4; ++jj) yv[4 * jh + jj] = (p[jj][0] + p[jj][1]) + (p[jj][2] + p[jj][3]); }
            } else {
#pragma unroll
                for (int j = 0; j < 8; ++j) { const v2u yw = *(const v2u*)(Y + (size_t)r * D + 4 * lane + 256 * j); yv[j] = (f32x4){bflo(yw.x), bfhi(yw.x), bflo(yw.y), bfhi(yw.y)}; }
            }
#pragma unroll
            for (int j = 0; j < 8; ++j) { const int c = 4 * lane + 256 * j; const f32x4 g = *(const LAS f32x4*)(gate + c);
                z[q][j] = hv[j] * ALPHA + g * yv[j]; } }
        float s0 = 0.f, s1 = 0.f;
#pragma unroll
        for (int j = 0; j < 8; ++j) { s0 += (z[0][j][0] + z[0][j][1]) + (z[0][j][2] + z[0][j][3]); s1 += (z[1][j][0] + z[1][j][1]) + (z[1][j][2] + z[1][j][3]); }
#pragma unroll
        for (int o = 1; o < 64; o <<= 1) { s0 += shx(s0, o, lane); s1 += shx(s1, o, lane); }
        const float m0 = s0 * (1.0f / D), m1 = s1 * (1.0f / D); float q0 = 0.f, q1 = 0.f;
#pragma unroll
        for (int j = 0; j < 8; ++j) { z[0][j] = z[0][j] - m0; z[1][j] = z[1][j] - m1;
            q0 += (z[0][j][0] * z[0][j][0] + z[0][j][1] * z[0][j][1]) + (z[0][j][2] * z[0][j][2] + z[0][j][3] * z[0][j][3]);
            q1 += (z[1][j][0] * z[1][j][0] + z[1][j][1] * z[1][j][1]) + (z[1][j][2] * z[1][j][2] + z[1][j][3] * z[1][j][3]); }
#pragma unroll
        for (int o = 1; o < 64; o <<= 1) { q0 += shx(q0, o, lane); q1 += shx(q1, o, lane); }
        const float rs[2] = {rsqrtf(q0 * (1.0f / D) + LN_EPS), rsqrtf(q1 * (1.0f / D) + LN_EPS)};
#pragma unroll
        for (int q = 0; q < 2; ++q) { if (!ok[q]) continue; const int r = rr[q], t = tt[q]; const LAS float* nm = V + ((t < SEQ ? 0 : 3) + 1) * 2048;
#pragma unroll
            for (int j = 0; j < 8; ++j) { const int c = 4 * lane + 256 * j; const f32x4 gg = *(const LAS f32x4*)(V + 6 * 2048 + c), bv = *(const LAS f32x4*)(V + 7 * 2048 + c);
                const f32x4 hn = z[q][j] * rs[q] * gg + bv;
                if (final) { if (!dry) *(f32x4*)(a.out + ((size_t)bb * SEQ + t) * D + c) = hn; else *(h16x4*)(Hw + (size_t)r * D + c) = __builtin_convertvector(hn, h16x4); }
                else { *(h16x4*)(Hw + (size_t)r * D + c) = __builtin_convertvector(hn, h16x4); const f32x4 sh = *(const LAS f32x4*)(nm + c), sc = *(const LAS f32x4*)(nm + 2048 + c); const f32x4 uu = hn * (1.0f + sc) + sh;
                    v2u w; w.x = cvt_pk_bf16(uu[0], uu[1]); w.y = cvt_pk_bf16(uu[2], uu[3]); *(v2u*)(U + (size_t)r * D + c) = w; } } }
    }
    __syncthreads();
}
__device__ __forceinline__ void phase_ln(const Args& a, int layer, int which, LAS unsigned char* lds, int tid, int lane, int wave, int vcu, int G, bool dry = false) {
    if (layer == 0 && which == 0) phase_ln_t<true>(a, layer, which, lds, tid, lane, wave, vcu, G, dry); else phase_ln_t<false>(a, layer, which, lds, tid, lane, wave, vcu, G, dry);
}
__device__ __forceinline__ void phase_mla_norm(const Args& a, int ml, int lane, int wave, int vcu, int G) {
    const int gw = vcu * NWAVES + wave, NGW = G * NWAVES;
    const float* C = (const float*)(a.ws + WS_CQKV); bf16* CQN = (bf16*)(a.ws + WS_CQN); bf16* CKVN = (bf16*)(a.ws + WS_CKVN); bf16* KR = (bf16*)(a.ws + WS_KR);
    const float* gq = a.in[I_MGQ] + (size_t)ml * 512; const float* gkv = a.in[I_MGKV] + (size_t)ml * 512; const f32x2* acs = (const f32x2*)(a.ws + WS_ACS);
    for (int r = gw; r < M; r += NGW) { const float* row = C + (size_t)r * 1280; const int b = r / TPB, t = r - b * TPB;
        f32x4 q0 = *(const f32x4*)(row + 4 * lane), q1 = *(const f32x4*)(row + 256 + 4 * lane), k0 = *(const f32x4*)(row + 512 + 4 * lane), k1 = *(const f32x4*)(row + 768 + 4 * lane);
        float sq = (q0[0] * q0[0] + q0[1] * q0[1]) + (q0[2] * q0[2] + q0[3] * q0[3]) + (q1[0] * q1[0] + q1[1] * q1[1]) + (q1[2] * q1[2] + q1[3] * q1[3]);
        float sk = (k0[0] * k0[0] + k0[1] * k0[1]) + (k0[2] * k0[2] + k0[3] * k0[3]) + (k1[0] * k1[0] + k1[1] * k1[1]) + (k1[2] * k1[2] + k1[3] * k1[3]);
        const float rq = rsqrtf(wave_sum(sq, lane) * (1.0f / 512.0f) + RMS_EPS), rk = rsqrtf(wave_sum(sk, lane) * (1.0f / 512.0f) + RMS_EPS);
        const f32x4 g0 = *(const f32x4*)(gq + 4 * lane), g1 = *(const f32x4*)(gq + 256 + 4 * lane), h0 = *(const f32x4*)(gkv + 4 * lane), h1 = *(const f32x4*)(gkv + 256 + 4 * lane);
        q0 = q0 * rq * g0; q1 = q1 * rq * g1; k0 = k0 * rk * h0; k1 = k1 * rk * h1;
        v2u w; w.x = cvt_pk_bf16(q0[0], q0[1]); w.y = cvt_pk_bf16(q0[2], q0[3]); *(v2u*)(CQN + (size_t)r * 512 + 4 * lane) = w;
        w.x = cvt_pk_bf16(q1[0], q1[1]); w.y = cvt_pk_bf16(q1[2], q1[3]); *(v2u*)(CQN + (size_t)r * 512 + 256 + 4 * lane) = w;
        w.x = cvt_pk_bf16(k0[0], k0[1]); w.y = cvt_pk_bf16(k0[2], k0[3]); *(v2u*)(CKVN + (size_t)r * 512 + 4 * lane) = w;
        w.x = cvt_pk_bf16(k1[0], k1[1]); w.y = cvt_pk_bf16(k1[2], k1[3]); *(v2u*)(CKVN + (size_t)r * 512 + 256 + 4 * lane) = w;
        if (lane < 32) { f32x2 kr = *(const f32x2*)(row + 1024 + 2 * lane);
            if (t < SEQ) { const f32x2 cs = acs[(size_t)t * 32 + lane]; kr = (f32x2){kr[0] * cs[0] - kr[1] * cs[1], kr[0] * cs[1] + kr[1] * cs[0]}; }
            *(unsigned*)(KR + (size_t)r * 64 + 2 * lane) = cvt_pk_bf16(kr[0], kr[1]); } }
}

constexpr int RQ_RS = 528, RV_RS = 288, RP_RS = 144;
__device__ __forceinline__ int koff(int row, int ch32) { const int f = ((row & 3) << 2) | ((row >> 2) & 3); return (ch32 >> 4) * 16384 + row * 256 + (((ch32 & 15) ^ f) << 4); }
constexpr int RL_Q = 0, RL_K = RL_Q + 64 * RQ_RS, RL_V = RL_K + 32768, RL_P = RL_V + 64 * RV_RS, RL_OT = RL_P + 64 * RP_RS, RL_FAC = RL_OT + 64 * 272, RL_END = RL_FAC + 4 * 64 * 4;
constexpr int ROT_RS = 272;
static_assert(RL_END <= RING_BYTES, "retention LDS map");
template <int OFF> __device__ __forceinline__ s16x4 tr_read(int addr) {
    s16x4 r; asm volatile("ds_read_b64_tr_b16 %0, %1 offset:%2" : "=&v"(r) : "v"(addr), "i"(OFF) : "memory"); return r;
}
template <int CTL> __device__ __forceinline__ float dpp_ctl(float v) { return __int_as_float(__builtin_amdgcn_update_dpp(0, __float_as_int(v), CTL, 0xf, 0xf, false)); }
template <int N> __device__ __forceinline__ float dpp_ror(float v) { return __int_as_float(__builtin_amdgcn_update_dpp(0, __float_as_int(v), 0x120 + N, 0xf, 0xf, false)); }
__device__ __forceinline__ bf16x8 cat4(s16x4 l, s16x4 h) { return (bf16x8){l[0], l[1], l[2], l[3], h[0], h[1], h[2], h[3]}; }

__device__ __forceinline__ void phase_ret_scan(const Args& a, int rl, LAS unsigned char* lds, int tid, int lane, int wave, int vcu, int G) {
    const bf16* Qg = (const bf16*)(a.ws + WS_RQ); const bf16* Kg = (const bf16*)(a.ws + WS_RK); const bf16* Vg = (const bf16*)(a.ws + WS_RV);
    bf16* OFg = (bf16*)(a.ws + WS_OF); bf16* OBg = (bf16*)(a.ws + WS_OB); f32x2* part = (f32x2*)(a.ws + WS_PART);
    LAS float* fac = (LAS float*)(lds + RL_FAC);
    const int ldsb = (int)(uintptr_t)lds;
    for (int item = vcu; item < 256; item += G) {
        const int slice = item & 3, dir = (item >> 2) & 1, h = (item >> 3) & 7, b = item >> 6;
        __syncthreads();
        if (tid < 64) { const float x = a.in[I_RDEC][(size_t)rl * 16 + dir * 8 + h]; const float lg = -log1pf(expf(-x));
            const int i = tid;
            fac[i] = dir ? expf(-lg * (float)i) : expf(lg * (float)(i - 63));
            fac[64 + i] = dir ? expf(lg * (float)(64 - i)) : expf(lg * (float)(i + 1));
            fac[128 + i] = dir ? expf(lg * (float)i) : expf(lg * (float)(63 - i));
            if (i == 0) fac[192] = expf(lg * 64.0f); }
        __syncthreads();
#define RET_ROWBASE(n) ({ int _cc, _rb; if ((n) < 4) { _cc = dir ? 3 - (n) : (n); _rb = b * TPB + SEQ + 64 * _cc; } else { _cc = dir ? 63 - ((n) - 4) : (n) - 4; _rb = b * TPB + 64 * _cc; } _rb; })
        if (wave < 4) {
            __builtin_amdgcn_s_setprio(2);
            int lane_c = lane; asm volatile("" : "+v"(lane_c));
            const int g = lane_c >> 4, c16 = lane_c & 15, q4 = c16 >> 2, p4 = lane_c & 3;
            const int cw = wave, sa = cw >> 1, sb = cw & 1;
            const float cdec = fac[192];
            const float pf[2] = {fac[16 * (2 * sa) + c16], fac[16 * (2 * sa + 1) + c16]};
            int kb[4][2];
#pragma unroll
            for (int u = 0; u < 4; ++u)
#pragma unroll
                for (int t = 0; t < 2; ++t) { const int row = 8 * g + 4 * t + q4, f = ((row & 3) << 2) | ((row >> 2) & 3); kb[u][t] = ldsb + RL_K + row * 256 + (((4 * u + p4) ^ f) << 4); }
            pg8::f32x4 S[2][16];
#pragma unroll
            for (int nb = 0; nb < 2; ++nb)
#pragma unroll
                for (int T = 0; T < 16; ++T) S[nb][T] = (pg8::f32x4){0.f, 0.f, 0.f, 0.f};
            for (int n = 0; n < 68; ++n) {
                __syncthreads();
                { pg8::f32x4 sc[2][2];
#pragma unroll
                  for (int ti = 0; ti < 2; ++ti)
#pragma unroll
                      for (int tj = 0; tj < 2; ++tj) sc[ti][tj] = (pg8::f32x4){0.f, 0.f, 0.f, 0.f};
                  bf16x8 fq_[2][2], fa_[2][2];
#pragma unroll
                  for (int t = 0; t < 2; ++t) { fq_[0][t] = *(const LAS bf16x8*)(lds + RL_Q + (16 * (2 * sa + t) + c16) * RQ_RS + (8 * g) * 2); fa_[0][t] = *(const LAS bf16x8*)(lds + RL_K + koff(16 * (2 * sb + t) + c16, g)); }
#pragma unroll
                  for (int s = 0; s < 8; ++s) {
                      if (s < 7) {
#pragma unroll
                          for (int t = 0; t < 2; ++t) { fq_[(s + 1) & 1][t] = *(const LAS bf16x8*)(lds + RL_Q + (16 * (2 * sa + t) + c16) * RQ_RS + (32 * (s + 1) + 8 * g) * 2);
                              fa_[(s + 1) & 1][t] = *(const LAS bf16x8*)(lds + RL_K + koff(16 * (2 * sb + t) + c16, 4 * (s + 1) + g)); } }
#pragma unroll
                      for (int ti = 0; ti < 2; ++ti)
#pragma unroll
                          for (int tj = 0; tj < 2; ++tj) sc[ti][tj] = __builtin_amdgcn_mfma_f32_16x16x32_bf16(fa_[s & 1][tj], fq_[s & 1][ti], sc[ti][tj], 0, 0, 0); }
#pragma unroll
                  for (int ti = 0; ti < 2; ++ti) { const int i = 16 * (2 * sa + ti) + c16;
#pragma unroll
                      for (int tj = 0; tj < 2; ++tj) { const pg8::f32x4 scv = sc[ti][tj]; const int j0 = 16 * (2 * sb + tj) + 4 * g; float pv[4];
#pragma unroll
                          for (int r = 0; r < 4; ++r) { const int j = j0 + r; const bool keep = dir ? (j >= i) : (j <= i); pv[r] = keep ? scv[r] * pf[ti] : 0.f; }
                          v2u w; w.x = cvt_pk_bf16(pv[0], pv[1]); w.y = cvt_pk_bf16(pv[2], pv[3]);
                          *(LAS v2u*)(lds + RL_P + i * RP_RS + j0 * 2) = w; } } }
                pg8::f32x4 o[2][4];
#pragma unroll
                for (int nb = 0; nb < 2; ++nb)
#pragma unroll
                    for (int ib = 0; ib < 4; ++ib) o[nb][ib] = (pg8::f32x4){0.f, 0.f, 0.f, 0.f};
                { bf16x8 aq[2][4];
#pragma unroll
                  for (int ib = 0; ib < 4; ++ib) aq[0][ib] = *(const LAS bf16x8*)(lds + RL_Q + (16 * ib + c16) * RQ_RS + (8 * g) * 2);
#pragma unroll
                  for (int s = 0; s < 8; ++s) {
                      if (s < 7) {
#pragma unroll
                          for (int ib = 0; ib < 4; ++ib) aq[(s + 1) & 1][ib] = *(const LAS bf16x8*)(lds + RL_Q + (16 * ib + c16) * RQ_RS + (32 * (s + 1) + 8 * g) * 2); }
                      bf16x8 bs[2];
#pragma unroll
                      for (int nb = 0; nb < 2; ++nb) { v4u bw; bw.x = cvt_pk_bf16(S[nb][2 * s][0], S[nb][2 * s][1]); bw.y = cvt_pk_bf16(S[nb][2 * s][2], S[nb][2 * s][3]); bw.z = cvt_pk_bf16(S[nb][2 * s + 1][0], S[nb][2 * s + 1][1]); bw.w = cvt_pk_bf16(S[nb][2 * s + 1][2], S[nb][2 * s + 1][3]);
                          bs[nb] = __builtin_bit_cast(bf16x8, bw); }
#pragma unroll
                      for (int ib = 0; ib < 4; ++ib)
#pragma unroll
                          for (int nb = 0; nb < 2; ++nb) o[nb][ib] = __builtin_amdgcn_mfma_f32_16x16x32_bf16(aq[s & 1][ib], bs[nb], o[nb][ib], 0, 0, 0); } }
#pragma unroll
                for (int ib = 0; ib < 4; ++ib)
#pragma unroll
                    for (int r = 0; r < 4; ++r) { const float qf = fac[64 + 16 * ib + 4 * g + r]; o[0][ib][r] *= qf; o[1][ib][r] *= qf; }
                bf16x8 bv[2][2];
                { const int va = ldsb + RL_V + (8 * g + q4) * RV_RS + (32 * cw + 4 * p4) * 2;
                  const s16x4 l0 = tr_read<0>(va), h0 = tr_read<4 * RV_RS>(va), l1 = tr_read<32 * RV_RS>(va), h1 = tr_read<36 * RV_RS>(va);
                  const s16x4 m0 = tr_read<32>(va), n0 = tr_read<32 + 4 * RV_RS>(va), m1 = tr_read<32 + 32 * RV_RS>(va), n1 = tr_read<32 + 36 * RV_RS>(va);
                  LDS_WAIT(); SBAR();
                  bv[0][0] = cat4(l0, h0); bv[0][1] = cat4(l1, h1); bv[1][0] = cat4(m0, n0); bv[1][1] = cat4(m1, n1); }
                {
#define KTR(T, ks, t) tr_read<(ks) * 8192 + ((T) >> 3) * 16384 + ((T) & 1) * 8>(kb[((T) >> 1) & 3][t])
#define KLOAD(T, L0, H0, L1, H1) do { L0 = KTR(T, 0, 0); H0 = KTR(T, 0, 1); L1 = KTR(T, 1, 0); H1 = KTR(T, 1, 1); } while (0)
#define KMMA(T, L0, H0, L1, H1) do { const bf16x8 A0_ = cat4(L0, H0), A1_ = cat4(L1, H1); \
                      pg8::f32x4 ac0_ = S[0][T] * cdec, ac1_ = S[1][T] * cdec; \
                      ac0_ = __builtin_amdgcn_mfma_f32_16x16x32_bf16(A0_, bv[0][0], ac0_, 0, 0, 0); ac1_ = __builtin_amdgcn_mfma_f32_16x16x32_bf16(A0_, bv[1][0], ac1_, 0, 0, 0); \
                      ac0_ = __builtin_amdgcn_mfma_f32_16x16x32_bf16(A1_, bv[0][1], ac0_, 0, 0, 0); ac1_ = __builtin_amdgcn_mfma_f32_16x16x32_bf16(A1_, bv[1][1], ac1_, 0, 0, 0); \
                      S[0][T] = ac0_; S[1][T] = ac1_; } while (0)
                  s16x4 xa0, xa1, xa2, xa3, ya0, ya1, ya2, ya3;
                  KLOAD(0, xa0, xa1, xa2, xa3);
#define KGROUP(T, LAST) do { KLOAD(T + 1, ya0, ya1, ya2, ya3); \
                      asm volatile("s_waitcnt lgkmcnt(4)" ::: "memory"); SBAR(); \
                      KMMA(T, xa0, xa1, xa2, xa3); \
                      if (!(LAST)) { KLOAD(((T) + 2) & 15, xa0, xa1, xa2, xa3); asm volatile("s_waitcnt lgkmcnt(4)" ::: "memory"); } \
                      else asm volatile("s_waitcnt lgkmcnt(0)" ::: "memory"); \
                      SBAR(); \
                      KMMA(T + 1, ya0, ya1, ya2, ya3); } while (0)
                  KGROUP(0, false); KGROUP(2, false); KGROUP(4, false); KGROUP(6, false); KGROUP(8, false); KGROUP(10, false); KGROUP(12, false); KGROUP(14, true);
#undef KGROUP
#undef KTR
#undef KLOAD
#undef KMMA
                }
                __syncthreads();
#pragma unroll
                for (int ks = 0; ks < 2; ++ks)
#pragma unroll
                    for (int ib = 0; ib < 4; ++ib) { const bf16x8 ap = *(const LAS bf16x8*)(lds + RL_P + (16 * ib + c16) * RP_RS + (32 * ks + 8 * g) * 2);
                        o[0][ib] = __builtin_amdgcn_mfma_f32_16x16x32_bf16(ap, bv[0][ks], o[0][ib], 0, 0, 0); o[1][ib] = __builtin_amdgcn_mfma_f32_16x16x32_bf16(ap, bv[1][ks], o[1][ib], 0, 0, 0); }
#pragma unroll
                for (int nb = 0; nb < 2; ++nb)
#pragma unroll
                    for (int ib = 0; ib < 4; ++ib)
#pragma unroll
                        for (int r = 0; r < 4; ++r) *(LAS unsigned short*)(lds + RL_OT + (16 * ib + 4 * g + r) * ROT_RS + (32 * cw + 16 * nb + c16) * 2) = __builtin_bit_cast(unsigned short, (__bf16)o[nb][ib][r]);
            }
            __builtin_amdgcn_s_setprio(0);
            __syncthreads();
        } else {
            int lt_ = tid - 256; asm volatile("" : "+v"(lt_)); const int lt = lt_; bf16* Og = dir ? OBg : OFg;
            const int qrow = lt >> 5, qch = lt & 31, vrow = lt >> 4, vch = lt & 15;
            v4u sq[8], sk[8], sv[4];
#define RET_LOAD(n) do { const int _rb = RET_ROWBASE(n); \
            _Pragma("unroll") for (int e = 0; e < 8; ++e) { sq[e] = *(const v4u*)(Qg + (size_t)(_rb + qrow + 8 * e) * 2048 + h * 256 + qch * 8); sk[e] = *(const v4u*)(Kg + (size_t)(_rb + qrow + 8 * e) * 2048 + h * 256 + qch * 8); } \
            _Pragma("unroll") for (int e = 0; e < 4; ++e) sv[e] = *(const v4u*)(Vg + (size_t)(_rb + vrow + 16 * e) * 4096 + h * 512 + slice * 128 + vch * 8); } while (0)
#define RET_STAGE() do { \
            _Pragma("unroll") for (int e = 0; e < 8; ++e) { *(LAS v4u*)(lds + RL_Q + (qrow + 8 * e) * RQ_RS + qch * 16) = sq[e]; *(LAS v4u*)(lds + RL_K + koff(qrow + 8 * e, qch)) = sk[e]; } \
            _Pragma("unroll") for (int e = 0; e < 4; ++e) { const float vf = fac[128 + vrow + 16 * e]; v4u w; \
                w.x = cvt_pk_bf16(bflo(sv[e].x) * vf, bfhi(sv[e].x) * vf); w.y = cvt_pk_bf16(bflo(sv[e].y) * vf, bfhi(sv[e].y) * vf); \
                w.z = cvt_pk_bf16(bflo(sv[e].z) * vf, bfhi(sv[e].z) * vf); w.w = cvt_pk_bf16(bflo(sv[e].w) * vf, bfhi(sv[e].w) * vf); \
                *(LAS v4u*)(lds + RL_V + (vrow + 16 * e) * RV_RS + vch * 16) = w; } } while (0)
#define RET_OSTORE(n) do { const int rowprev = RET_ROWBASE(n); \
            _Pragma("unroll") for (int e = 0; e < 2; ++e) { const int orow = (lt >> 3) + 32 * e, ocg = lt & 7; const LAS v4u* op = (const LAS v4u*)(lds + RL_OT + orow * ROT_RS + ocg * 32); const v4u w0 = op[0], w1 = op[1]; \
              float s1 = 0.f, s2 = 0.f; \
              _Pragma("unroll") for (int q = 0; q < 4; ++q) { const float a0 = bflo(w0[q]), a1 = bfhi(w0[q]), b0 = bflo(w1[q]), b1 = bfhi(w1[q]); s1 += (a0 + a1) + (b0 + b1); s2 += (a0 * a0 + a1 * a1) + (b0 * b0 + b1 * b1); } \
              s1 += dpp_ctl<0xB1>(s1); s2 += dpp_ctl<0xB1>(s2); s1 += dpp_ctl<0x4E>(s1); s2 += dpp_ctl<0x4E>(s2); s1 += dpp_ctl<0x141>(s1); s2 += dpp_ctl<0x141>(s2); \
              v4u* gp = (v4u*)(Og + (size_t)(rowprev + orow) * 4096 + h * 512 + slice * 128 + ocg * 16); gp[0] = w0; gp[1] = w1; \
              if (ocg == 0) part[(size_t)(rowprev + orow) * 64 + h * 8 + dir * 4 + slice] = (f32x2){s1, s2}; } } while (0)
            RET_LOAD(0);
            RET_STAGE();
            for (int n = 0; n < 68; ++n) {
                __syncthreads();
                if (n + 1 < 68) RET_LOAD(n + 1);
                if (n > 0) RET_OSTORE(n - 1);
                __syncthreads();
                if (n + 1 < 68) RET_STAGE();
            }
            __syncthreads();
            RET_OSTORE(67);
#undef RET_LOAD
#undef RET_STAGE
#undef RET_OSTORE
        }
#undef RET_ROWBASE
    }
}

namespace att {
constexpr int KVBLK = 64, QBLK = 32;
constexpr int LDQ = 3072, LDKN = 2048, LDKR = 64, LDV = 2048, LDO = 2048;
constexpr float SCALE = MLA_SCALE;
constexpr float THR = 8.f;
constexpr int SHM_V = KVBLK * 128 * 2, SHM_K = KVBLK * 128 * 2, SHM_R = KVBLK * 64 * 2;
constexpr int L_V = 0, L_K = 2 * SHM_V, L_R = L_K + 2 * SHM_K, L_WS = L_R + 2 * SHM_R, L_END = L_WS + NWAVES * 64 * 4;
static_assert(L_END <= RING_BYTES, "attention LDS map");
#define KSWZ(row, colB) ((row) * 256 + ((colB) ^ (((row) & 7) << 4)))
#define RSWZ(row, colB) ((row) * 128 + ((colB) ^ (((row) & 7) << 4)))
__device__ __forceinline__ int crow(int r, int hi) { return (r & 3) + 8 * (r >> 2) + 4 * hi; }
__device__ __forceinline__ void partialSM(f32x16& p0, f32x16& p1, float& m_reg, float& mn, float& alpha) {
  constexpr float C = SCALE * 1.4426950408889634f;
  float pmax = p0[0];
#pragma unroll
  for (int r = 1; r < 16; ++r) pmax = fmaxf(pmax, p0[r]);
#pragma unroll
  for (int r = 0; r < 16; ++r) pmax = fmaxf(pmax, p1[r]);
  { auto rr = __builtin_amdgcn_permlane32_swap(__float_as_uint(pmax), __float_as_uint(pmax), false, false);
    pmax = fmaxf(__uint_as_float(rr[0]), __uint_as_float(rr[1])); }
  if (__builtin_expect(__all(pmax - m_reg <= THR / SCALE), 1)) { mn = m_reg; alpha = 1.f; }
  else { mn = fmaxf(m_reg, pmax); alpha = __builtin_amdgcn_exp2f((m_reg - mn) * C); m_reg = mn; }
  const float mnC = -mn * C;
#pragma unroll
  for (int r = 0; r < 16; ++r) p0[r] = fmaf(p0[r], C, mnC);
#pragma unroll
  for (int r = 0; r < 16; ++r) p1[r] = fmaf(p1[r], C, mnC);
#pragma unroll
  for (int r = 0; r < 16; ++r) p0[r] = __builtin_amdgcn_exp2f(p0[r]);
}
__device__ __forceinline__ void finishSM(f32x16& p0, f32x16& p1, float alpha, float& l_reg, bf16x8& pa0, bf16x8& pa1, bf16x8& pa2, bf16x8& pa3) {
#pragma unroll
  for (int r = 0; r < 16; ++r) p1[r] = __builtin_amdgcn_exp2f(p1[r]);
  float ps = 0;
#pragma unroll
  for (int r = 0; r < 16; ++r) ps += p0[r];
#pragma unroll
  for (int r = 0; r < 16; ++r) ps += p1[r];
  { auto rr = __builtin_amdgcn_permlane32_swap(__float_as_uint(ps), __float_as_uint(ps), false, false);
    ps = __uint_as_float(rr[0]) + __uint_as_float(rr[1]); }
  l_reg = l_reg * alpha + ps;
#define PK4(P, BASE, OUT) do { unsigned a0 = cvt_pk_bf16(P[BASE + 0], P[BASE + 1]), a1 = cvt_pk_bf16(P[BASE + 2], P[BASE + 3]);   \
    unsigned b0 = cvt_pk_bf16(P[BASE + 4], P[BASE + 5]), b1 = cvt_pk_bf16(P[BASE + 6], P[BASE + 7]);                              \
    auto r0 = __builtin_amdgcn_permlane32_swap(a0, b0, false, false); auto r1 = __builtin_amdgcn_permlane32_swap(a1, b1, false, false); \
    v4u w = {r0[0], r1[0], r0[1], r1[1]}; OUT = __builtin_bit_cast(bf16x8, w); } while (0)
  PK4(p0, 0, pa0); PK4(p0, 8, pa1); PK4(p1, 0, pa2); PK4(p1, 8, pa3);
#undef PK4
}
__device__ __forceinline__ void qkt(f32x16& p0, f32x16& p1, const LAS unsigned char* Ks, const LAS unsigned char* Rs, const bf16x8 (&qr)[12], int r32, int hi) {
  p0 = f32x16{}; p1 = f32x16{};
#pragma unroll
  for (int d0 = 0; d0 < 8; ++d0) { const int cb = (d0 * 16 + hi * 8) * 2;
    const bf16x8 b0 = *(const LAS bf16x8*)(Ks + KSWZ(r32, cb));
    const bf16x8 b1 = *(const LAS bf16x8*)(Ks + KSWZ(32 + r32, cb));
    p0 = __builtin_amdgcn_mfma_f32_32x32x16_bf16(b0, qr[d0], p0, 0, 0, 0);
    p1 = __builtin_amdgcn_mfma_f32_32x32x16_bf16(b1, qr[d0], p1, 0, 0, 0); }
#pragma unroll
  for (int d0 = 0; d0 < 4; ++d0) { const int cb = (d0 * 16 + hi * 8) * 2;
    const bf16x8 b0 = *(const LAS bf16x8*)(Rs + RSWZ(r32, cb));
    const bf16x8 b1 = *(const LAS bf16x8*)(Rs + RSWZ(32 + r32, cb));
    p0 = __builtin_amdgcn_mfma_f32_32x32x16_bf16(b0, qr[8 + d0], p0, 0, 0, 0);
    p1 = __builtin_amdgcn_mfma_f32_32x32x16_bf16(b1, qr[8 + d0], p1, 0, 0, 0); }
}
__device__ __forceinline__ int v_st(int k, int c) { const int kk = (k & ~0xC) | ((k & 4) << 1) | ((k & 8) >> 1); return ((kk >> 3) * 4 + (c >> 5)) * 512 + ((kk & 7) * 32 + (c & 31)) * 2; }
__device__ __forceinline__ int v_rd_base(int lane) { return ((lane & 3) << 3) | (((lane >> 2) & 3) << 6) | (((lane >> 4) & 1) << 5) | (((lane >> 5) & 1) << 8); }
constexpr int v_rd_off(int d0, int ks, int half) { return d0 * 512 + ks * 4096 + half * 2048; }
template <int D0> __device__ __forceinline__ void pv_one(f32x16& od, int vb, bf16x8 pa0, bf16x8 pa1, bf16x8 pa2, bf16x8 pa3) {
  const s16x4 l0 = tr_read<v_rd_off(D0, 0, 0)>(vb), h0 = tr_read<v_rd_off(D0, 0, 1)>(vb), l1 = tr_read<v_rd_off(D0, 1, 0)>(vb), h1 = tr_read<v_rd_off(D0, 1, 1)>(vb);
  const s16x4 l2 = tr_read<v_rd_off(D0, 2, 0)>(vb), h2 = tr_read<v_rd_off(D0, 2, 1)>(vb), l3 = tr_read<v_rd_off(D0, 3, 0)>(vb), h3 = tr_read<v_rd_off(D0, 3, 1)>(vb);
  asm volatile("s_waitcnt lgkmcnt(0)" ::: "memory"); SBAR();
  od = __builtin_amdgcn_mfma_f32_32x32x16_bf16(pa0, cat4(l0, h0), od, 0, 0, 0);
  od = __builtin_amdgcn_mfma_f32_32x32x16_bf16(pa1, cat4(l1, h1), od, 0, 0, 0);
  od = __builtin_amdgcn_mfma_f32_32x32x16_bf16(pa2, cat4(l2, h2), od, 0, 0, 0);
  od = __builtin_amdgcn_mfma_f32_32x32x16_bf16(pa3, cat4(l3, h3), od, 0, 0, 0);
}
__device__ __forceinline__ void pv_d0(f32x16* o, int vb, bf16x8 pa0, bf16x8 pa1, bf16x8 pa2, bf16x8 pa3) {
  pv_one<0>(o[0], vb, pa0, pa1, pa2, pa3); pv_one<1>(o[1], vb, pa0, pa1, pa2, pa3); pv_one<2>(o[2], vb, pa0, pa1, pa2, pa3); pv_one<3>(o[3], vb, pa0, pa1, pa2, pa3);
}
__device__ __forceinline__ void attn_body(const bf16* __restrict__ Qb, const bf16* __restrict__ Kn, const bf16* __restrict__ Kr, const bf16* __restrict__ Vh,
                                          bf16* __restrict__ Ob, int seq, LAS unsigned char* lds, int tid_in) {
  int tid_ = tid_in; asm volatile("" : "+v"(tid_));
  const int tid = tid_, wid = tid >> 6, lane = tid & 63, r32 = lane & 31, hi = lane >> 5;
  LAS unsigned char* V_lds = lds + L_V; LAS unsigned char* K_lds = lds + L_K; LAS unsigned char* R_lds = lds + L_R;
  LAS float* wsf = (LAS float*)(lds + L_WS) + wid * 64; LAS float* li_l = wsf; LAS float* al_l = wsf + 32;
  float m_reg = -1e30f, l_reg = 0; f32x16 o[4] = {}; bf16x8 qr[12];
  const bf16* Qw = Qb + (size_t)(wid * QBLK + r32) * LDQ + hi * 8;
#pragma unroll
  for (int d0 = 0; d0 < 12; ++d0) qr[d0] = *(const bf16x8*)(Qw + d0 * 16);
  const int sr = tid >> 4, sc = (tid & 15) * 8, vst0 = v_st(sr, sc), vst1 = v_st(32 + sr, sc);
  const int rr = tid >> 3, rc = (tid & 7) * 8;
  const int vb0 = (int)(uintptr_t)V_lds + v_rd_base(lane);
  bf16x8 vs0, vs1, ks0, ks1, rs0;
#define SLOAD(k0) do { vs0 = *(const bf16x8*)(Vh + (size_t)((k0) + sr) * LDV + sc); vs1 = *(const bf16x8*)(Vh + (size_t)((k0) + 32 + sr) * LDV + sc); \
    ks0 = *(const bf16x8*)(Kn + (size_t)((k0) + sr) * LDKN + sc); ks1 = *(const bf16x8*)(Kn + (size_t)((k0) + 32 + sr) * LDKN + sc); \
    rs0 = *(const bf16x8*)(Kr + (size_t)((k0) + rr) * LDKR + rc); } while (0)
#define SWRITE(b) do { *(LAS bf16x8*)(V_lds + (b) * SHM_V + vst0) = vs0; *(LAS bf16x8*)(V_lds + (b) * SHM_V + vst1) = vs1; const int kc = sc * 2; \
    *(LAS bf16x8*)(K_lds + (b) * SHM_K + KSWZ(sr, kc)) = ks0; *(LAS bf16x8*)(K_lds + (b) * SHM_K + KSWZ(32 + sr, kc)) = ks1; \
    *(LAS bf16x8*)(R_lds + (b) * SHM_R + RSWZ(rr, rc * 2)) = rs0; } while (0)
#define RESC(a) do { if (__any((a) < 1.f)) { if (hi == 0) al_l[r32] = (a); asm volatile("s_waitcnt lgkmcnt(0)" ::: "memory"); \
    _Pragma("unroll") for (int d = 0; d < 4; ++d) _Pragma("unroll") for (int r = 0; r < 16; ++r) o[d][r] *= al_l[crow(r, hi)]; } } while (0)
  f32x16 pA0, pA1, pB0, pB1; float mnA, mnB, alA, alB; bf16x8 pa0, pa1, pa2, pa3; const int NT = seq / KVBLK;
  SLOAD(0); VM_WAIT(); SWRITE(0); __syncthreads();
  qkt(pA0, pA1, K_lds, R_lds, qr, r32, hi); partialSM(pA0, pA1, m_reg, mnA, alA);
  SLOAD(KVBLK);
  VM_WAIT(); SWRITE(1); __syncthreads();
  for (int j = 1; j + 1 < NT; j += 2) {
    SBAR(); qkt(pB0, pB1, K_lds + SHM_K, R_lds + SHM_R, qr, r32, hi);
    finishSM(pA0, pA1, alA, l_reg, pa0, pa1, pa2, pa3); SBAR();
    SLOAD((j + 1) * KVBLK); SBAR();
    pv_d0(o, vb0, pa0, pa1, pa2, pa3); partialSM(pB0, pB1, m_reg, mnB, alB);
    __syncthreads(); VM_WAIT(); SWRITE(0);
    RESC(alB); __syncthreads();
    SBAR(); qkt(pA0, pA1, K_lds, R_lds, qr, r32, hi);
    finishSM(pB0, pB1, alB, l_reg, pa0, pa1, pa2, pa3); SBAR();
    SLOAD((j + 2) * KVBLK); SBAR();
    pv_d0(o, vb0 + SHM_V, pa0, pa1, pa2, pa3); partialSM(pA0, pA1, m_reg, mnA, alA);
    __syncthreads(); VM_WAIT(); SWRITE(1);
    RESC(alA); __syncthreads();
  }
  SBAR(); qkt(pB0, pB1, K_lds + SHM_K, R_lds + SHM_R, qr, r32, hi);
  finishSM(pA0, pA1, alA, l_reg, pa0, pa1, pa2, pa3); SBAR();
  pv_d0(o, vb0, pa0, pa1, pa2, pa3); partialSM(pB0, pB1, m_reg, mnB, alB);
  __syncthreads(); RESC(alB);
  finishSM(pB0, pB1, alB, l_reg, pa0, pa1, pa2, pa3); SBAR();
  pv_d0(o, vb0 + SHM_V, pa0, pa1, pa2, pa3);
  if (hi == 0) li_l[r32] = l_reg; asm volatile("s_waitcnt lgkmcnt(0)" ::: "memory");
  float rli[16];
#pragma unroll
  for (int r = 0; r < 16; ++r) rli[r] = __builtin_amdgcn_rcpf(li_l[crow(r, hi)]);
  bf16* Ow = Ob + (size_t)(wid * QBLK) * LDO;
#pragma unroll
  for (int r = 0; r < 16; ++r) { const int orow = crow(r, hi);
#pragma unroll
    for (int d0 = 0; d0 < 4; ++d0) Ow[(size_t)orow * LDO + d0 * 32 + r32] = (bf16)(cvt_pk_bf16(o[d0][r] * rli[r], 0.f) & 0xffffu); }
  __syncthreads();
#undef SLOAD
#undef SWRITE
#undef RESC
}
}

__device__ __forceinline__ void phase_attn(const Args& a, bool withctx, LAS unsigned char* lds, int tid, int vcu, int G) {
    const bf16* QB = (const bf16*)(a.ws + WS_QB); const bf16* KN = (const bf16*)(a.ws + WS_KN); const bf16* KR = (const bf16*)(a.ws + WS_KR); const bf16* VB = (const bf16*)(a.ws + WS_VB);
    bf16* AO = (bf16*)(a.ws + WS_AO);
    const int nunits = 1024 + (withctx ? 64 : 0);
    for (int u = vcu; u < nunits; u += G) {
        int b, h, qrow0, krow0, seq;
        if (u < 1024) { const int bh = u >> 4, qb = u & 15; b = bh >> 4; h = bh & 15; qrow0 = b * TPB + qb * 256; krow0 = b * TPB; seq = TPB; }
        else { const int v = u - 1024; b = v >> 4; h = v & 15; qrow0 = b * TPB + SEQ; krow0 = b * TPB + SEQ; seq = CTXL; }
        att::attn_body(QB + (size_t)qrow0 * 3072 + h * 192, KN + (size_t)krow0 * 2048 + h * 128, KR + (size_t)krow0 * 64, VB + (size_t)krow0 * 2048 + h * 128,
                       AO + (size_t)qrow0 * 2048 + h * 128, seq, lds, tid);
    }
}

constexpr int PH_PER_LAYER = 10, PH_TOTAL = 2 + DEPTH * PH_PER_LAYER;
#ifndef MK_LAUNCH_PER_PHASE
#define MK_LAUNCH_PER_PHASE 0
#endif

__global__ void __launch_bounds__(NWAVES * 64, 2) fwd(Args a) {
    extern __shared__ __attribute__((aligned(16))) unsigned char lds_raw[];
    LAS unsigned char* lds = (LAS unsigned char*)lds_raw;
    const int tid = threadIdx.x, lane = tid & 63, wave = __builtin_amdgcn_readfirstlane(tid >> 6);
    const int G = gridDim.x; const int bx = blockIdx.x; const int vcu = (G % 8 == 0) ? (bx % 8) * (G / 8) + bx / 8 : bx;
    volatile LAS unsigned* MISC = (volatile LAS unsigned*)(lds + MISC_OFF);
    for (int u = tid; u < (LDS_BYTES - LDSCTL_OFF) / 4; u += NWAVES * 64) ((LAS unsigned*)(lds + LDSCTL_OFF))[u] = 0u;
    __syncthreads();
    const int lo = a.ph_lo, hi = a.ph_hi; const bool use_bar = (hi - lo) > 1;
    XcdBarrier bar; bar.bar = (unsigned*)(a.ws + WS_CTL) + CW_BAR; bar.x = 0; bar.st = MISC + 8;
    if (use_bar) bar = xcd_barrier_post((unsigned*)(a.ws + WS_CTL) + CW_BAR, MISC + 8);
#ifndef DBLMASK
#define DBLMASK 0u
#endif
#define REP(k) (((DBLMASK >> (k)) & 1) ? 2 : 1)
#ifndef PHMASK
#define PHMASK 0xFFFFFFFFu
#endif
#define IN(k) (lo <= (k) && (k) < hi)
#define SEAM(k) do { if ((k) + 1 < hi) xcd_barrier(bar, wave); } while (0)
#define U ((const bf16*)(ws + WS_U))
#define Y ((bf16*)(ws + WS_Y))
#define FRESH_TID() int lane_l; asm volatile("v_mbcnt_lo_u32_b32 %0, -1, 0\n\tv_mbcnt_hi_u32_b32 %0, -1, %0" : "=v"(lane_l));     const int wave_l = wave, tid_l = (wave << 6) | lane_l; (void)tid_l; (void)wave_l; size_t wz_ = 0; asm volatile("" : "+s"(wz_)); Args al = a; al.ws = a.ws + wz_; unsigned char* ws = al.ws; (void)ws;     int bxl = bx, vcul = vcu; asm volatile("" : "+s"(bxl), "+s"(vcul)); (void)bxl; (void)vcul

#define TAIL(cur_, fi_, cnt_) do { if (G == 256 && bxl >= (fi_)) convert_deferred(al, (LAS float*)(lds + wave_l * 16384), lane_l, (cur_) + (bxl - (fi_)) * NWAVES + wave_l, (G - (fi_)) * NWAVES, (cnt_)); } while (0)
    constexpr int TS_QKV = 0, TS_GATE = TS_QKV + 128 * 8 * 8, TS_WIN0 = TS_GATE + 128 * 8 * 8, TS_WOUT0 = TS_WIN0 + 80 * 8 * 12, TS_DQKV = TS_WOUT0 + 128 * 8 * 8, TS_WIN1 = TS_DQKV + 172 * 8 * 12, TS_WOUT1 = TS_WIN1 + 80 * 8 * 12, TS_END = TS_WOUT1 + 128 * 8 * 8;

    if (((PHMASK >> 0) & 1) && IN(0)) { for (int rep = 0; rep < REP(0); ++rep) { FRESH_TID(); phase_pro_a(al, lds, tid_l, lane_l, wave_l, vcul, G); __syncthreads(); } SEAM(0); }
    if (((PHMASK >> 1) & 1) && IN(1)) { FRESH_TID(); phase_pro_b(al, lane_l, wave_l, vcul, G); SEAM(1); }

    for (int layer = 0; layer < DEPTH; ++layer) {
        const int pb = 2 + layer * PH_PER_LAYER; const int j = layer >> 1; const bool last = (layer == DEPTH - 1);
        if ((layer & 1) == 0) {
            if (((PHMASK >> 2) & 1) && IN(pb + 0)) { FRESH_TID();
                pg8::Gemm g{U, (const bf16*)(ws + WS_WQKV) + (size_t)j * 8192 * 2048, M, 8192, 2048}; pg8::TileOrder S; S.init(NTM, 32, G, bxl, 0, 0, 32);
                EpiQKV E{(bf16*)(ws + WS_RQ), (bf16*)(ws + WS_RK), (bf16*)(ws + WS_RV), (const float*)(ws + WS_RCS)};
                for (int rep = 0; rep < REP(2); ++rep) { pg8::gemm_phase<EpiQKV, pg8::TileOrder, true, true>(lds, g, S, E, tid_l); __syncthreads(); } if (layer == 0) TAIL(TS_QKV, 128, 8); SEAM(pb + 0); }
            if (((PHMASK >> 3) & 1) && IN(pb + 1)) { for (int rep = 0; rep < REP(3); ++rep) { FRESH_TID(); phase_ret_scan(al, j, lds, tid_l, lane_l, wave_l, vcul, G); __syncthreads(); } SEAM(pb + 1); }
            if (((PHMASK >> 4) & 1) && IN(pb + 2)) { FRESH_TID();
                pg8::Gemm g{U, (const bf16*)(ws + WS_WG) + (size_t)j * 8192 * 2048, M, 8192, 2048}; pg8::TileOrder S; S.init(NTM, 32, G, bxl, 0, 0, 32);
                EpiGate E{(const bf16*)(ws + WS_OF), (const bf16*)(ws + WS_OB), (const float*)(ws + WS_PART), (bf16*)(ws + WS_YG)};
                for (int rep = 0; rep < REP(4); ++rep) { pg8::gemm_phase<EpiGate, pg8::TileOrder, true, true>(lds, g, S, E, tid_l); __syncthreads(); } if (layer == 0) TAIL(TS_GATE, 128, 8); SEAM(pb + 2); }
            if (((PHMASK >> 5) & 1) && IN(pb + 3)) { FRESH_TID();
                pg8::Gemm g{(const bf16*)(ws + WS_YG), (const bf16*)(ws + WS_WOR) + (size_t)j * 2048 * 4096, M, 2048, 4096}; pg8::TileOrder S; S.init(NTL, 8, G, bxl, 1, KSPLIT, 64);
                EpiBf E{Y, Y, 2048, 0, (float*)(ws + WS_YP)};
                for (int rep = 0; rep < REP(5); ++rep) { pg8::gemm_phase<EpiBf, pg8::TileOrder, true, true>(lds, g, S, E, tid_l); __syncthreads(); } SEAM(pb + 3); }
        } else {
            if (((PHMASK >> 6) & 1) && IN(pb + 0)) { FRESH_TID();
                pg8::Gemm g{U, (const bf16*)(ws + WS_WD) + (size_t)j * 1280 * 2048, M, 1280, 2048}; pg8::TileOrder S; S.init(NTM, 5, G, bxl, 0, 0, 32);
                EpiDQKV E{(bf16*)(ws + WS_CQN), (bf16*)(ws + WS_CKVN), (bf16*)(ws + WS_KR), (float*)(ws + WS_SSQ), (const float*)(ws + WS_ACS)};
                for (int rep = 0; rep < REP(6); ++rep) { pg8::gemm_phase<EpiDQKV, pg8::TileOrder, true, true>(lds, g, S, E, tid_l); __syncthreads(); } if (layer == 1) TAIL(TS_DQKV, 84, 12); SEAM(pb + 0); }
            if (((PHMASK >> 8) & 1) && IN(pb + 2)) { FRESH_TID();
                { pg8::Gemm g{(const bf16*)(ws + WS_CQN), (const bf16*)(ws + WS_WUQ) + (size_t)j * 3072 * 512, M, 3072, 512}; pg8::TileOrder S; S.init(last ? NTL : NTM, 12, G, bxl, last ? 1 : 0, 0, 8);
                  EpiUQ E{(bf16*)(ws + WS_QB), (const float*)(ws + WS_ACS), (const float*)(ws + WS_SSQ)};
                  for (int rep = 0; rep < REP(8); ++rep) { pg8::gemm_phase<EpiUQ, pg8::TileOrder, true, true>(lds, g, S, E, tid_l); __syncthreads(); } }
                __syncthreads();
                { pg8::Gemm g{(const bf16*)(ws + WS_CKVN), (const bf16*)(ws + WS_WUKV) + (size_t)j * 4096 * 512, M, 4096, 512}; pg8::TileOrder S; S.init(NTM, 16, G, bxl, 0, 0, 8);
                  EpiUKV E{(bf16*)(ws + WS_KN), (bf16*)(ws + WS_VB), (const float*)(ws + WS_SSQ)};
                  for (int rep = 0; rep < REP(8); ++rep) { pg8::gemm_phase<EpiUKV, pg8::TileOrder, true, true>(lds, g, S, E, tid_l); __syncthreads(); } }
                SEAM(pb + 2); }
            if (((PHMASK >> 9) & 1) && IN(pb + 3)) { FRESH_TID(); for (int rep = 0; rep < REP(9); ++rep) phase_attn(al, !last, lds, tid_l, vcul, G); SEAM(pb + 3); }
            if (((PHMASK >> 10) & 1) && IN(pb + 4)) { FRESH_TID();
                pg8::Gemm g{(const bf16*)(ws + WS_AO), (const bf16*)(ws + WS_WOM) + (size_t)j * 2048 * 2048, M, 2048, 2048}; pg8::TileOrder S; S.init(NTL, 8, G, bxl, 1, last ? 0 : KSPLIT, 32);
                EpiBf E{Y, Y, 2048, 0, (float*)(ws + WS_YP)};
                for (int rep = 0; rep < REP(10); ++rep) { pg8::gemm_phase<EpiBf, pg8::TileOrder, true, true>(lds, g, S, E, tid_l); __syncthreads(); } SEAM(pb + 4); }
        }
        if (((PHMASK >> 11) & 1) && IN(pb + 5)) { if (REP(11) > 1) { FRESH_TID(); phase_ln(al, layer, 0, lds, tid_l, lane_l, wave_l, vcul, G, true); } FRESH_TID(); phase_ln(al, layer, 0, lds, tid_l, lane_l, wave_l, vcul, G); SEAM(pb + 5); }
        if (((PHMASK >> 12) & 1) && IN(pb + 6)) { FRESH_TID();
            pg8::Gemm g{U, (const bf16*)(ws + WS_WIN) + (size_t)layer * 11264 * 2048, M, 11264, 2048}; pg8::TileOrder S; S.init(last ? NTL : NTM, 44, G, bxl, last ? 1 : 0, 0, 32);
            EpiSwiglu E{(bf16*)(ws + WS_HID)};
#if defined(SPLIT_WIN_PROBE)
            { pg8::TileOrder S1 = S; S1.ilim = 6; pg8::gemm_phase<EpiSwiglu, pg8::TileOrder, true, true>(lds, g, S1, E, tid_l); __syncthreads(); xcd_barrier(bar, wave);
              pg8::TileOrder S2 = S; S2.ioff = 6; pg8::gemm_phase<EpiSwiglu, pg8::TileOrder, true, true>(lds, g, S2, E, tid_l); __syncthreads(); } SEAM(pb + 6); }
#else
            for (int rep = 0; rep < REP(12); ++rep) { pg8::gemm_phase<EpiSwiglu, pg8::TileOrder, true, true>(lds, g, S, E, tid_l); __syncthreads(); } if (layer < 2) TAIL(layer == 0 ? TS_WIN0 : TS_WIN1, 176, 12); SEAM(pb + 6); }
#endif
        if (((PHMASK >> 13) & 1) && IN(pb + 7)) { FRESH_TID();
            pg8::Gemm g{(const bf16*)(ws + WS_HID), (const bf16*)(ws + WS_WOUT) + (size_t)layer * 2048 * 5632, M, 2048, 5632}; pg8::TileOrder S; S.init(NTL, 8, G, bxl, 1, last ? 0 : KSPLIT, 88);
            EpiBf E{Y, Y, 2048, 0, (float*)(ws + WS_YP)};
            for (int rep = 0; rep < REP(13); ++rep) { pg8::gemm_phase<EpiBf, pg8::TileOrder, true, true>(lds, g, S, E, tid_l); __syncthreads(); } if (layer < 2) TAIL(layer == 0 ? TS_WOUT0 : TS_WOUT1, 128, 8); SEAM(pb + 7); }
        if (((PHMASK >> 14) & 1) && IN(pb + 8) && layer == 1) { FRESH_TID();
            const int c0 = (G == 256) ? TS_END : 0; if (c0 < N_DEF_ITEMS) { const int NGW = G * NWAVES; convert_deferred(al, (LAS float*)(lds + wave_l * 16384), lane_l, c0 + vcul * NWAVES + wave_l, NGW, ((N_DEF_ITEMS - c0 + NGW - 1) / NGW + 3) & ~3); } __syncthreads(); }
        if (((PHMASK >> 14) & 1) && IN(pb + 8)) { if (REP(11) > 1) { FRESH_TID(); phase_ln(al, layer, 1, lds, tid_l, lane_l, wave_l, vcul, G, true); } FRESH_TID(); phase_ln(al, layer, 1, lds, tid_l, lane_l, wave_l, vcul, G); SEAM(pb + 8); }
    }
#undef IN
#undef SEAM
#undef U
#undef Y
}

extern "C" void kernel_launch(void* const* d_in, const int* in_sizes, int n_in, void* d_out, int out_size, void* d_ws, size_t ws_size, hipStream_t stream) {
    static int grid = 0;
    if (grid == 0) {
        if (n_in != 21 || ws_size < WS_END) { fprintf(stderr, "kernel_launch: need 21 inputs and %zu bytes of workspace; got %d, %zu\n", (size_t)WS_END, n_in, ws_size); grid = -1; return; }
        int dev = 0, cus = 0, per_cu = 0;
        if (hipGetDevice(&dev) != hipSuccess || hipDeviceGetAttribute(&cus, hipDeviceAttributeMultiprocessorCount, dev) != hipSuccess) { grid = -1; return; }
        if (hipFuncSetAttribute((const void*)fwd, hipFuncAttributeMaxDynamicSharedMemorySize, LDS_BYTES) != hipSuccess) { fprintf(stderr, "kernel_launch: hipFuncSetAttribute failed\n"); grid = -1; return; }
        if (hipOccupancyMaxActiveBlocksPerMultiprocessor(&per_cu, (const void*)fwd, NWAVES * 64, LDS_BYTES) != hipSuccess || per_cu < 1)
            fprintf(stderr, "kernel_launch: occupancy query reports %d workgroups per CU\n", per_cu);
        (void)hipGetLastError();
        grid = cus;
    }
    if (grid < 0) return;
    if (hipMemsetAsync((char*)d_ws + WS_CTL, 0, CTL_ZERO_BYTES, stream) != hipSuccess) return;
    Args a{};
    for (int i = 0; i < 21; ++i) a.in[i] = (const float*)d_in[i];
    a.out = (float*)d_out; a.ws = (unsigned char*)d_ws;
#if MK_LAUNCH_PER_PHASE
    for (int p = 0; p < PH_TOTAL; ++p) {
        const int pl = (p - 2) % PH_PER_LAYER, layer = (p - 2) / PH_PER_LAYER;
        if (p >= 2 && (pl == 9 || (pl == 4 && (layer & 1) == 0))) continue;
        a.ph_lo = p; a.ph_hi = p + 1;
        hipLaunchKernelGGL(fwd, dim3(grid), dim3(NWAVES * 64), LDS_BYTES, stream, a);
    }
#else
    a.ph_lo = 0; a.ph_hi = PH_TOTAL;
    hipLaunchKernelGGL(fwd, dim3(grid), dim3(NWAVES * 64), LDS_BYTES, stream, a);
#endif
    const hipError_t le = hipPeekAtLastError();
    if (le != hipSuccess) fprintf(stderr, "kernel_launch: launch failed: %s\n", hipGetErrorName(le));
}
```
